# Optimizing an MI355X kernel written in HIP

```python
import math
import jax, jax.numpy as jnp
from jax import lax
import numpy as np

D_MODEL = 1024
BATCH = 16
SEQ = 2048
DEPTH = 1

D_MIX = 2 * D_MODEL
M_WIDTH = D_MIX // 2
M_HEADS = 4
M_HD = M_WIDTH // M_HEADS
M_CHUNK = 64
CONV_K = 4
A_WIDTH = D_MIX - M_WIDTH
A_HEADS = 8
A_VHD = A_WIDTH // A_HEADS
A_QKD = A_VHD // 2
Q_BLOCK = 128
N_BUCKETS = 32
MAX_DIST = 128
EPS = 1e-6

SPLIT_SIZES = (M_WIDTH, M_WIDTH, M_WIDTH, M_WIDTH, M_WIDTH, M_HEADS, M_HEADS,
               A_WIDTH, A_WIDTH, A_WIDTH, A_WIDTH)
D_IN = 5 * M_WIDTH + 2 * M_HEADS + 4 * A_WIDTH

kernel_name = "hymba_mlstm_diffattn_hybrid"


def rmsnorm(x, w):
    xf = x.astype(jnp.float32)
    y = xf * lax.rsqrt(jnp.mean(xf * xf, axis=-1, keepdims=True) + EPS)
    return (y * w.astype(jnp.float32)).astype(x.dtype)


def head_layernorm(h, w):
    mu = jnp.mean(h, axis=-1, keepdims=True)
    var = jnp.mean(jnp.square(h - mu), axis=-1, keepdims=True)
    return (h - mu) * lax.rsqrt(var + EPS) * w.astype(jnp.float32)


def causal_dwconv(x, w):
    C = x.shape[-1]
    return lax.conv_general_dilated(
        x, w[:, None, :].astype(x.dtype), window_strides=(1,),
        padding=[(CONV_K - 1, 0)], dimension_numbers=('NWC', 'WIO', 'NWC'),
        feature_group_count=C)


def t5_bucket(q_pos, k_pos):
    n = jnp.maximum(q_pos[:, None] - k_pos[None, :], 0)
    max_exact = N_BUCKETS // 2
    nf = jnp.maximum(n, 1).astype(jnp.float32)
    large = max_exact + (jnp.log(nf / max_exact) / math.log(MAX_DIST / max_exact)
                         * (N_BUCKETS - max_exact)).astype(jnp.int32)
    large = jnp.minimum(large, N_BUCKETS - 1)
    return jnp.where(n < max_exact, n, large)


def mlstm_chunkwise(q, k, v, log_i, log_f):
    Bn, S, H, DH = q.shape
    NC = S // M_CHUNK

    def to_chunks(a):
        a = a.reshape((Bn, NC, M_CHUNK) + a.shape[2:])
        a = jnp.moveaxis(a, 3, 2)
        return jnp.moveaxis(a, 1, 0)

    qc = to_chunks(q) * (DH ** -0.5)
    kc = to_chunks(k)
    vc = to_chunks(v)
    lic = to_chunks(log_i)
    bc = jnp.cumsum(to_chunks(log_f), axis=-1)
    mask = jnp.tril(jnp.ones((M_CHUNK, M_CHUNK), dtype=bool))

    def step(carry, inp):
        C, n, m = carry
        qb, kb, vb, lib, bb = inp
        D = bb[..., :, None] - bb[..., None, :] + lib[..., None, :]
        D = jnp.where(mask, D, -jnp.inf)
        inter = bb + m[..., None]
        m_t = jnp.maximum(jnp.max(D, axis=-1), inter)
        Dw = jnp.exp(D - m_t[..., None])
        inter_w = jnp.exp(inter - m_t)
        s_qk = jnp.einsum('bhtd,bhsd->bhts', qb, kb) * Dw
        num = (inter_w[..., None] * jnp.einsum('bhed,bhtd->bhte', C, qb)
               + jnp.einsum('bhts,bhse->bhte', s_qk, vb))
        den = inter_w * jnp.einsum('bhd,bhtd->bht', n, qb) + jnp.sum(s_qk, axis=-1)
        h = num / jnp.maximum(jnp.abs(den), jnp.exp(-m_t))[..., None]
        bL = bb[..., -1]
        g = bL[..., None] - bb + lib
        m_new = jnp.maximum(bL + m, jnp.max(g, axis=-1))
        decay = jnp.exp(bL + m - m_new)
        w = jnp.exp(g - m_new[..., None])
        C_new = decay[..., None, None] * C + jnp.einsum('bhs,bhse,bhsd->bhed', w, vb, kb)
        n_new = decay[..., None] * n + jnp.einsum('bhs,bhsd->bhd', w, kb)
        return (C_new, n_new, m_new), h

    init = (jnp.zeros((Bn, H, DH, DH), jnp.float32),
            jnp.zeros((Bn, H, DH), jnp.float32),
            jnp.zeros((Bn, H), jnp.float32))
    _, hs = lax.scan(step, init, (qc, kc, vc, lic, bc))
    hs = jnp.transpose(hs, (1, 0, 3, 2, 4))
    return hs.reshape(Bn, S, H, DH)


def diff_attention(q, k, v, lam, rel_bias):
    S = q.shape[1]
    q = q * (A_QKD ** -0.5)
    outs = []
    for blk in range(S // Q_BLOCK):
        q0 = blk * Q_BLOCK
        ke = q0 + Q_BLOCK
        qb, kb, vb = q[:, q0:ke], k[:, :ke], v[:, :ke]
        logits = jnp.einsum('bqhmd,bkhmd->bmhqk', qb, kb).astype(jnp.float32)
        q_pos = jnp.arange(q0, ke)
        k_pos = jnp.arange(ke)
        bias = jnp.transpose(rel_bias[t5_bucket(q_pos, k_pos)], (2, 0, 1)).astype(jnp.float32)
        causal = k_pos[None, :] <= q_pos[:, None]
        logits = jnp.where(causal, logits + bias, -jnp.inf)
        p = jax.nn.softmax(logits, axis=-1)
        w = p[:, 0] - lam * p[:, 1]
        outs.append(jnp.einsum('bhqk,bkhe->bqhe', w, vb.astype(jnp.float32)))
    return jnp.concatenate(outs, axis=1)


def hybrid_layer(x, c, layer_idx, norm_w, w_ada, b_ada, w_in, b_i, b_f, conv_q_w,
                 conv_k_w, m_norm_w, lq1, lk1, lq2, lk2, a_norm_w, rel_bias, w_out):
    Bn, S, _ = x.shape
    mod = jax.nn.silu(c) @ w_ada + b_ada
    shift, scale, gate = jnp.split(mod, 3, axis=-1)
    h = rmsnorm(x, norm_w) * (1 + scale[:, None, :]) + shift[:, None, :]

    proj = h @ w_in
    split_pts = np.cumsum(SPLIT_SIZES)[:-1].tolist()
    mq, mk, mv, mo, mz, mi, mf, aq, ak, av, az = jnp.split(proj, split_pts, axis=-1)

    mq = jax.nn.silu(causal_dwconv(mq, conv_q_w))
    mk = jax.nn.silu(causal_dwconv(mk, conv_k_w))
    hs4 = (Bn, S, M_HEADS, M_HD)
    log_i = (mi + b_i).astype(jnp.float32)
    log_f = jax.nn.log_sigmoid((mf + b_f).astype(jnp.float32))
    hm = mlstm_chunkwise(mq.astype(jnp.float32).reshape(hs4),
                         mk.astype(jnp.float32).reshape(hs4),
                         mv.astype(jnp.float32).reshape(hs4), log_i, log_f)
    hm = head_layernorm(hm, m_norm_w.reshape(M_HEADS, M_HD))
    hm = jax.nn.sigmoid(mo.astype(jnp.float32)).reshape(hs4) * hm
    hm = hm.reshape(Bn, S, M_WIDTH).astype(x.dtype) * jax.nn.silu(mz)

    lam_init = 0.8 - 0.6 * math.exp(-0.3 * layer_idx)
    lam = (jnp.exp(jnp.sum(lq1.astype(jnp.float32) * lk1.astype(jnp.float32)))
           - jnp.exp(jnp.sum(lq2.astype(jnp.float32) * lk2.astype(jnp.float32))) + lam_init)
    ha = diff_attention(aq.reshape(Bn, S, A_HEADS, 2, A_QKD),
                        ak.reshape(Bn, S, A_HEADS, 2, A_QKD),
                        av.reshape(Bn, S, A_HEADS, A_VHD), lam, rel_bias)
    ha = rmsnorm(ha, a_norm_w) * (1 - lam_init)
    ha = ha.reshape(Bn, S, A_WIDTH).astype(x.dtype) * jax.nn.silu(az)

    y = jnp.concatenate([hm, ha], axis=-1) @ w_out
    return x + gate[:, None, :] * y


def setup_inputs(seed: int = 0) -> dict:
    key = jax.random.key(seed)
    ks = jax.random.split(key, 20)
    f32 = jnp.float32
    nrm = lambda k, s: jax.random.normal(k, s, f32)
    return {
        "x": nrm(ks[0], (BATCH, SEQ, D_MODEL)),
        "c": nrm(ks[1], (BATCH, D_MODEL)),
        "norm_w": 1.0 + 0.02 * nrm(ks[2], (DEPTH, D_MODEL)),
        "w_ada": 0.3 * D_MODEL ** -0.5 * nrm(ks[3], (DEPTH, D_MODEL, 3 * D_MODEL)),
        "b_ada": 0.01 * nrm(ks[4], (DEPTH, 3 * D_MODEL)),
        "w_in": D_MODEL ** -0.5 * nrm(ks[5], (DEPTH, D_MODEL, D_IN)),
        "b_i": 0.1 * nrm(ks[6], (DEPTH, M_HEADS)),
        "b_f": jnp.linspace(3.0, 6.0, M_HEADS, dtype=f32)[None, :] + 0.1 * nrm(ks[7], (DEPTH, M_HEADS)),
        "conv_q_w": CONV_K ** -0.5 * nrm(ks[8], (DEPTH, CONV_K, M_WIDTH)),
        "conv_k_w": CONV_K ** -0.5 * nrm(ks[9], (DEPTH, CONV_K, M_WIDTH)),
        "m_norm_w": 1.0 + 0.02 * nrm(ks[10], (DEPTH, M_WIDTH)),
        "lambda_q1": 0.1 * nrm(ks[11], (DEPTH, A_QKD)),
        "lambda_k1": 0.1 * nrm(ks[12], (DEPTH, A_QKD)),
        "lambda_q2": 0.1 * nrm(ks[13], (DEPTH, A_QKD)),
        "lambda_k2": 0.1 * nrm(ks[14], (DEPTH, A_QKD)),
        "a_norm_w": 1.0 + 0.02 * nrm(ks[15], (DEPTH, A_VHD)),
        "rel_bias": 0.5 * nrm(ks[16], (N_BUCKETS, A_HEADS)),
        "w_out": D_MIX ** -0.5 * nrm(ks[17], (DEPTH, D_MIX, D_MODEL)),
        "final_norm_w": 1.0 + 0.02 * nrm(ks[18], (D_MODEL,)),
    }


def reference(x, c, norm_w, w_ada, b_ada, w_in, b_i, b_f, conv_q_w, conv_k_w,
              m_norm_w, lambda_q1, lambda_k1, lambda_q2, lambda_k2, a_norm_w,
              rel_bias, w_out, final_norm_w):
    for l in range(DEPTH):
        x = hybrid_layer(x, c, l, norm_w[l], w_ada[l], b_ada[l], w_in[l], b_i[l], b_f[l],
                         conv_q_w[l], conv_k_w[l], m_norm_w[l], lambda_q1[l], lambda_k1[l],
                         lambda_q2[l], lambda_k2[l], a_norm_w[l], rel_bias, w_out[l])
    return rmsnorm(x, final_norm_w)
```

```cpp
#include <hip/hip_runtime.h>
#include <cstdint>
#include <cmath>

namespace bl {
constexpr int D = 1024, BATCH = 16, SEQ = 2048, DIN = 9224, DMIX = 2048;
constexpr int MH = 4, MHD = 256, AH = 8, AVD = 128, AQK = 64;
constexpr int C_MQ = 0, C_MK = 1024, C_MV = 2048, C_MO = 3072, C_MZ = 4096, C_MI = 5120, C_MF = 5124, C_AQ = 5128, C_AK = 6152, C_AV = 7176, C_AZ = 8200;
constexpr float EPS = 1e-6f;

__device__ __forceinline__ float siluf(float x) { return x / (1.f + expf(-x)); }
__device__ __forceinline__ float sigmf(float x) { return 1.f / (1.f + expf(-x)); }

__device__ __forceinline__ float block_sum(float v, float* red) {
    for (int o = 32; o > 0; o >>= 1) v += __shfl_xor(v, o);
    __syncthreads();
    if ((threadIdx.x & 63) == 0) red[threadIdx.x >> 6] = v;
    __syncthreads();
    return red[0] + red[1] + red[2] + red[3];
}
__device__ __forceinline__ float block_max(float v, float* red) {
    for (int o = 32; o > 0; o >>= 1) v = fmaxf(v, __shfl_xor(v, o));
    __syncthreads();
    if ((threadIdx.x & 63) == 0) red[threadIdx.x >> 6] = v;
    __syncthreads();
    return fmaxf(fmaxf(red[0], red[1]), fmaxf(red[2], red[3]));
}

__global__ __launch_bounds__(256) void k_mod(const float* c, const float* w_ada, const float* b_ada, float* mod) {
    __shared__ float sc[16 * 1024];
    for (int i = threadIdx.x; i < 16 * 1024; i += 256) sc[i] = siluf(c[i]);
    __syncthreads();
    const int j = blockIdx.x * 256 + threadIdx.x;
    float acc[16];
    for (int b = 0; b < 16; ++b) acc[b] = 0.f;
    for (int i = 0; i < 1024; ++i) { const float w = w_ada[(size_t)i * 3072 + j];
        for (int b = 0; b < 16; ++b) acc[b] += sc[b * 1024 + i] * w; }
    for (int b = 0; b < 16; ++b) mod[b * 3072 + j] = acc[b] + b_ada[j];
}

__global__ __launch_bounds__(256) void k_h(const float* x, const float* norm_w, const float* mod, float* h, int b) {
    __shared__ float red[4];
    const int t = blockIdx.x; const float* xr = x + ((size_t)b * SEQ + t) * D;
    float v[4]; float s = 0.f;
    for (int i = 0; i < 4; ++i) { v[i] = xr[threadIdx.x + 256 * i]; s += v[i] * v[i]; }
    const float tot = block_sum(s, red);
    const float rstd = 1.0f / sqrtf(tot / D + EPS);
    for (int i = 0; i < 4; ++i) { const int j = threadIdx.x + 256 * i;
        h[(size_t)t * D + j] = v[i] * rstd * norm_w[j] * (1.f + mod[b * 3072 + 1024 + j]) + mod[b * 3072 + j]; }
}

struct GemmArgs { const float* A; const float* B; float* C; int M, N, K, lda, ldb, ldc; long sA, sB, sC; int causal; int pad;
                  const double* F; const float* li; const float* relb; };

__device__ __forceinline__ int t5_bucket(int n) {
    if (n < 16) return n;
    const int th[15] = {19, 21, 24, 27, 31, 35, 40, 46, 52, 59, 67, 77, 87, 99, 113};
    int bkt = 16;
    for (int i = 0; i < 15; ++i) bkt += (n >= th[i]) ? 1 : 0;
    return bkt;
}

template <int TB, int EPI>
__global__ __launch_bounds__(256) void k_gemm(GemmArgs g) {
    __shared__ __attribute__((aligned(16))) float As[16][68];
    __shared__ __attribute__((aligned(16))) float Bs[16][68];
    const int z = blockIdx.z, tid = threadIdx.x;
    const float* A = g.A + (size_t)z * g.sA; const float* B = g.B + (size_t)z * g.sB; float* C = g.C + (size_t)z * g.sC;
    const int m0 = blockIdx.y * 64, n0 = blockIdx.x * 64;
    const int ty = tid >> 4, tx = tid & 15;
    float acc[4][4];
    for (int i = 0; i < 4; ++i) for (int j = 0; j < 4; ++j) acc[i][j] = 0.f;
    int kend = g.K;
    if (g.causal == 2) kend = (m0 + 64 < g.K) ? m0 + 64 : g.K;
    const bool skip = (g.causal == 1) && (n0 > m0 + 63);
    if (!skip)
    for (int k0 = 0; k0 < kend; k0 += 16) {
        { const int row = tid >> 2, kq = (tid & 3) * 4;
          const float4 v = *(const float4*)(A + (size_t)(m0 + row) * g.lda + k0 + kq);
          As[kq + 0][row] = v.x; As[kq + 1][row] = v.y; As[kq + 2][row] = v.z; As[kq + 3][row] = v.w; }
        if (TB) { const int n = tid >> 2, kq = (tid & 3) * 4;
          float4 v = make_float4(0.f, 0.f, 0.f, 0.f);
          if (n0 + n < g.N) v = *(const float4*)(B + (size_t)(n0 + n) * g.ldb + k0 + kq);
          Bs[kq + 0][n] = v.x; Bs[kq + 1][n] = v.y; Bs[kq + 2][n] = v.z; Bs[kq + 3][n] = v.w;
        } else { const int kk = tid >> 4, nq = (tid & 15) * 4;
          float4 v = make_float4(0.f, 0.f, 0.f, 0.f);
          if (n0 + nq < g.N) v = *(const float4*)(B + (size_t)(k0 + kk) * g.ldb + n0 + nq);
          *(float4*)&Bs[kk][nq] = v; }
        __syncthreads();
#pragma unroll
        for (int k = 0; k < 16; ++k) {
            const float4 a = *(const float4*)&As[k][ty * 4]; const float4 b = *(const float4*)&Bs[k][tx * 4];
            const float av[4] = {a.x, a.y, a.z, a.w}, bv[4] = {b.x, b.y, b.z, b.w};
#pragma unroll
            for (int i = 0; i < 4; ++i)
#pragma unroll
                for (int j = 0; j < 4; ++j) acc[i][j] += av[i] * bv[j];
        }
        __syncthreads();
    }
    for (int i = 0; i < 4; ++i) { const int m = m0 + ty * 4 + i;
        for (int j = 0; j < 4; ++j) { const int n = n0 + tx * 4 + j; if (n >= g.N) continue;
            float v = acc[i][j];
            if (EPI == 1) { v = (n <= m) ? v * expf((float)(g.F[(size_t)z * SEQ + m] - g.F[(size_t)z * SEQ + n]) + g.li[(size_t)z * SEQ + n]) : 0.f; }
            if (EPI == 2) { const int hh = z >> 1; v = (n <= m) ? v * 0.125f + g.relb[t5_bucket(m - n) * AH + hh] : -INFINITY; }
            C[(size_t)m * g.ldc + n] = v; } }
}

__global__ __launch_bounds__(256) void k_conv(const float* proj, const float* cqw, const float* ckw, float* qc, float* kc) {
    const int t = blockIdx.x;
    for (int i = 0; i < 4; ++i) { const int c = threadIdx.x + 256 * i;
        float aq = 0.f, ak = 0.f;
        for (int j = 0; j < 4; ++j) { const int tt = t - 3 + j; if (tt < 0) continue;
            aq += cqw[j * 1024 + c] * proj[(size_t)tt * DIN + C_MQ + c];
            ak += ckw[j * 1024 + c] * proj[(size_t)tt * DIN + C_MK + c]; }
        qc[(size_t)t * 1024 + c] = siluf(aq) * 0.0625f; kc[(size_t)t * 1024 + c] = siluf(ak); }
}
__global__ void k_gates(const float* proj, const float* b_i, const float* b_f, double* F, float* li) {
    const int h = threadIdx.x; if (h >= MH) return;
    double acc = 0.0;
    for (int t = 0; t < SEQ; ++t) {
        const float xf = proj[(size_t)t * DIN + C_MF + h] + b_f[h];
        const double xd = (double)xf;
        const double ls = fmin(xd, 0.0) - log1p(exp(-fabs(xd)));
        acc += ls; F[h * SEQ + t] = acc;
        li[h * SEQ + t] = proj[(size_t)t * DIN + C_MI + h] + b_i[h];
    }
}
__global__ __launch_bounds__(256) void k_post_m(const float* W, const float* hraw, const float* proj, const float* mnw, float* Abuf) {
    __shared__ float red[4];
    const int t = blockIdx.x;
    for (int h = 0; h < MH; ++h) {
        const float* wr = W + ((size_t)h * SEQ + t) * SEQ;
        float s = 0.f;
        for (int i = threadIdx.x; i <= t; i += 256) s += wr[i];
        const float den = block_sum(s, red);
        const float dn = fmaxf(fabsf(den), 1.0f);
        const int c = h * 256 + threadIdx.x;
        const float v = hraw[(size_t)t * 1024 + c] / dn;
        const float mu = block_sum(v, red) * (1.f / 256.f);
        const float d = v - mu;
        const float var = block_sum(d * d, red) * (1.f / 256.f);
        float o = d * (1.0f / sqrtf(var + EPS)) * mnw[c];
        o = sigmf(proj[(size_t)t * DIN + C_MO + c]) * o;
        o = o * siluf(proj[(size_t)t * DIN + C_MZ + c]);
        Abuf[(size_t)t * DMIX + c] = o;
    }
}
__global__ __launch_bounds__(256) void k_softmax(float* L, const float* lq1, const float* lk1, const float* lq2, const float* lk2) {
    __shared__ float red[4];
    const int t = blockIdx.x, h = blockIdx.y;
    float s1 = 0.f, s2 = 0.f;
    if (threadIdx.x < 64) { s1 = lq1[threadIdx.x] * lk1[threadIdx.x]; s2 = lq2[threadIdx.x] * lk2[threadIdx.x]; }
    const float d1 = block_sum(s1, red), d2 = block_sum(s2, red);
    const float lam = expf(d1) - expf(d2) + 0.2f;
    float* r0 = L + ((size_t)(2 * h) * SEQ + t) * SEQ; float* r1 = L + ((size_t)(2 * h + 1) * SEQ + t) * SEQ;
    float m0 = -INFINITY, m1 = -INFINITY;
    for (int i = threadIdx.x; i <= t; i += 256) { m0 = fmaxf(m0, r0[i]); m1 = fmaxf(m1, r1[i]); }
    m0 = block_max(m0, red); m1 = block_max(m1, red);
    float a0 = 0.f, a1 = 0.f;
    for (int i = threadIdx.x; i <= t; i += 256) { a0 += expf(r0[i] - m0); a1 += expf(r1[i] - m1); }
    a0 = block_sum(a0, red); a1 = block_sum(a1, red);
    for (int i = threadIdx.x; i < SEQ; i += 256) r0[i] = (i <= t) ? expf(r0[i] - m0) / a0 - lam * (expf(r1[i] - m1) / a1) : 0.f;
}
__global__ __launch_bounds__(256) void k_post_a(const float* haraw, const float* proj, const float* anw, float* Abuf) {
    const int t = blockIdx.x;
    __shared__ float ss[8];
    float v[4];
    for (int i = 0; i < 4; ++i) { v[i] = haraw[(size_t)t * 1024 + threadIdx.x + 256 * i]; }
    for (int i = 0; i < 4; ++i) {
        float s = v[i] * v[i];
        for (int o = 32; o > 0; o >>= 1) s += __shfl_xor(s, o);
        __syncthreads();
        if ((threadIdx.x & 63) == 0) ss[threadIdx.x >> 6] = s;
        __syncthreads();
        const int half = threadIdx.x >> 7;
        const float tot = ss[2 * half] + ss[2 * half + 1];
        const int c = threadIdx.x + 256 * i;
        float o = v[i] * (1.0f / sqrtf(tot * (1.f / 128.f) + EPS)) * anw[c & 127] * 0.8f;
        o = o * siluf(proj[(size_t)t * DIN + C_AZ + c]);
        Abuf[(size_t)t * DMIX + 1024 + c] = o;
    }
}
__global__ __launch_bounds__(256) void k_final(const float* x, const float* y, const float* mod, const float* fnw, float* out, int b) {
    __shared__ float red[4];
    const int t = blockIdx.x; const size_t row = ((size_t)b * SEQ + t) * D;
    float v[4]; float s = 0.f;
    for (int i = 0; i < 4; ++i) { const int j = threadIdx.x + 256 * i; v[i] = x[row + j] + mod[b * 3072 + 2048 + j] * y[(size_t)t * D + j]; s += v[i] * v[i]; }
    const float tot = block_sum(s, red);
    const float rstd = 1.0f / sqrtf(tot / D + EPS);
    for (int i = 0; i < 4; ++i) { const int j = threadIdx.x + 256 * i; out[row + j] = v[i] * rstd * fnw[j]; }
}
}

extern "C" void kernel_launch(void* const* d_in, const int* in_sizes, int n_in, void* d_out, int out_size, void* d_ws, size_t ws_size, hipStream_t stream) {
    using namespace bl;
    const float* x = (const float*)d_in[0]; const float* c = (const float*)d_in[1]; const float* norm_w = (const float*)d_in[2];
    const float* w_ada = (const float*)d_in[3]; const float* b_ada = (const float*)d_in[4]; const float* w_in = (const float*)d_in[5];
    const float* b_i = (const float*)d_in[6]; const float* b_f = (const float*)d_in[7]; const float* cqw = (const float*)d_in[8]; const float* ckw = (const float*)d_in[9];
    const float* mnw = (const float*)d_in[10]; const float* lq1 = (const float*)d_in[11]; const float* lk1 = (const float*)d_in[12];
    const float* lq2 = (const float*)d_in[13]; const float* lk2 = (const float*)d_in[14]; const float* anw = (const float*)d_in[15];
    const float* relb = (const float*)d_in[16]; const float* w_out = (const float*)d_in[17]; const float* fnw = (const float*)d_in[18];
    float* out = (float*)d_out;
    float* ws = (float*)d_ws; size_t off = 0;
    auto carve = [&](size_t nfl) { float* p = ws + off; off += (nfl + 63) & ~(size_t)63; return p; };
    float* mod = carve(16 * 3072);
    float* hbuf = carve((size_t)SEQ * D);
    float* proj = carve((size_t)SEQ * DIN);
    float* qc = carve((size_t)SEQ * 1024); float* kc = carve((size_t)SEQ * 1024);
    double* F = (double*)carve(2 * MH * SEQ); float* li = carve(MH * SEQ);
    float* scores = carve((size_t)16 * SEQ * SEQ);
    float* hmraw = carve((size_t)SEQ * 1024); float* haraw = carve((size_t)SEQ * 1024);
    float* Abuf = carve((size_t)SEQ * DMIX);
    float* ybuf = carve((size_t)SEQ * D);
    if (off * 4 > ws_size) return;

    k_mod<<<12, 256, 0, stream>>>(c, w_ada, b_ada, mod);
    for (int b = 0; b < BATCH; ++b) {
        k_h<<<SEQ, 256, 0, stream>>>(x, norm_w, mod, hbuf, b);
        { GemmArgs g{}; g.A = hbuf; g.B = w_in; g.C = proj; g.M = SEQ; g.N = DIN; g.K = D; g.lda = D; g.ldb = DIN; g.ldc = DIN;
          k_gemm<0, 0><<<dim3((DIN + 63) / 64, SEQ / 64, 1), 256, 0, stream>>>(g); }
        k_conv<<<SEQ, 256, 0, stream>>>(proj, cqw, ckw, qc, kc);
        k_gates<<<1, 64, 0, stream>>>(proj, b_i, b_f, F, li);
        { GemmArgs g{}; g.A = qc; g.B = kc; g.C = scores; g.M = SEQ; g.N = SEQ; g.K = MHD; g.lda = 1024; g.ldb = 1024; g.ldc = SEQ; g.sA = MHD; g.sB = MHD; g.sC = (long)SEQ * SEQ; g.causal = 1; g.F = F; g.li = li;
          k_gemm<1, 1><<<dim3(SEQ / 64, SEQ / 64, MH), 256, 0, stream>>>(g); }
        { GemmArgs g{}; g.A = scores; g.B = proj + C_MV; g.C = hmraw; g.M = SEQ; g.N = MHD; g.K = SEQ; g.lda = SEQ; g.ldb = DIN; g.ldc = 1024; g.sA = (long)SEQ * SEQ; g.sB = MHD; g.sC = MHD; g.causal = 2;
          k_gemm<0, 0><<<dim3(MHD / 64, SEQ / 64, MH), 256, 0, stream>>>(g); }
        k_post_m<<<SEQ, 256, 0, stream>>>(scores, hmraw, proj, mnw, Abuf);
        { GemmArgs g{}; g.A = proj + C_AQ; g.B = proj + C_AK; g.C = scores; g.M = SEQ; g.N = SEQ; g.K = AQK; g.lda = DIN; g.ldb = DIN; g.ldc = SEQ; g.sA = AQK; g.sB = AQK; g.sC = (long)SEQ * SEQ; g.causal = 1; g.relb = relb;
          k_gemm<1, 2><<<dim3(SEQ / 64, SEQ / 64, 2 * AH), 256, 0, stream>>>(g); }
        k_softmax<<<dim3(SEQ, AH), 256, 0, stream>>>(scores, lq1, lk1, lq2, lk2);
        { GemmArgs g{}; g.A = scores; g.B = proj + C_AV; g.C = haraw; g.M = SEQ; g.N = AVD; g.K = SEQ; g.lda = SEQ; g.ldb = DIN; g.ldc = 1024; g.sA = 2L * SEQ * SEQ; g.sB = AVD; g.sC = AVD; g.causal = 2;
          k_gemm<0, 0><<<dim3(AVD / 64, SEQ / 64, AH), 256, 0, stream>>>(g); }
        k_post_a<<<SEQ, 256, 0, stream>>>(haraw, proj, anw, Abuf);
        { GemmArgs g{}; g.A = Abuf; g.B = w_out; g.C = ybuf; g.M = SEQ; g.N = D; g.K = DMIX; g.lda = DMIX; g.ldb = D; g.ldc = D;
          k_gemm<0, 0><<<dim3(D / 64, SEQ / 64, 1), 256, 0, stream>>>(g); }
        k_final<<<SEQ, 256, 0, stream>>>(x, ybuf, mod, fnw, out, b);
    }
}
```

```cpp
#include <hip/hip_runtime.h>
#include <hip/hip_cooperative_groups.h>
#include <cstdio>
#include <cstdint>
#include <cmath>
namespace cg = cooperative_groups;
namespace pg8 {
#define PG8_LAS __attribute__((address_space(3)))
typedef unsigned short bf16_t;
typedef short bf16x8 __attribute__((ext_vector_type(8)));
typedef float f32x4 __attribute__((ext_vector_type(4)));
typedef unsigned u32x4 __attribute__((ext_vector_type(4)));
constexpr int BM = 256, BK = 64, HALF = 128, HTB = HALF * BK * 2  , STAGE_BYTES = 8 * HTB, NXCD = 8, WGM = 8;

__host__ __device__ __forceinline__ int lds_byte(int r, int c) { const int st = (r >> 4) * 2 + (c >> 5), rr = r & 15, cc = c & 31, ob = rr * 64 + cc * 2; return st * 1024 + (ob ^ (((ob >> 9) & 1) << 5)); }
__host__ __device__ __forceinline__ void stage_rc(int b, int& R, int& C) { const int st = b / 1024, sb = b % 1024, swz = sb ^ (((sb >> 9) & 1) << 5); R = (st >> 1) * 16 + swz / 64; C = (st & 1) * 32 + (swz % 64) / 2; }
__host__ __device__ __forceinline__ int perm32(int rho) { const int n = rho >> 4, i = rho & 15; return 8 * (i >> 2) + 4 * n + (i & 3); }

struct Unit { int pm, pn; };
struct Gemm { const bf16_t* A; const bf16_t* A2; const bf16_t* Bt; int M, N, K, lda, nt1; };

struct StaticOrder {
    int nM, nN, nwg, G, c;
    __host__ __device__ void init(int M, int N, int G_, int c_) { nM = M / BM; nN = N / BM; nwg = nM * nN; G = G_; c = c_; }
    __host__ __device__ bool next(int i, Unit& u) const {
        const long L = (long)i * G + c; if (L >= nwg) return false;
        int wgid = (int)L; { const int q = nwg / NXCD, r = nwg % NXCD, xcd = wgid % NXCD, off = wgid / NXCD; wgid = (xcd < r ? xcd * (q + 1) : r * (q + 1) + (xcd - r) * q) + off; }
        const int nig = WGM * nN, gid = wgid / nig, fm = gid * WGM, gsz = (nM - fm) < WGM ? (nM - fm) : WGM;
        u.pm = fm + ((wgid % nig) % gsz); u.pn = (wgid % nig) / gsz; return true;
    }
    __device__ __forceinline__ void a_ready(const Unit&) const {}
    __device__ __forceinline__ void done(const Unit&) const {}
};

__device__ __forceinline__ unsigned cvt_pk_bf16(float lo, float hi) { unsigned r; asm volatile("v_cvt_pk_bf16_f32 %0, %1, %2" : "=v"(r) : "v"(lo), "v"(hi)); return r; }
template <class Epi, class Sched, bool ALIGN_EPI = false, bool SP2 = false>
__device__ __forceinline__ void gemm_phase(PG8_LAS unsigned char* lds, const Gemm g, const Sched& S, const Epi& E) {
    const int tid = threadIdx.x, wid = __builtin_amdgcn_readfirstlane(tid >> 6), lane = tid & 63, wr = wid >> 2, wc = wid & 3, fr = lane & 15, fq = lane >> 4;
    const int K = g.K, nt = K / BK;
    unsigned voffA[2], voffB[2];
#pragma unroll
    for (int i = 0; i < 2; ++i) { int R, C; stage_rc(tid * 16 + i * 8192, R, C); const int Rb = Epi::PERM ? ((R & ~31) + perm32(R & 31)) : R;
        voffA[i] = (unsigned)(R * g.lda + C) * 2u; voffB[i] = (unsigned)(Rb * K + C) * 2u; }
    const size_t kstep = (size_t)(BK * 2);
    const size_t hstep = (size_t)HALF * K * 2;
    const size_t tstep = 2 * hstep;
    const size_t hstepA = (size_t)HALF * g.lda * 2, tstepA = 2 * hstepA; const int nt1 = g.nt1;
#define PG8_AP(b1, b2, t) ((t) < nt1 ? (b1) + (size_t)(t) * kstep : (b2) + (size_t)((t) - nt1) * kstep)
    const unsigned ldsw = (unsigned)wid * 1024u;
    const int aoff = lds_byte(wr * 64 + fr, fq * 8), boff = lds_byte(wc * 32 + fr, fq * 8);
#define PG8_SA(b, h) (((b) * 2 + (h)) * HTB)
#define PG8_SB(b, h) ((4 + (b) * 2 + (h)) * HTB)
#define PG8_STAGE(bufoff, gbase, voff) do { _Pragma("unroll") for (int _i = 0; _i < 2; ++_i) \
        __builtin_amdgcn_global_load_lds((const unsigned*)((const char*)(gbase) + (voff)[_i]), (PG8_LAS unsigned*)(lds + (bufoff) + ldsw + _i * 8192), 16, 0, 0); } while (0)
#define PG8_LDA(dst, b, h) do { _Pragma("unroll") for (int m = 0; m < 4; ++m) _Pragma("unroll") for (int k = 0; k < 2; ++k) dst[m][k] = *(const PG8_LAS bf16x8*)(lds + PG8_SA(b, h) + aoff + m * 2048 + k * 1024); } while (0)
#define PG8_LDB(dst, b, h) do { _Pragma("unroll") for (int n = 0; n < 2; ++n) _Pragma("unroll") for (int k = 0; k < 2; ++k) dst[n][k] = *(const PG8_LAS bf16x8*)(lds + PG8_SB(b, h) + boff + n * 2048 + k * 1024); } while (0)
#define PG8_MMA(ai, bj, At, Bt) do { __builtin_amdgcn_s_setprio(1); _Pragma("unroll") for (int m = 0; m < 4; ++m) _Pragma("unroll") for (int n = 0; n < 2; ++n) _Pragma("unroll") for (int k = 0; k < 2; ++k) \
        acc[ai][bj][m][n] = __builtin_amdgcn_mfma_f32_16x16x32_bf16(Bt[n][k], At[m][k], acc[ai][bj][m][n], 0, 0, 0); __builtin_amdgcn_s_setprio(0); } while (0)
#define PG8_WAIT_V(n) asm volatile("s_waitcnt vmcnt(" #n ")" ::: "memory")
#define PG8_WAIT_L(n) asm volatile("s_waitcnt lgkmcnt(" #n ")" ::: "memory")
#define PG8_BAR __builtin_amdgcn_s_barrier()
#define PG8_SCHED __builtin_amdgcn_sched_barrier(0)
    Unit cur, nxt; int ui = 0;
    if (!S.next(0, cur)) return;
    f32x4 acc[2][2][4][2];
#pragma unroll
    for (int a = 0; a < 2; ++a)
#pragma unroll
        for (int b = 0; b < 2; ++b)
#pragma unroll
            for (int m = 0; m < 4; ++m)
#pragma unroll
                for (int n = 0; n < 2; ++n) acc[a][b][m][n] = (f32x4){0.f, 0.f, 0.f, 0.f};
    bf16x8 At[4][2], B0[2][2], B1[2][2];
    const char* cA = (const char*)g.A + (size_t)cur.pm * tstepA; const char* cA2 = (const char*)g.A2 + (size_t)cur.pm * tstepA; const char* cB = (const char*)g.Bt + (size_t)cur.pn * tstep;
    S.a_ready(cur);
    if constexpr (SP2) {
        PG8_STAGE(PG8_SB(0, 0), cB, voffB); PG8_STAGE(PG8_SB(0, 1), cB + hstep, voffB); PG8_STAGE(PG8_SA(0, 0), cA, voffA); PG8_STAGE(PG8_SA(0, 1), cA + hstepA, voffA);
        if (wr == 1) PG8_BAR;
        PG8_WAIT_V(2); PG8_BAR;
        PG8_STAGE(PG8_SB(1, 0), cB + kstep, voffB); PG8_STAGE(PG8_SA(1, 0), cA + kstep, voffA); PG8_STAGE(PG8_SB(1, 1), cB + hstep + kstep, voffB);
        PG8_WAIT_V(6); PG8_BAR;
    } else {
        PG8_STAGE(PG8_SB(0, 0), cB, voffB); PG8_STAGE(PG8_SA(0, 0), cA, voffA); PG8_STAGE(PG8_SB(0, 1), cB + hstep, voffB); PG8_STAGE(PG8_SA(0, 1), cA + hstepA, voffA);
        if (wr == 1) PG8_BAR;
        PG8_WAIT_V(4); PG8_BAR;
        PG8_STAGE(PG8_SB(1, 0), cB + kstep, voffB); PG8_STAGE(PG8_SA(1, 0), cA + kstep, voffA); PG8_STAGE(PG8_SB(1, 1), cB + hstep + kstep, voffB);
        PG8_WAIT_V(6); PG8_BAR;
    }
    for (;;) {
        const bool has_next = S.next(ui + 1, nxt);
        const char* nA = has_next ? (const char*)g.A + (size_t)nxt.pm * tstepA : cA; const char* nA2 = has_next ? (const char*)g.A2 + (size_t)nxt.pm * tstepA : cA2; const char* nB = has_next ? (const char*)g.Bt + (size_t)nxt.pn * tstep : cB;
        for (int t = 0; t < nt; t += 2) {
            const bool last = (t == nt - 2);
            const char* a1 = PG8_AP(cA, cA2, t + 1);
            const char* a2 = last ? nA : PG8_AP(cA, cA2, t + 2); const char* b2 = last ? nB : cB + (size_t)(t + 2) * kstep;
            const char* a3 = last ? nA + kstep : PG8_AP(cA, cA2, t + 3); const char* b3 = b2 + kstep;
            if (last && has_next) S.a_ready(nxt);
            if constexpr (SP2) {
            PG8_LDB(B0, 0, 0); PG8_LDB(B1, 0, 1); PG8_SCHED; PG8_LDA(At, 0, 0); PG8_STAGE(PG8_SA(1, 1), a1 + hstepA, voffA);
            PG8_WAIT_V(8); PG8_WAIT_L(0); PG8_BAR; PG8_MMA(0, 0, At, B0); PG8_MMA(0, 1, At, B1); PG8_BAR; PG8_SCHED;
            PG8_LDA(At, 0, 1); PG8_STAGE(PG8_SB(0, 0), b2, voffB); PG8_STAGE(PG8_SB(0, 1), b2 + hstep, voffB); PG8_STAGE(PG8_SA(0, 0), a2, voffA);
            PG8_WAIT_V(8); PG8_WAIT_L(0); PG8_BAR; PG8_MMA(1, 0, At, B0); PG8_MMA(1, 1, At, B1); PG8_BAR; PG8_SCHED;
            PG8_LDB(B0, 1, 0); PG8_LDB(B1, 1, 1); PG8_SCHED; PG8_LDA(At, 1, 0); PG8_STAGE(PG8_SA(0, 1), a2 + hstepA, voffA);
            PG8_WAIT_V(8); PG8_WAIT_L(0); PG8_BAR; PG8_MMA(0, 0, At, B0); PG8_MMA(0, 1, At, B1); PG8_BAR; PG8_SCHED;
            PG8_LDA(At, 1, 1); PG8_STAGE(PG8_SB(1, 0), b3, voffB); PG8_STAGE(PG8_SB(1, 1), b3 + hstep, voffB); PG8_STAGE(PG8_SA(1, 0), a3, voffA);
            PG8_WAIT_V(8); PG8_WAIT_L(0); PG8_BAR; PG8_MMA(1, 0, At, B0); PG8_MMA(1, 1, At, B1); PG8_BAR; PG8_SCHED;
            } else {
            PG8_LDB(B0, 0, 0); PG8_SCHED; PG8_LDA(At, 0, 0); PG8_STAGE(PG8_SA(1, 1), a1 + hstepA, voffA);
            PG8_WAIT_L(8); PG8_BAR; PG8_WAIT_L(0); PG8_MMA(0, 0, At, B0); PG8_BAR; PG8_SCHED;
            PG8_LDB(B1, 0, 1); PG8_STAGE(PG8_SB(0, 0), b2, voffB);
            PG8_BAR; PG8_WAIT_L(0); PG8_MMA(0, 1, At, B1); PG8_BAR;
            PG8_LDA(At, 0, 1); PG8_STAGE(PG8_SA(0, 0), a2, voffA);
            PG8_BAR; PG8_WAIT_L(0); PG8_MMA(1, 0, At, B0); PG8_BAR; PG8_SCHED;
            PG8_STAGE(PG8_SB(0, 1), b2 + hstep, voffB);
            PG8_WAIT_V(6); PG8_BAR; PG8_MMA(1, 1, At, B1); PG8_BAR;
            PG8_LDB(B0, 1, 0); PG8_SCHED; PG8_LDA(At, 1, 0); PG8_STAGE(PG8_SA(0, 1), a2 + hstepA, voffA);
            PG8_WAIT_L(8); PG8_BAR; PG8_WAIT_L(0); PG8_MMA(0, 0, At, B0); PG8_BAR; PG8_SCHED;
            PG8_LDB(B1, 1, 1); PG8_STAGE(PG8_SB(1, 0), b3, voffB);
            PG8_BAR; PG8_WAIT_L(0); PG8_MMA(0, 1, At, B1); PG8_BAR;
            PG8_LDA(At, 1, 1); PG8_STAGE(PG8_SA(1, 0), a3, voffA);
            PG8_BAR; PG8_WAIT_L(0); PG8_MMA(1, 0, At, B0); PG8_BAR; PG8_SCHED;
            PG8_STAGE(PG8_SB(1, 1), b3 + hstep, voffB);
            PG8_WAIT_V(6); PG8_BAR; PG8_MMA(1, 1, At, B1); PG8_BAR;
            }
        }
        if constexpr (ALIGN_EPI) { if (wr == 0) PG8_BAR; }
        if constexpr (!Epi::AFTER_DRAIN) { E(acc, cur, wr, wc, fr, fq); S.done(cur); }
        if (!has_next) break;
#pragma unroll
        for (int a = 0; a < 2; ++a)
#pragma unroll
            for (int b = 0; b < 2; ++b)
#pragma unroll
                for (int m = 0; m < 4; ++m)
#pragma unroll
                    for (int n = 0; n < 2; ++n) acc[a][b][m][n] = (f32x4){0.f, 0.f, 0.f, 0.f};
        cur = nxt; cA = nA; cA2 = nA2; cB = nB; ++ui;
        if constexpr (ALIGN_EPI) { if (wr == 1) PG8_BAR; }
    }
    PG8_WAIT_V(0);
    if constexpr (!ALIGN_EPI) { if (wr == 0) PG8_BAR; }
    PG8_BAR;
    if constexpr (Epi::AFTER_DRAIN) { E.fused(acc, cur, wr, wc, fr, fq, lds, wid, lane); S.done(cur); }
#undef PG8_AP
#undef PG8_SA
#undef PG8_SB
#undef PG8_STAGE
#undef PG8_LDA
#undef PG8_LDB
#undef PG8_MMA
#undef PG8_WAIT_V
#undef PG8_WAIT_L
#undef PG8_BAR
#undef PG8_SCHED
}
}
constexpr int NWAVES = 8, NTHREADS = 512;
constexpr int D = 1024, BATCH = 16, SEQ = 2048, MTOK = BATCH * SEQ, DIN = 9224, NPROJ = 9216, DMIX = 2048;
constexpr int MH = 4, MHD = 256, AH = 8, AVD = 128, AQK = 64, MCH = 64;
constexpr int C_MQ = 0, C_MK = 1024, C_MV = 2048, C_MO = 3072, C_MZ = 4096, C_MI = 5120, C_MF = 5124, C_AQ = 5128, C_AK = 6152, C_AV = 7176, C_AZ = 8200;
constexpr float EPS = 1e-6f, LOG2E = 1.4426950408889634f;
constexpr float QSCALE = 0.125f * LOG2E;
constexpr size_t MiB = 1u << 20;
constexpr size_t WS_CTL = 0;
constexpr size_t WS_MOD = 1 * MiB;
constexpr size_t WS_LI = 2 * MiB;
constexpr size_t WS_LF = 2 * MiB + 512 * 1024;
constexpr size_t WS_RSS = 4 * MiB;
constexpr size_t WS_WIN = 8 * MiB;
constexpr size_t WS_WOUT = 26 * MiB;
constexpr size_t WS_HB = 32 * MiB;
constexpr size_t WS_MV = 96 * MiB;
constexpr size_t WS_GM = 160 * MiB;
constexpr size_t WS_AQ = 224 * MiB;
constexpr size_t WS_AK = 288 * MiB;
constexpr size_t WS_AV = 352 * MiB;
constexpr size_t WS_AZ = 416 * MiB;
constexpr size_t WS_END = 480 * MiB;
constexpr int CW_QUEUE = 64;
constexpr int LDS_BYTES = 155648;

#define LAS __attribute__((address_space(3)))
typedef unsigned short bf16;
typedef float f32x4 __attribute__((ext_vector_type(4)));
typedef float f32x16 __attribute__((ext_vector_type(16)));
typedef float f32x2 __attribute__((ext_vector_type(2)));
typedef short bf16x8 __attribute__((ext_vector_type(8)));
typedef short s16x4 __attribute__((ext_vector_type(4)));
typedef unsigned u32x4 __attribute__((ext_vector_type(4)));
typedef unsigned u32x2 __attribute__((ext_vector_type(2)));
typedef __bf16 bf16x2_t __attribute__((ext_vector_type(2)));

__device__ __forceinline__ unsigned pk2(float lo, float hi) { f32x2 v = {lo, hi}; bf16x2_t b = __builtin_convertvector(v, bf16x2_t); return __builtin_bit_cast(unsigned, b); }
__device__ __forceinline__ float bflo(unsigned u) { return __uint_as_float(u << 16); }
__device__ __forceinline__ float bfhi(unsigned u) { return __uint_as_float(u & 0xffff0000u); }
__device__ __forceinline__ float siluf(float x) { return x / (1.f + __expf(-x)); }
__device__ __forceinline__ float sigmf(float x) { return 1.f / (1.f + __expf(-x)); }
__device__ __forceinline__ float wave_sum(float v) {
#pragma unroll
    for (int o = 1; o < 64; o <<= 1) v += __shfl_xor(v, o);
    return v;
}

struct Args { const float* in[19]; float* out; unsigned char* ws; int ph_lo, ph_hi; };
typedef const __attribute__((address_space(4))) Args* KArgs;
__device__ __forceinline__ KArgs kargs() { KArgs p = (KArgs)__builtin_amdgcn_kernarg_segment_ptr(); asm volatile("" : "+s"(p)); return p; }

__device__ __forceinline__ int win_src_col(int n) {
    if (n < 3072) return n;
    if (n < 5120) { const int g = (n - 3072) >> 8, r = (n - 3072) & 255; return (r < 128) ? C_MO + 128 * g + r : C_MZ + 128 * g + (r - 128); }
    return n + 8;
}
__device__ __forceinline__ void p0_transpose_item(const float* W, int ldw, int K, bf16* WT, int k0, int n0, int sc0, LAS float* scr, int lane) {
#pragma unroll 8
    for (int i = 0; i < 32; ++i) { const int kk = 2 * i + (lane >> 5); scr[kk * 33 + (lane & 31)] = W[(size_t)(k0 + kk) * ldw + sc0 + (lane & 31)]; }
    asm volatile("s_waitcnt lgkmcnt(0)" ::: "memory");
    const int c = lane & 7;
#pragma unroll
    for (int j = 0; j < 4; ++j) { const int n = (lane >> 3) + 8 * j; const LAS float* s = scr + (8 * c) * 33 + n;
        u32x4 o; o.x = pk2(s[0 * 33], s[1 * 33]); o.y = pk2(s[2 * 33], s[3 * 33]); o.z = pk2(s[4 * 33], s[5 * 33]); o.w = pk2(s[6 * 33], s[7 * 33]);
        *(u32x4*)(WT + (size_t)(n0 + n) * K + k0 + 8 * c) = o; }
    asm volatile("s_waitcnt lgkmcnt(0)" ::: "memory");
}
__device__ __forceinline__ void phase0(KArgs a, LAS unsigned char* lds, int vcu, int G) {
    const int tid = threadIdx.x, lane = tid & 63, wave = __builtin_amdgcn_readfirstlane(tid >> 6);
    const float* c = a->in[1]; const float* w_ada = a->in[3]; const float* b_ada = a->in[4];
    float* mod = (float*)(a->ws + WS_MOD);
    if (blockIdx.x == 0 && tid == 0) ((unsigned*)(a->ws + WS_CTL))[CW_QUEUE] = 0u;
    for (int cgp = vcu; cgp < 256; cgp += G) {
        const int b = tid >> 5, part = tid & 31, j0 = 12 * cgp;
        float acc[12];
#pragma unroll
        for (int j = 0; j < 12; ++j) acc[j] = 0.f;
        for (int ii = 0; ii < 32; ++ii) { const int i = part + 32 * ii;
            const float s = c[b * 1024 + i]; const float sv = s / (1.f + expf(-s));
            const f32x4* wr = (const f32x4*)(w_ada + (size_t)i * 3072 + j0);
            const f32x4 w0 = wr[0], w1 = wr[1], w2 = wr[2];
            acc[0] += sv * w0[0]; acc[1] += sv * w0[1]; acc[2] += sv * w0[2]; acc[3] += sv * w0[3];
            acc[4] += sv * w1[0]; acc[5] += sv * w1[1]; acc[6] += sv * w1[2]; acc[7] += sv * w1[3];
            acc[8] += sv * w2[0]; acc[9] += sv * w2[1]; acc[10] += sv * w2[2]; acc[11] += sv * w2[3]; }
#pragma unroll
        for (int j = 0; j < 12; ++j) { float v = acc[j];
            v += __shfl_xor(v, 1); v += __shfl_xor(v, 2); v += __shfl_xor(v, 4); v += __shfl_xor(v, 8); v += __shfl_xor(v, 16);
            if (part == 0) mod[b * 3072 + j0 + j] = v + b_ada[j0 + j]; }
    }
    LAS float* scr = (LAS float*)(lds + wave * 16384);
    const int gw = vcu * NWAVES + wave, NGW = G * NWAVES;
    constexpr int I_IN = (1024 / 64) * (NPROJ / 32), I_OUT = (2048 / 64) * (1024 / 32);
    bf16* WinT = (bf16*)(a->ws + WS_WIN); bf16* WoutT = (bf16*)(a->ws + WS_WOUT);
    for (int it = gw; it < I_IN + I_OUT; it += NGW) {
        if (it < I_IN) { const int nb = it % (NPROJ / 32), kb = it / (NPROJ / 32); p0_transpose_item(a->in[5], DIN, 1024, WinT, 64 * kb, 32 * nb, win_src_col(32 * nb), scr, lane); }
        else { const int r = it - I_IN, nb = r % 32, kb = r / 32; p0_transpose_item(a->in[17], 1024, 2048, WoutT, 64 * kb, 32 * nb, 32 * nb, scr, lane); }
    }
}

__device__ __forceinline__ void phase1(KArgs a, LAS unsigned char* lds, int vcu, int G) {
    const int tid = threadIdx.x, lane = tid & 63, wave = __builtin_amdgcn_readfirstlane(tid >> 6);
    const float* x = a->in[0]; const float* norm_w = a->in[2]; const float* w_in = a->in[5]; const float* b_i = a->in[6]; const float* b_f = a->in[7];
    const float* mod = (const float*)(a->ws + WS_MOD);
    bf16* HB = (bf16*)(a->ws + WS_HB); float* LI = (float*)(a->ws + WS_LI); float* LF = (float*)(a->ws + WS_LF);
    LAS float* wg = (LAS float*)lds;
    for (int i = tid; i < 1024 * 8; i += NTHREADS) wg[i] = w_in[(size_t)(i >> 3) * DIN + C_MI + (i & 7)];
    __syncthreads();
    const int gw = vcu * NWAVES + wave, NGW = G * NWAVES;
    for (int grp = gw; grp < MTOK / 16; grp += NGW) {
        const int row0 = grp * 16, b = row0 / SEQ;
        f32x4 am[4], sh[4];
#pragma unroll
        for (int j = 0; j < 4; ++j) { const int col = 4 * lane + 256 * j;
            const f32x4 nw = *(const f32x4*)(norm_w + col), sc = *(const f32x4*)(mod + b * 3072 + 1024 + col);
            am[j] = nw * (sc + 1.0f); sh[j] = *(const f32x4*)(mod + b * 3072 + col); }
        for (int r = 0; r < 16; ++r) { const int row = row0 + r;
            LAS float* wgr = wg; asm volatile("" : "+v"(wgr));
            const f32x4* xr = (const f32x4*)(x + (size_t)row * D) + lane;
            f32x4 v[4]; float s = 0.f;
#pragma unroll
            for (int j = 0; j < 4; ++j) { v[j] = xr[64 * j]; s += (v[j][0] * v[j][0] + v[j][1] * v[j][1]) + (v[j][2] * v[j][2] + v[j][3] * v[j][3]); }
            const float rstd = 1.0f / sqrtf(wave_sum(s) * (1.f / D) + EPS);
            float g8[8];
#pragma unroll
            for (int q = 0; q < 8; ++q) g8[q] = 0.f;
            u32x2* o8 = (u32x2*)(HB + (size_t)row * D) + lane;
#pragma unroll
            for (int j = 0; j < 4; ++j) { const f32x4 hv = v[j] * rstd * am[j] + sh[j];
                u32x2 w; w.x = pk2(hv[0], hv[1]); w.y = pk2(hv[2], hv[3]); o8[64 * j] = w;
#pragma unroll
                for (int e = 0; e < 4; ++e) { const int k = 4 * lane + 256 * j + e;
                    const f32x4 w0 = *(const LAS f32x4*)(wgr + k * 8), w1 = *(const LAS f32x4*)(wgr + k * 8 + 4);
                    g8[0] += hv[e] * w0[0]; g8[1] += hv[e] * w0[1]; g8[2] += hv[e] * w0[2]; g8[3] += hv[e] * w0[3];
                    g8[4] += hv[e] * w1[0]; g8[5] += hv[e] * w1[1]; g8[6] += hv[e] * w1[2]; g8[7] += hv[e] * w1[3]; } }
#pragma unroll
            for (int q = 0; q < 8; ++q) g8[q] = wave_sum(g8[q]);
#pragma unroll
            for (int q = 0; q < 4; ++q) {
                if (lane == q) LI[(size_t)row * 4 + q] = g8[q] + b_i[q];
                if (lane == 4 + q) { const float xf = g8[4 + q] + b_f[q]; LF[(size_t)row * 4 + q] = fminf(xf, 0.f) - log1pf(expf(-fabsf(xf))); } }
        }
    }
}

struct EpiProj {
    static constexpr bool PERM = true, AFTER_DRAIN = false;
    bf16 *MQ, *MK, *MV, *GM, *AQ, *AK, *AV, *AZ;
    __device__ __forceinline__ void operator()(const pg8::f32x4 (&acc)[2][2][4][2], const pg8::Unit& u, int wr, int wc, int fr, int fq) const {
        const int pn = u.pn; const int row0 = u.pm * 256 + wr * 64 + fr;
        if (pn >= 12 && pn < 20) {
            const int col = 128 * (pn - 12) + wc * 32 + 8 * fq;
#pragma unroll
            for (int ai = 0; ai < 2; ++ai)
#pragma unroll
                for (int m = 0; m < 4; ++m) { bf16* p = GM + (size_t)(row0 + ai * 128 + m * 16) * 1024 + col;
                    float g[8];
#pragma unroll
                    for (int n = 0; n < 2; ++n)
#pragma unroll
                        for (int e = 0; e < 4; ++e) { const float o = acc[ai][0][m][n][e], z = acc[ai][1][m][n][e]; g[4 * n + e] = sigmf(o) * siluf(z); }
                    u32x4 w; w.x = pk2(g[0], g[1]); w.y = pk2(g[2], g[3]); w.z = pk2(g[4], g[5]); w.w = pk2(g[6], g[7]);
                    *(u32x4*)p = w; }
            return;
        }
        bf16* base; float sc = 1.f; int act = 0; int ct;
        if (pn < 4) { base = MQ; ct = pn; } else if (pn < 8) { base = MK; ct = pn - 4; } else if (pn < 12) { base = MV; ct = pn - 8; }
        else if (pn < 24) { base = AQ; ct = pn - 20; sc = QSCALE; } else if (pn < 28) { base = AK; ct = pn - 24; } else if (pn < 32) { base = AV; ct = pn - 28; }
        else { base = AZ; ct = pn - 32; act = 1; }
        const int col0 = ct * 256 + wc * 32 + 8 * fq;
#pragma unroll
        for (int ai = 0; ai < 2; ++ai)
#pragma unroll
            for (int m = 0; m < 4; ++m) { bf16* rowp = base + (size_t)(row0 + ai * 128 + m * 16) * 1024 + col0;
#pragma unroll
                for (int bj = 0; bj < 2; ++bj) { pg8::f32x4 v0 = acc[ai][bj][m][0], v1 = acc[ai][bj][m][1];
                    if (act) { v0 = (pg8::f32x4){siluf(v0[0]), siluf(v0[1]), siluf(v0[2]), siluf(v0[3])}; v1 = (pg8::f32x4){siluf(v1[0]), siluf(v1[1]), siluf(v1[2]), siluf(v1[3])}; }
                    v0 = v0 * sc; v1 = v1 * sc;
                    u32x4 w; w.x = pk2(v0[0], v0[1]); w.y = pk2(v0[2], v0[3]); w.z = pk2(v1[0], v1[1]); w.w = pk2(v1[2], v1[3]);
                    *(u32x4*)(rowp + bj * 128) = w; } }
    }
};
struct EpiOut {
    static constexpr bool PERM = false, AFTER_DRAIN = false;
    const float* x; const float* mod; float* out; float* rss;
    __device__ __forceinline__ void operator()(const pg8::f32x4 (&acc)[2][2][4][2], const pg8::Unit& u, int wr, int wc, int fr, int fq) const {
        const int col0 = u.pn * 256 + wc * 32 + 4 * fq; const int b = (u.pm * 256) / SEQ;
        pg8::f32x4 gv[2][2];
#pragma unroll
        for (int bj = 0; bj < 2; ++bj)
#pragma unroll
            for (int n = 0; n < 2; ++n) gv[bj][n] = *(const pg8::f32x4*)(mod + b * 3072 + 2048 + col0 + bj * 128 + n * 16);
#pragma unroll
        for (int ai = 0; ai < 2; ++ai)
#pragma unroll
            for (int m = 0; m < 4; ++m) { const int row = u.pm * 256 + ai * 128 + wr * 64 + m * 16 + fr; const size_t off = (size_t)row * D + col0; float ss = 0.f;
#pragma unroll
                for (int bj = 0; bj < 2; ++bj)
#pragma unroll
                    for (int n = 0; n < 2; ++n) { const pg8::f32x4 xv = *(const pg8::f32x4*)(x + off + bj * 128 + n * 16);
                        const pg8::f32x4 o = xv + gv[bj][n] * acc[ai][bj][m][n];
                        ss += (o[0] * o[0] + o[1] * o[1]) + (o[2] * o[2] + o[3] * o[3]);
                        *(pg8::f32x4*)(out + off + bj * 128 + n * 16) = o; }
                ss += __shfl_xor(ss, 16); ss += __shfl_xor(ss, 32);
                if (fq == 0) rss[(size_t)row * 16 + u.pn * 4 + wc] = ss; }
    }
};

__device__ __forceinline__ void phase5(KArgs a, int vcu, int G) {
    const int tid = threadIdx.x, lane = tid & 63, wave = __builtin_amdgcn_readfirstlane(tid >> 6);
    const float* fnw = a->in[18]; const float* rss = (const float*)(a->ws + WS_RSS); float* out = a->out;
    f32x4 fw[4];
#pragma unroll
    for (int j = 0; j < 4; ++j) fw[j] = *(const f32x4*)(fnw + 4 * lane + 256 * j);
    const int gw = vcu * NWAVES + wave, NGW = G * NWAVES;
    for (int grp = gw; grp < MTOK / 16; grp += NGW)
        for (int r = 0; r < 16; ++r) { const int row = grp * 16 + r;
            const f32x4* pr = (const f32x4*)(rss + (size_t)row * 16);
            const f32x4 p0 = pr[0], p1 = pr[1], p2 = pr[2], p3 = pr[3];
            const float tot = (((p0[0] + p0[1]) + (p0[2] + p0[3])) + ((p1[0] + p1[1]) + (p1[2] + p1[3]))) + (((p2[0] + p2[1]) + (p2[2] + p2[3])) + ((p3[0] + p3[1]) + (p3[2] + p3[3])));
            const float rstd = 1.0f / sqrtf(tot * (1.f / D) + EPS);
            f32x4* o = (f32x4*)(out + (size_t)row * D) + lane;
#pragma unroll
            for (int j = 0; j < 4; ++j) o[64 * j] = o[64 * j] * rstd * fw[j]; }
}
__device__ __forceinline__ int crow(int r, int hi) { return (r & 3) + 8 * (r >> 2) + 4 * hi; }
typedef short v4i16_t __attribute__((ext_vector_type(4)));
__device__ __forceinline__ s16x4 ldtr(const LAS unsigned char* p) { return __builtin_bit_cast(s16x4, __builtin_amdgcn_ds_read_tr16_b64_v4i16((LAS v4i16_t*)p)); }
__device__ __forceinline__ bf16x8 ldfrag(const LAS unsigned char* p) { return *(const LAS bf16x8*)p; }
__device__ __forceinline__ float halfswap_max(float m) { auto rr = __builtin_amdgcn_permlane32_swap(__float_as_uint(m), __float_as_uint(m), false, false); return fmaxf(__uint_as_float(rr[0]), __uint_as_float(rr[1])); }
__device__ __forceinline__ float halfswap_sum(float m) { auto rr = __builtin_amdgcn_permlane32_swap(__float_as_uint(m), __float_as_uint(m), false, false); return __uint_as_float(rr[0]) + __uint_as_float(rr[1]); }
__device__ __forceinline__ bf16x8 pack8(const f32x16& p, int base) {
    u32x4 w; w.x = pk2(p[base + 0], p[base + 1]); w.y = pk2(p[base + 2], p[base + 3]); w.z = pk2(p[base + 4], p[base + 5]); w.w = pk2(p[base + 6], p[base + 7]);
    return __builtin_bit_cast(bf16x8, w);
}
__device__ __forceinline__ int t5_bucket(int n) {
    if (n < 16) return n;
    int bkt = 16;
    bkt += (n >= 19); bkt += (n >= 21); bkt += (n >= 24); bkt += (n >= 27); bkt += (n >= 31); bkt += (n >= 35); bkt += (n >= 40); bkt += (n >= 46);
    bkt += (n >= 52); bkt += (n >= 59); bkt += (n >= 67); bkt += (n >= 77); bkt += (n >= 87); bkt += (n >= 99); bkt += (n >= 113);
    return bkt;
}

namespace att {
constexpr int L_RING = 0;
constexpr int L_TB = 65536;
constexpr int L_WSF = L_TB + 512;
constexpr int L_STAGE = L_WSF + 2048;
constexpr int SROW = 132;
constexpr float THR = 8.0f;

__device__ __forceinline__ void attn_unit(KArgs a, LAS unsigned char* lds, int b, int h, int qb, float lam) {
    int tid_ = threadIdx.x; asm volatile("" : "+v"(tid_));
    const int tid = tid_, lane = tid & 63, r32 = lane & 31, hi = lane >> 5, wave = __builtin_amdgcn_readfirstlane(tid >> 6);
    const int rb = wave & 3, mp = wave >> 2;
    bf16* AQ = (bf16*)(a->ws + WS_AQ); const bf16* AK = (const bf16*)(a->ws + WS_AK); const bf16* AV = (const bf16*)(a->ws + WS_AV); const bf16* AZ = (const bf16*)(a->ws + WS_AZ);
    const float* relb = a->in[16]; const float* anw = a->in[15];
    const size_t rowbase = (size_t)b * SEQ; const int q0 = qb * 128;
    const int qmin = q0 + 32 * rb, qrow = qmin + r32;
    LAS float* tb = (LAS float*)(lds + L_TB); LAS float* wsf = (LAS float*)(lds + L_WSF) + wave * 64; LAS float* stage = (LAS float*)(lds + L_STAGE);
    bf16x8 qf[4];
#pragma unroll
    for (int ks = 0; ks < 4; ++ks) qf[ks] = *(const bf16x8*)(AQ + (rowbase + qrow) * 1024 + h * 128 + mp * 64 + ks * 16 + hi * 8);
    if (tid < 128) tb[tid] = (tid < 113) ? (relb[t5_bucket(tid) * AH + h] - relb[31 * AH + h]) * LOG2E : 0.f;
    const int lc = tid & 15, lkv = tid >> 4;
    const bf16* kg = AK + (rowbase + lkv) * 1024 + h * 128 + lc * 8;
    const bf16* vg = AV + (rowbase + lkv) * 1024 + h * 128 + lc * 8;
    const int kofs0 = lc * 1024 + ((lkv ^ lc) * 16), kofs1 = lc * 1024 + (((lkv + 32) ^ lc) * 16);
    const int vofs0 = 16384 + (lc >> 2) * 4096 + (lkv >> 4) * 1024 + (lkv & 15) * 64 + (lc & 3) * 16, vofs1 = vofs0 + 2048;
    const int NT = 2 * qb + 2;
    u32x4 kr0, kr1, vr0, vr1;
    kr0 = *(const u32x4*)kg; kr1 = *(const u32x4*)(kg + 32 * 1024); vr0 = *(const u32x4*)vg; vr1 = *(const u32x4*)(vg + 32 * 1024);
    *(LAS u32x4*)(lds + L_RING + kofs0) = kr0; *(LAS u32x4*)(lds + L_RING + kofs1) = kr1; *(LAS u32x4*)(lds + L_RING + vofs0) = vr0; *(LAS u32x4*)(lds + L_RING + vofs1) = vr1;
    __syncthreads();
    f32x16 o[4];
#pragma unroll
    for (int e = 0; e < 4; ++e)
#pragma unroll
        for (int r = 0; r < 16; ++r) o[e][r] = 0.f;
    float mref = 0.f, lsum = 0.f;
    const int vlane = ((lane >> 4) & 1) * 32 + (lane & 3) * 8 + (4 * hi + ((lane & 15) >> 2)) * 64;
    for (int j = 0; j < NT; ++j) {
        const bool more = (j + 1 < NT);
        if (more) { const size_t go = (size_t)(j + 1) * 64 * 1024; kr0 = *(const u32x4*)(kg + go); kr1 = *(const u32x4*)(kg + go + 32 * 1024); vr0 = *(const u32x4*)(vg + go); vr1 = *(const u32x4*)(vg + go + 32 * 1024); }
        const int kv0 = 64 * j;
        if (kv0 <= qmin + 31) {
            const LAS unsigned char* kb = lds + L_RING + (j & 1) * 32768; const LAS unsigned char* vb = kb + 16384 + vlane;
            f32x16 s0, s1;
#pragma unroll
            for (int r = 0; r < 16; ++r) { s0[r] = 0.f; s1[r] = 0.f; }
#pragma unroll
            for (int ks = 0; ks < 4; ++ks) { const int cgi = mp * 8 + 2 * ks + hi;
                const bf16x8 a0 = ldfrag(kb + cgi * 1024 + ((r32 ^ cgi) * 16)), a1 = ldfrag(kb + cgi * 1024 + (((r32 + 32) ^ cgi) * 16));
                s0 = __builtin_amdgcn_mfma_f32_32x32x16_bf16(a0, qf[ks], s0, 0, 0, 0);
                s1 = __builtin_amdgcn_mfma_f32_32x32x16_bf16(a1, qf[ks], s1, 0, 0, 0); }
            if (qmin - (kv0 + 63) < 113) {
#pragma unroll
                for (int r = 0; r < 16; ++r) { const int d0 = qrow - (kv0 + crow(r, hi)); const int i0 = min(max(d0, 0), 127), i1 = min(max(d0 - 32, 0), 127);
                    s0[r] += tb[i0]; s1[r] += tb[i1]; }
            }
            if (kv0 + 63 > qmin) {
#pragma unroll
                for (int r = 0; r < 16; ++r) { const int kv = kv0 + crow(r, hi); if (kv > qrow) s0[r] = -INFINITY; if (kv + 32 > qrow) s1[r] = -INFINITY; }
            }
            float rm = fmaxf(s0[0], s1[0]);
#pragma unroll
            for (int r = 1; r < 16; ++r) rm = fmaxf(rm, fmaxf(s0[r], s1[r]));
            rm = halfswap_max(rm);
            if (j == 0) { mref = rm; }
            else if (__any(rm - mref > THR)) {
                const float mnew = fmaxf(mref, rm); const float f = __builtin_amdgcn_exp2f(mref - mnew); mref = mnew; lsum *= f;
                if (hi == 0) wsf[r32] = f;
#pragma unroll
                for (int r = 0; r < 16; ++r) { const float fr_ = wsf[crow(r, hi)];
#pragma unroll
                    for (int e = 0; e < 4; ++e) o[e][r] *= fr_; }
            }
            float ps = 0.f;
#pragma unroll
            for (int r = 0; r < 16; ++r) { s0[r] = __builtin_amdgcn_exp2f(s0[r] - mref); s1[r] = __builtin_amdgcn_exp2f(s1[r] - mref); ps += s0[r] + s1[r]; }
            lsum += ps;
            const bf16x8 pa0 = pack8(s0, 0), pa1 = pack8(s0, 8), pa2 = pack8(s1, 0), pa3 = pack8(s1, 8);
#pragma unroll
            for (int e = 0; e < 4; ++e) {
                s16x4 lo[4], hh[4];
#pragma unroll
                for (int ks = 0; ks < 4; ++ks) { lo[ks] = ldtr(vb + e * 4096 + ks * 1024); hh[ks] = ldtr(vb + e * 4096 + ks * 1024 + 512); }
#define ATT_VF(k) (bf16x8){lo[k][0], lo[k][1], lo[k][2], lo[k][3], hh[k][0], hh[k][1], hh[k][2], hh[k][3]}
                o[e] = __builtin_amdgcn_mfma_f32_32x32x16_bf16(pa0, ATT_VF(0), o[e], 0, 0, 0);
                o[e] = __builtin_amdgcn_mfma_f32_32x32x16_bf16(pa1, ATT_VF(1), o[e], 0, 0, 0);
                o[e] = __builtin_amdgcn_mfma_f32_32x32x16_bf16(pa2, ATT_VF(2), o[e], 0, 0, 0);
                o[e] = __builtin_amdgcn_mfma_f32_32x32x16_bf16(pa3, ATT_VF(3), o[e], 0, 0, 0);
#undef ATT_VF
            }
        }
        if (more) { LAS unsigned char* nb = lds + L_RING + ((j + 1) & 1) * 32768;
            *(LAS u32x4*)(nb + kofs0) = kr0; *(LAS u32x4*)(nb + kofs1) = kr1; *(LAS u32x4*)(nb + vofs0) = vr0; *(LAS u32x4*)(nb + vofs1) = vr1; }
        __syncthreads();
    }
    const float ltot = halfswap_sum(lsum);
    const float sc = (mp == 0 ? 1.0f : -lam) / ltot;
    if (hi == 0) wsf[r32] = sc;
    float scr[16];
#pragma unroll
    for (int r = 0; r < 16; ++r) scr[r] = wsf[crow(r, hi)];
    if (mp == 0) {
#pragma unroll
        for (int e = 0; e < 4; ++e)
#pragma unroll
            for (int r = 0; r < 16; ++r) stage[(32 * rb + crow(r, hi)) * SROW + 32 * e + r32] = o[e][r] * scr[r];
    }
    __syncthreads();
    if (mp == 1) {
#pragma unroll
        for (int e = 0; e < 4; ++e)
#pragma unroll
            for (int r = 0; r < 16; ++r) stage[(32 * rb + crow(r, hi)) * SROW + 32 * e + r32] += o[e][r] * scr[r];
    }
    __syncthreads();
    { const int row = tid >> 2, part = tid & 3;
      const LAS f32x4* sp = (const LAS f32x4*)(stage + row * SROW + 32 * part);
      f32x4 v[8]; float ss = 0.f;
#pragma unroll
      for (int i = 0; i < 8; ++i) { v[i] = sp[i]; ss += (v[i][0] * v[i][0] + v[i][1] * v[i][1]) + (v[i][2] * v[i][2] + v[i][3] * v[i][3]); }
      ss += __shfl_xor(ss, 1); ss += __shfl_xor(ss, 2);
      const float rs = 0.8f / sqrtf(ss * (1.f / 128.f) + EPS);
      const size_t go = (rowbase + q0 + row) * 1024 + h * 128 + 32 * part;
      const u32x4* zp = (const u32x4*)(AZ + go); u32x4* op = (u32x4*)(AQ + go); const f32x4* wp = (const f32x4*)(anw + 32 * part);
#pragma unroll
      for (int i = 0; i < 4; ++i) { const u32x4 z = zp[i]; const f32x4 w0 = wp[2 * i], w1 = wp[2 * i + 1]; const f32x4 x0 = v[2 * i] * rs * w0, x1 = v[2 * i + 1] * rs * w1;
          u32x4 w; w.x = pk2(x0[0] * bflo(z.x), x0[1] * bfhi(z.x)); w.y = pk2(x0[2] * bflo(z.y), x0[3] * bfhi(z.y));
          w.z = pk2(x1[0] * bflo(z.z), x1[1] * bfhi(z.z)); w.w = pk2(x1[2] * bflo(z.w), x1[3] * bfhi(z.w)); op[i] = w; } }
    __syncthreads();
}
}

namespace mls {
constexpr int L_Q = 0;
constexpr int L_K = 32768;
constexpr int L_STAGE = 0;
constexpr int L_KW = 66560;
constexpr int L_V = L_KW + 32768;
constexpr int L_P = L_V + 32768;
constexpr int L_SC = L_P + 8192;
constexpr int L_N = L_SC + 18 * 256;
constexpr int L_CW = L_N + 1024;
constexpr int L_END = L_CW + 8192;
static_assert(L_END <= LDS_BYTES, "mLSTM LDS map");
constexpr int SROW = 260;

__device__ __forceinline__ void mlstm_unit(KArgs a, LAS unsigned char* lds, int b, int h) {
    int tid_ = threadIdx.x; asm volatile("" : "+v"(tid_));
    const int tid = tid_, lane = tid & 63, r32 = lane & 31, hi = lane >> 5, wave = __builtin_amdgcn_readfirstlane(tid >> 6);
    const bf16* MQ = (const bf16*)a->out; const bf16* MK = (const bf16*)a->out + (size_t)MTOK * 1024; const bf16* MV = (const bf16*)(a->ws + WS_MV); const bf16* GM = (const bf16*)(a->ws + WS_GM);
    bf16* HM = (bf16*)(a->ws + WS_HB);
    const float* LI = (const float*)(a->ws + WS_LI); const float* LF = (const float*)(a->ws + WS_LF);
    const float* cqw = a->in[8]; const float* ckw = a->in[9]; const float* mnw = a->in[10];
    LAS float* S_psum = (LAS float*)(lds + L_SC) + 768; LAS float* S_qn = S_psum + 256;
    LAS float* nperm = (LAS float*)(lds + L_N); LAS float* cw = (LAS float*)(lds + L_CW); LAS float* stage = (LAS float*)(lds + L_STAGE);
    f32x16 X[8];
#pragma unroll
    for (int i = 0; i < 8; ++i)
#pragma unroll
        for (int r = 0; r < 16; ++r) X[i][r] = 0.f;
    if (tid < 256) nperm[tid] = 0.f;
    for (int i = tid; i < 2048; i += NTHREADS) { const int j = (i >> 8) & 3, d = i & 255; cw[i] = (i < 1024 ? cqw : ckw)[j * 1024 + h * 256 + d]; }
    float m_prev = 0.f;
    const int g6 = tid & 63, d0 = 4 * g6;
    const int qch = 2 * (g6 >> 2) + (g6 & 1), qbo = 8 * ((g6 >> 1) & 1);
    for (int c = 0; c < SEQ / MCH; ++c) {
        const size_t row0 = (size_t)b * SEQ + 64 * c;
        LAS float* S_alpha = (LAS float*)(lds + L_SC) + (c & 1) * 384; LAS float* S_beta = S_alpha + 64; LAS float* S_iw = S_alpha + 128; LAS float* S_clamp = S_alpha + 192; LAS float* S_ws = S_alpha + 256; LAS float* S_misc = S_alpha + 320;
        if (wave == 0) {
            const float lf = LF[(row0 + lane) * 4 + h], li = LI[(row0 + lane) * 4 + h];
            float bt = lf;
#pragma unroll
            for (int o = 1; o < 64; o <<= 1) { const float u = __shfl_up(bt, o); if (lane >= o) bt += u; }
            const float beta = li - bt; float cm = beta;
#pragma unroll
            for (int o = 1; o < 64; o <<= 1) { const float u = __shfl_up(cm, o); if (lane >= o) cm = fmaxf(cm, u); }
            const float mx = fmaxf(cm, m_prev);
            S_alpha[lane] = -mx; S_beta[lane] = beta; S_iw[lane] = expf(m_prev - mx); S_clamp[lane] = expf(-(bt + mx));
            const float cmL = __shfl(cm, 63), bL = __shfl(bt, 63); const float mxL = fmaxf(m_prev, cmL);
            S_ws[lane] = expf(beta - mxL);
            if (lane == 0) S_misc[0] = expf(m_prev - mxL);
            m_prev = bL + mxL;
        }
        __syncthreads();
#pragma unroll 1
        for (int rd = 0; rd < 2; ++rd) {
            const int t0 = 32 * rd + 4 * wave;
            u32x2 rq[7], rk[7], rv[4];
            {
              const size_t ub = ((size_t)b * SEQ + 64 * c + t0) * 1024 + h * 256;
              const bf16* qb_ = MQ + ub - 3 * 1024; const bf16* kb_ = MK + ub - 3 * 1024; const bf16* vb_ = MV + ub;
              const int t_first = 64 * c + t0 - 3;
#pragma unroll
              for (int i = 0; i < 7; ++i) {
                  if (t_first + i >= 0) { rq[i] = *(const u32x2*)(qb_ + (i * 1024 + d0)); rk[i] = *(const u32x2*)(kb_ + (i * 1024 + d0)); }
                  else { rq[i] = (u32x2){0u, 0u}; rk[i] = (u32x2){0u, 0u}; } }
#pragma unroll
              for (int i = 0; i < 4; ++i) rv[i] = *(const u32x2*)(vb_ + (i * 1024 + d0)); }
            { float qv[4][4];
#pragma unroll
              for (int t = 0; t < 4; ++t)
#pragma unroll
                  for (int e = 0; e < 4; ++e) qv[t][e] = 0.f;
#pragma unroll
              for (int j = 0; j < 4; ++j) { const f32x4 wq = *(const LAS f32x4*)(cw + j * 256 + d0);
#pragma unroll
                  for (int t = 0; t < 4; ++t) { const u32x2 uq = rq[t + j];
                      qv[t][0] += wq[0] * bflo(uq.x); qv[t][1] += wq[1] * bfhi(uq.x); qv[t][2] += wq[2] * bflo(uq.y); qv[t][3] += wq[3] * bfhi(uq.y); } }
#pragma unroll
              for (int t = 0; t < 4; ++t) { const int row = t0 + t;
#pragma unroll
                  for (int e = 0; e < 4; ++e) qv[t][e] = siluf(qv[t][e]) * 0.0625f;
                  u32x2 w; w.x = pk2(qv[t][0], qv[t][1]); w.y = pk2(qv[t][2], qv[t][3]); *(LAS u32x2*)(lds + L_Q + row * 512 + ((qch ^ (row & 15)) * 16) + qbo) = w; } }
            __builtin_amdgcn_sched_barrier(0);
            float kv[4][4];
#pragma unroll
            for (int t = 0; t < 4; ++t)
#pragma unroll
                for (int e = 0; e < 4; ++e) kv[t][e] = 0.f;
#pragma unroll
            for (int j = 0; j < 4; ++j) { const f32x4 wk = *(const LAS f32x4*)(cw + 1024 + j * 256 + d0);
#pragma unroll
                for (int t = 0; t < 4; ++t) { const u32x2 uk = rk[t + j];
                    kv[t][0] += wk[0] * bflo(uk.x); kv[t][1] += wk[1] * bfhi(uk.x); kv[t][2] += wk[2] * bflo(uk.y); kv[t][3] += wk[3] * bfhi(uk.y); } }
#pragma unroll
            for (int t = 0; t < 4; ++t) { const int row = t0 + t; const float wsr = S_ws[row];
#pragma unroll
                for (int e = 0; e < 4; ++e) kv[t][e] = siluf(kv[t][e]);
                u32x2 w; w.x = pk2(kv[t][0], kv[t][1]); w.y = pk2(kv[t][2], kv[t][3]); *(LAS u32x2*)(lds + L_K + row * 512 + ((qch ^ (row & 15)) * 16) + qbo) = w;
#pragma unroll
                for (int e = 0; e < 4; ++e) kv[t][e] *= wsr; }
            const int cs = t0 >> 3, bs = (t0 & 7) * 2;
#pragma unroll
            for (int e = 0; e < 4; ++e) { const int d = d0 + e; const int ro = d * 128 + ((cs ^ ((d >> 1) & 7)) * 16) + bs;
                u32x2 w; w.x = pk2(kv[0][e], kv[1][e]); w.y = pk2(kv[2][e], kv[3][e]); *(LAS u32x2*)(lds + L_KW + ro) = w;
                const unsigned sh = (e & 1) * 16;
                const unsigned v0 = ((e < 2 ? rv[0].x : rv[0].y) >> sh) & 0xffffu, v1 = ((e < 2 ? rv[1].x : rv[1].y) >> sh) & 0xffffu, v2 = ((e < 2 ? rv[2].x : rv[2].y) >> sh) & 0xffffu, v3 = ((e < 2 ? rv[3].x : rv[3].y) >> sh) & 0xffffu;
                u32x2 wv; wv.x = v0 | (v1 << 16); wv.y = v2 | (v3 << 16); *(LAS u32x2*)(lds + L_V + ro) = wv; }
        }
        __syncthreads();
        f32x16 num[2];
        {
            int lo_ = lane; asm volatile("" : "+v"(lo_));
            const int l15 = lo_ & 15, kq = lo_ >> 4, r32a = lo_ & 31, hia = lo_ >> 5;
            const int si = wave >> 1, ti0 = 2 * (wave & 1);
            f32x4 sa[2] = {(f32x4){0.f, 0.f, 0.f, 0.f}, (f32x4){0.f, 0.f, 0.f, 0.f}};
            { const int y = kq ^ l15; const int rowoff = l15 * 512;
              int b4[4];
#pragma unroll
              for (int j = 0; j < 4; ++j) b4[j] = rowoff + (((4 * j) ^ y) * 16);
              const LAS unsigned char* kbase = lds + L_K + si * 8192; const LAS unsigned char* qbase = lds + L_Q + ti0 * 8192;
#pragma unroll
              for (int kk = 0; kk < 8; ++kk) { const int o_ = b4[kk & 3] + (kk >> 2) * 256;
                  const bf16x8 ka = ldfrag(kbase + o_);
                  const bf16x8 q0_ = ldfrag(qbase + o_), q1_ = ldfrag(qbase + 8192 + o_);
                  sa[0] = __builtin_amdgcn_mfma_f32_16x16x32_bf16(ka, q0_, sa[0], 0, 0, 0);
                  sa[1] = __builtin_amdgcn_mfma_f32_16x16x32_bf16(ka, q1_, sa[1], 0, 0, 0); } }
#pragma unroll
            for (int u = 0; u < 2; ++u) { const int ti = ti0 + u, t = 16 * ti + l15, s_ = 16 * si + 4 * kq;
                const float al = S_alpha[t]; const f32x4 bt4 = *(const LAS f32x4*)(S_beta + s_); float pv_[4]; float psum = 0.f;
#pragma unroll
                for (int r = 0; r < 4; ++r) { pv_[r] = (s_ + r <= t) ? sa[u][r] * __expf(al + bt4[r]) : 0.f; psum += pv_[r]; }
                psum += __shfl_xor(psum, 16); psum += __shfl_xor(psum, 32);
                if (kq == 0) S_psum[si * 64 + t] = psum;
                u32x2 w; w.x = pk2(pv_[0], pv_[1]); w.y = pk2(pv_[2], pv_[3]);
                const int cp = 2 * si + (kq >> 1);
                *(LAS u32x2*)(lds + L_P + t * 128 + ((cp ^ ((t >> 1) & 7)) * 16) + 8 * (kq & 1)) = w; }
#pragma unroll
            for (int r = 0; r < 16; ++r) { num[0][r] = 0.f; num[1][r] = 0.f; }
            { const int yq = hia ^ (r32a & 15); const int rowoff = r32a * 512;
              int b8[8];
#pragma unroll
              for (int g = 0; g < 8; ++g) b8[g] = rowoff + (((2 * g) ^ yq) * 16);
              const LAS unsigned char* qbase = lds + L_Q;
#pragma unroll
              for (int dt = 0; dt < 8; ++dt) { __builtin_amdgcn_sched_barrier(0);
#pragma unroll
                  for (int sp = 0; sp < 2; ++sp) { const bf16x8 xb = pack8(X[dt], 8 * sp); const int G_ = 2 * dt + sp; const int o_ = b8[G_ & 7] + (G_ >> 3) * 256;
                      const bf16x8 qa0 = ldfrag(qbase + o_), qa1 = ldfrag(qbase + 16384 + o_);
                      num[0] = __builtin_amdgcn_mfma_f32_32x32x16_bf16(qa0, xb, num[0], 0, 0, 0);
                      num[1] = __builtin_amdgcn_mfma_f32_32x32x16_bf16(qa1, xb, num[1], 0, 0, 0); } } }
            __builtin_amdgcn_sched_barrier(0);
            { int to_ = tid; asm volatile("" : "+v"(to_));
              const int t = to_ >> 3, part = to_ & 7; float accn = 0.f;
#pragma unroll
              for (int i = 0; i < 4; ++i) { const int ch = 4 * part + i; const u32x4 qq = *(const LAS u32x4*)(lds + L_Q + t * 512 + ((ch ^ (t & 15)) * 16));
                  const f32x4 n0 = *(const LAS f32x4*)(nperm + 8 * ch), n1 = *(const LAS f32x4*)(nperm + 8 * ch + 4);
                  accn += bflo(qq.x) * n0[0] + bfhi(qq.x) * n0[1] + bflo(qq.y) * n0[2] + bfhi(qq.y) * n0[3] + bflo(qq.z) * n1[0] + bfhi(qq.z) * n1[1] + bflo(qq.w) * n1[2] + bfhi(qq.w) * n1[3]; }
              accn += __shfl_xor(accn, 1); accn += __shfl_xor(accn, 2); accn += __shfl_xor(accn, 4);
              if (part == 0) S_qn[t] = accn; }
        }
        __syncthreads();
        {
            int lo_ = lane; asm volatile("" : "+v"(lo_));
            const int r32a = lo_ & 31, hia = lo_ >> 5;
            const int e = 32 * wave + r32a;
            const int yk = hia ^ ((r32a >> 1) & 7); const int rowoff = r32a * 128;
            int b4[4];
#pragma unroll
            for (int ks = 0; ks < 4; ++ks) b4[ks] = rowoff + (((2 * ks) ^ yk) * 16);
            bf16x8 vf[4];
#pragma unroll
            for (int ks = 0; ks < 4; ++ks) vf[ks] = ldfrag(lds + L_V + wave * 4096 + b4[ks]);
#pragma unroll
            for (int tt = 0; tt < 2; ++tt) {
#pragma unroll
                for (int g = 0; g < 4; ++g) { const f32x4 iw4 = *(const LAS f32x4*)(S_iw + 32 * tt + 8 * g + 4 * hia);
#pragma unroll
                    for (int q = 0; q < 4; ++q) num[tt][4 * g + q] *= iw4[q]; }
#pragma unroll
                for (int ks = 0; ks < 4; ++ks) { const bf16x8 pa = ldfrag(lds + L_P + tt * 4096 + b4[ks]);
                    num[tt] = __builtin_amdgcn_mfma_f32_32x32x16_bf16(pa, vf[ks], num[tt], 0, 0, 0); }
#pragma unroll
                for (int r = 0; r < 16; ++r) stage[(32 * tt + crow(r, hia)) * SROW + e] = num[tt][r];
            }
            const float decay = S_misc[0];
#pragma unroll
            for (int dt = 0; dt < 8; ++dt) { __builtin_amdgcn_sched_barrier(0);
#pragma unroll
                for (int r = 0; r < 16; ++r) X[dt][r] *= decay;
#pragma unroll
                for (int ks = 0; ks < 4; ++ks) { const bf16x8 ka = ldfrag(lds + L_KW + dt * 4096 + b4[ks]);
                    X[dt] = __builtin_amdgcn_mfma_f32_32x32x16_bf16(ka, vf[ks], X[dt], 0, 0, 0); } }
            __builtin_amdgcn_sched_barrier(0);
            int to_ = tid; asm volatile("" : "+v"(to_));
            if (to_ < 256) { const int d = to_; float s = 0.f;
#pragma unroll
                for (int i = 0; i < 8; ++i) { const u32x4 kk = *(const LAS u32x4*)(lds + L_KW + d * 128 + i * 16);
                    s += (bflo(kk.x) + bfhi(kk.x)) + (bflo(kk.y) + bfhi(kk.y)) + (bflo(kk.z) + bfhi(kk.z)) + (bflo(kk.w) + bfhi(kk.w)); }
                const int p = (d & ~12) | ((d & 4) << 1) | ((d & 8) >> 1);
                nperm[p] = decay * nperm[p] + s; }
        }
        __syncthreads();
        { const int t = tid >> 3, part = tid & 7;
          const float den = S_iw[t] * S_qn[t] + ((S_psum[t] + S_psum[64 + t]) + (S_psum[128 + t] + S_psum[192 + t]));
          const float hd = 1.0f / fmaxf(fabsf(den), S_clamp[t]);
          const LAS f32x4* sp = (const LAS f32x4*)(stage + t * SROW + 32 * part);
          f32x4 v[8]; float s1 = 0.f;
#pragma unroll
          for (int i = 0; i < 8; ++i) { v[i] = sp[i] * hd; s1 += (v[i][0] + v[i][1]) + (v[i][2] + v[i][3]); }
          s1 += __shfl_xor(s1, 1); s1 += __shfl_xor(s1, 2); s1 += __shfl_xor(s1, 4);
          const float mu = s1 * (1.f / 256.f); float s2 = 0.f;
#pragma unroll
          for (int i = 0; i < 8; ++i) { v[i] = v[i] - mu; s2 += (v[i][0] * v[i][0] + v[i][1] * v[i][1]) + (v[i][2] * v[i][2] + v[i][3] * v[i][3]); }
          s2 += __shfl_xor(s2, 1); s2 += __shfl_xor(s2, 2); s2 += __shfl_xor(s2, 4);
          const float rs = 1.0f / sqrtf(s2 * (1.f / 256.f) + EPS);
          const size_t ub = row0 * 1024 + h * 256; const int lo2 = t * 1024 + 32 * part;
          const u32x4* gp = (const u32x4*)(GM + ub + lo2); u32x4* op = (u32x4*)(HM + ub + lo2); const f32x4* wp = (const f32x4*)(mnw + h * 256 + 32 * part);
#pragma unroll
          for (int i = 0; i < 4; ++i) { const u32x4 z = gp[i]; const f32x4 w0 = wp[2 * i], w1 = wp[2 * i + 1]; const f32x4 x0 = v[2 * i] * rs * w0, x1 = v[2 * i + 1] * rs * w1;
              u32x4 w; w.x = pk2(x0[0] * bflo(z.x), x0[1] * bfhi(z.x)); w.y = pk2(x0[2] * bflo(z.y), x0[3] * bfhi(z.y));
              w.z = pk2(x1[0] * bflo(z.z), x1[1] * bfhi(z.z)); w.w = pk2(x1[2] * bflo(z.w), x1[3] * bfhi(z.w)); op[i] = w; } }
    }
    __syncthreads();
}
}

__device__ __forceinline__ void phase3(KArgs a, LAS unsigned char* lds) {
    const int tid = threadIdx.x, lane = tid & 63;
    float s1 = a->in[11][lane] * a->in[12][lane], s2 = a->in[13][lane] * a->in[14][lane];
    s1 = wave_sum(s1); s2 = wave_sum(s2);
    const float lam = __uint_as_float(__builtin_amdgcn_readfirstlane(__float_as_uint(expf(s1) - expf(s2) + 0.2f)));
    unsigned* qhead = (unsigned*)(a->ws + WS_CTL) + CW_QUEUE;
    LAS unsigned* slot = (LAS unsigned*)(lds + LDS_BYTES - 64);
    constexpr unsigned N_M = BATCH * MH, N_A = BATCH * AH * (SEQ / 128);
    for (;;) {
        if (tid == 0) *slot = __hip_atomic_fetch_add(qhead, 1u, __ATOMIC_RELAXED, __HIP_MEMORY_SCOPE_AGENT);
        __syncthreads();
        const unsigned it = *slot;
        __syncthreads();
        if (it >= N_M + N_A) break;
        if (it < N_M) mls::mlstm_unit(a, lds, (int)(it >> 2), (int)(it & 3));
        else { const unsigned i = it - N_M; const int qb = 15 - (int)(i >> 7), bh = (int)(i & 127); att::attn_unit(a, lds, bh >> 3, bh & 7, qb, lam); }
    }
}
template <bool COOP>
__global__ void __launch_bounds__(NTHREADS, 2) fwd(Args args) {
    extern __shared__ __attribute__((aligned(16))) unsigned char lds_raw[];
    LAS unsigned char* lds = (LAS unsigned char*)lds_raw;
    const int G = gridDim.x, bx = blockIdx.x;
    const int vcu = (G % 8 == 0) ? (bx % 8) * (G / 8) + bx / 8 : bx;
    const int lo = args.ph_lo, hi = args.ph_hi;
#define IN(k) (lo <= (k) && (k) < hi)
#define SEAM(k) do { if constexpr (COOP) { if (IN(k) && IN((k) + 1)) cg::this_grid().sync(); } } while (0)
    if (IN(0)) phase0(kargs(), lds, vcu, G);
    SEAM(0);
    if (IN(1)) phase1(kargs(), lds, vcu, G);
    SEAM(1);
    if (IN(2)) {
        const KArgs ka = kargs(); unsigned char* ws_ = ka->ws; float* out_ = ka->out;
        pg8::Gemm g{(const bf16*)(ws_ + WS_HB), (const bf16*)(ws_ + WS_HB), (const bf16*)(ws_ + WS_WIN), MTOK, NPROJ, 1024, 1024, 16};
        pg8::StaticOrder S; S.init(MTOK, NPROJ, G, bx);
        EpiProj E{(bf16*)out_, (bf16*)out_ + (size_t)MTOK * 1024, (bf16*)(ws_ + WS_MV), (bf16*)(ws_ + WS_GM), (bf16*)(ws_ + WS_AQ), (bf16*)(ws_ + WS_AK), (bf16*)(ws_ + WS_AV), (bf16*)(ws_ + WS_AZ)};
        pg8::gemm_phase<EpiProj, pg8::StaticOrder, true, true>(lds, g, S, E);
    }
    SEAM(2);
    if (IN(3)) phase3(kargs(), lds);
    SEAM(3);
    if (IN(4)) {
        const KArgs ka = kargs(); unsigned char* ws_ = ka->ws; float* out_ = ka->out; const float* x_ = ka->in[0];
        pg8::Gemm g{(const bf16*)(ws_ + WS_HB), (const bf16*)(ws_ + WS_AQ), (const bf16*)(ws_ + WS_WOUT), MTOK, D, DMIX, 1024, 16};
        pg8::StaticOrder S; S.init(MTOK, D, G, bx);
        EpiOut E{x_, (const float*)(ws_ + WS_MOD), out_, (float*)(ws_ + WS_RSS)};
        pg8::gemm_phase<EpiOut, pg8::StaticOrder, true, true>(lds, g, S, E);
    }
    SEAM(4);
    if (IN(5)) phase5(kargs(), vcu, G);
#undef IN
#undef SEAM
}

#ifndef MK_MULTI
#define MK_MULTI 1
#endif
extern "C" void kernel_launch(void* const* d_in, const int* in_sizes, int n_in, void* d_out, int out_size, void* d_ws, size_t ws_size, hipStream_t stream) {
    static int grid = 0;
    if (grid == 0) {
        if (n_in != 19 || out_size != MTOK * D || ws_size < WS_END) { fprintf(stderr, "kernel_launch: unexpected shapes (n_in %d, out %d, ws %zu)\n", n_in, out_size, ws_size); grid = -1; return; }
        int dev = 0, cus = 0, per_cu = 0;
        hipGetDevice(&dev); hipDeviceGetAttribute(&cus, hipDeviceAttributeMultiprocessorCount, dev);
        hipFuncSetAttribute((const void*)fwd<true>, hipFuncAttributeMaxDynamicSharedMemorySize, LDS_BYTES);
        hipFuncSetAttribute((const void*)fwd<false>, hipFuncAttributeMaxDynamicSharedMemorySize, LDS_BYTES);
        hipOccupancyMaxActiveBlocksPerMultiprocessor(&per_cu, (const void*)fwd<true>, NTHREADS, LDS_BYTES);
        if (per_cu < 1) { fprintf(stderr, "kernel_launch: occupancy query says %d blocks per CU\n", per_cu); per_cu = 1; }
        (void)hipGetLastError();
        grid = cus * (per_cu > 1 ? 1 : per_cu);
    }
    if (grid < 0) return;
    hipMemsetAsync((char*)d_ws + WS_CTL, 0, 1 * MiB, stream);
    Args a{};
    for (int i = 0; i < 19; ++i) a.in[i] = (const float*)d_in[i];
    a.out = (float*)d_out; a.ws = (unsigned char*)d_ws;
#if MK_MULTI
    for (int ph = 0; ph < 6; ++ph) { a.ph_lo = ph; a.ph_hi = ph + 1; hipLaunchKernelGGL(fwd<false>, dim3(grid), dim3(NTHREADS), LDS_BYTES, stream, a); }
#else
    a.ph_lo = 0; a.ph_hi = 6;
    void* kargs[] = {&a};
    hipError_t e = hipLaunchCooperativeKernel((const void*)fwd<true>, dim3(grid), dim3(NTHREADS), kargs, LDS_BYTES, stream);
    if (e != hipSuccess) fprintf(stderr, "cooperative launch failed: %s (grid %d)\n", hipGetErrorString(e), grid);
#endif
}
```

```cpp
#include <hip/hip_runtime.h>
#include <hip/hip_cooperative_groups.h>
#include <cstdio>
#include <cstdint>
#include <cmath>
namespace cg = cooperative_groups;
namespace pg8 {
#define PG8_LAS __attribute__((address_space(3)))
typedef unsigned short bf16_t;
typedef short bf16x8 __attribute__((ext_vector_type(8)));
typedef float f32x4 __attribute__((ext_vector_type(4)));
typedef unsigned u32x4 __attribute__((ext_vector_type(4)));
constexpr int BM = 256, BK = 64, HALF = 128, HTB = HALF * BK * 2  , STAGE_BYTES = 8 * HTB, NXCD = 8, WGM = 8;

__host__ __device__ __forceinline__ int lds_byte(int r, int c) { const int st = (r >> 4) * 2 + (c >> 5), rr = r & 15, cc = c & 31, ob = rr * 64 + cc * 2; return st * 1024 + (ob ^ (((ob >> 9) & 1) << 5)); }
__host__ __device__ __forceinline__ void stage_rc(int b, int& R, int& C) { const int st = b / 1024, sb = b % 1024, swz = sb ^ (((sb >> 9) & 1) << 5); R = (st >> 1) * 16 + swz / 64; C = (st & 1) * 32 + (swz % 64) / 2; }
__host__ __device__ __forceinline__ int perm32(int rho) { const int n = rho >> 4, i = rho & 15; return 8 * (i >> 2) + 4 * n + (i & 3); }

struct Unit { int pm, pn; };
struct Gemm { const bf16_t* A; const bf16_t* A2; const bf16_t* Bt; int M, N, K, lda, nt1; };

struct StaticOrder {
    int nM, nN, nwg, G, c;
    __host__ __device__ void init(int M, int N, int G_, int c_) { nM = M / BM; nN = N / BM; nwg = nM * nN; G = G_; c = c_; }
    __host__ __device__ bool next(int i, Unit& u) const {
        const long L = (long)i * G + c; if (L >= nwg) return false;
        int wgid = (int)L; { const int q = nwg / NXCD, r = nwg % NXCD, xcd = wgid % NXCD, off = wgid / NXCD; wgid = (xcd < r ? xcd * (q + 1) : r * (q + 1) + (xcd - r) * q) + off; }
        const int nig = WGM * nN, gid = wgid / nig, fm = gid * WGM, gsz = (nM - fm) < WGM ? (nM - fm) : WGM;
        u.pm = fm + ((wgid % nig) % gsz); u.pn = (wgid % nig) / gsz; return true;
    }
    __device__ __forceinline__ void a_ready(const Unit&) const {}
    __device__ __forceinline__ void done(const Unit&) const {}
};

__device__ __forceinline__ unsigned cvt_pk_bf16(float lo, float hi) { unsigned r; asm volatile("v_cvt_pk_bf16_f32 %0, %1, %2" : "=v"(r) : "v"(lo), "v"(hi)); return r; }
template <class Epi, class Sched, bool ALIGN_EPI = false, bool SP2 = false>
__device__ __forceinline__ void gemm_phase(PG8_LAS unsigned char* lds, const Gemm g, const Sched& S, const Epi& E) {
    const int tid = threadIdx.x, wid = __builtin_amdgcn_readfirstlane(tid >> 6), lane = tid & 63, wr = wid >> 2, wc = wid & 3, fr = lane & 15, fq = lane >> 4;
    const int K = g.K, nt = K / BK;
    unsigned voffA[2], voffB[2];
#pragma unroll
    for (int i = 0; i < 2; ++i) { int R, C; stage_rc(tid * 16 + i * 8192, R, C); const int Rb = Epi::PERM ? ((R & ~31) + perm32(R & 31)) : R;
        voffA[i] = (unsigned)(R * g.lda + C) * 2u; voffB[i] = (unsigned)(Rb * K + C) * 2u; }
    const size_t kstep = (size_t)(BK * 2);
    const size_t hstep = (size_t)HALF * K * 2;
    const size_t tstep = 2 * hstep;
    const size_t hstepA = (size_t)HALF * g.lda * 2, tstepA = 2 * hstepA; const int nt1 = g.nt1;
#define PG8_AP(b1, b2, t) ((t) < nt1 ? (b1) + (size_t)(t) * kstep : (b2) + (size_t)((t) - nt1) * kstep)
    const unsigned ldsw = (unsigned)wid * 1024u;
    const int aoff = lds_byte(wr * 64 + fr, fq * 8), boff = lds_byte(wc * 32 + fr, fq * 8);
#define PG8_SA(b, h) (((b) * 2 + (h)) * HTB)
#define PG8_SB(b, h) ((4 + (b) * 2 + (h)) * HTB)
#define PG8_STAGE(bufoff, gbase, voff) do { _Pragma("unroll") for (int _i = 0; _i < 2; ++_i) \
        __builtin_amdgcn_global_load_lds((const unsigned*)((const char*)(gbase) + (voff)[_i]), (PG8_LAS unsigned*)(lds + (bufoff) + ldsw + _i * 8192), 16, 0, 0); } while (0)
#define PG8_LDA(dst, b, h) do { _Pragma("unroll") for (int m = 0; m < 4; ++m) _Pragma("unroll") for (int k = 0; k < 2; ++k) dst[m][k] = *(const PG8_LAS bf16x8*)(lds + PG8_SA(b, h) + aoff + m * 2048 + k * 1024); } while (0)
#define PG8_LDB(dst, b, h) do { _Pragma("unroll") for (int n = 0; n < 2; ++n) _Pragma("unroll") for (int k = 0; k < 2; ++k) dst[n][k] = *(const PG8_LAS bf16x8*)(lds + PG8_SB(b, h) + boff + n * 2048 + k * 1024); } while (0)
#define PG8_MMA(ai, bj, At, Bt) do { __builtin_amdgcn_s_setprio(1); _Pragma("unroll") for (int m = 0; m < 4; ++m) _Pragma("unroll") for (int n = 0; n < 2; ++n) _Pragma("unroll") for (int k = 0; k < 2; ++k) \
        acc[ai][bj][m][n] = __builtin_amdgcn_mfma_f32_16x16x32_bf16(Bt[n][k], At[m][k], acc[ai][bj][m][n], 0, 0, 0); __builtin_amdgcn_s_setprio(0); } while (0)
#define PG8_WAIT_V(n) asm volatile("s_waitcnt vmcnt(" #n ")" ::: "memory")
#define PG8_WAIT_L(n) asm volatile("s_waitcnt lgkmcnt(" #n ")" ::: "memory")
#define PG8_BAR __builtin_amdgcn_s_barrier()
#define PG8_SCHED __builtin_amdgcn_sched_barrier(0)
    Unit cur, nxt; int ui = 0;
    if (!S.next(0, cur)) return;
    f32x4 acc[2][2][4][2];
#pragma unroll
    for (int a = 0; a < 2; ++a)
#pragma unroll
        for (int b = 0; b < 2; ++b)
#pragma unroll
            for (int m = 0; m < 4; ++m)
#pragma unroll
                for (int n = 0; n < 2; ++n) acc[a][b][m][n] = (f32x4){0.f, 0.f, 0.f, 0.f};
    bf16x8 At[4][2], B0[2][2], B1[2][2];
    const char* cA = (const char*)g.A + (size_t)cur.pm * tstepA; const char* cA2 = (const char*)g.A2 + (size_t)cur.pm * tstepA; const char* cB = (const char*)g.Bt + (size_t)cur.pn * tstep;
    S.a_ready(cur);
    if constexpr (SP2) {
        PG8_STAGE(PG8_SB(0, 0), cB, voffB); PG8_STAGE(PG8_SB(0, 1), cB + hstep, voffB); PG8_STAGE(PG8_SA(0, 0), cA, voffA); PG8_STAGE(PG8_SA(0, 1), cA + hstepA, voffA);
        if (wr == 1) PG8_BAR;
        PG8_WAIT_V(2); PG8_BAR;
        PG8_STAGE(PG8_SB(1, 0), cB + kstep, voffB); PG8_STAGE(PG8_SA(1, 0), cA + kstep, voffA); PG8_STAGE(PG8_SB(1, 1), cB + hstep + kstep, voffB);
        PG8_WAIT_V(6); PG8_BAR;
    } else {
        PG8_STAGE(PG8_SB(0, 0), cB, voffB); PG8_STAGE(PG8_SA(0, 0), cA, voffA); PG8_STAGE(PG8_SB(0, 1), cB + hstep, voffB); PG8_STAGE(PG8_SA(0, 1), cA + hstepA, voffA);
        if (wr == 1) PG8_BAR;
        PG8_WAIT_V(4); PG8_BAR;
        PG8_STAGE(PG8_SB(1, 0), cB + kstep, voffB); PG8_STAGE(PG8_SA(1, 0), cA + kstep, voffA); PG8_STAGE(PG8_SB(1, 1), cB + hstep + kstep, voffB);
        PG8_WAIT_V(6); PG8_BAR;
    }
    for (;;) {
        const bool has_next = S.next(ui + 1, nxt);
        const char* nA = has_next ? (const char*)g.A + (size_t)nxt.pm * tstepA : cA; const char* nA2 = has_next ? (const char*)g.A2 + (size_t)nxt.pm * tstepA : cA2; const char* nB = has_next ? (const char*)g.Bt + (size_t)nxt.pn * tstep : cB;
        for (int t = 0; t < nt; t += 2) {
            const bool last = (t == nt - 2);
            const char* a1 = PG8_AP(cA, cA2, t + 1);
            const char* a2 = last ? nA : PG8_AP(cA, cA2, t + 2); const char* b2 = last ? nB : cB + (size_t)(t + 2) * kstep;
            const char* a3 = last ? nA + kstep : PG8_AP(cA, cA2, t + 3); const char* b3 = b2 + kstep;
            if (last && has_next) S.a_ready(nxt);
            if constexpr (SP2) {
            PG8_LDB(B0, 0, 0); PG8_LDB(B1, 0, 1); PG8_SCHED; PG8_LDA(At, 0, 0); PG8_STAGE(PG8_SA(1, 1), a1 + hstepA, voffA);
            PG8_WAIT_V(8); PG8_WAIT_L(0); PG8_BAR; PG8_MMA(0, 0, At, B0); PG8_MMA(0, 1, At, B1); PG8_BAR; PG8_SCHED;
            PG8_LDA(At, 0, 1); PG8_STAGE(PG8_SB(0, 0), b2, voffB); PG8_STAGE(PG8_SB(0, 1), b2 + hstep, voffB); PG8_STAGE(PG8_SA(0, 0), a2, voffA);
            PG8_WAIT_V(8); PG8_WAIT_L(0); PG8_BAR; PG8_MMA(1, 0, At, B0); PG8_MMA(1, 1, At, B1); PG8_BAR; PG8_SCHED;
            PG8_LDB(B0, 1, 0); PG8_LDB(B1, 1, 1); PG8_SCHED; PG8_LDA(At, 1, 0); PG8_STAGE(PG8_SA(0, 1), a2 + hstepA, voffA);
            PG8_WAIT_V(8); PG8_WAIT_L(0); PG8_BAR; PG8_MMA(0, 0, At, B0); PG8_MMA(0, 1, At, B1); PG8_BAR; PG8_SCHED;
            PG8_LDA(At, 1, 1); PG8_STAGE(PG8_SB(1, 0), b3, voffB); PG8_STAGE(PG8_SB(1, 1), b3 + hstep, voffB); PG8_STAGE(PG8_SA(1, 0), a3, voffA);
            PG8_WAIT_V(8); PG8_WAIT_L(0); PG8_BAR; PG8_MMA(1, 0, At, B0); PG8_MMA(1, 1, At, B1); PG8_BAR; PG8_SCHED;
            } else {
            PG8_LDB(B0, 0, 0); PG8_SCHED; PG8_LDA(At, 0, 0); PG8_STAGE(PG8_SA(1, 1), a1 + hstepA, voffA);
            PG8_WAIT_L(8); PG8_BAR; PG8_WAIT_L(0); PG8_MMA(0, 0, At, B0); PG8_BAR; PG8_SCHED;
            PG8_LDB(B1, 0, 1); PG8_STAGE(PG8_SB(0, 0), b2, voffB);
            PG8_BAR; PG8_WAIT_L(0); PG8_MMA(0, 1, At, B1); PG8_BAR;
            PG8_LDA(At, 0, 1); PG8_STAGE(PG8_SA(0, 0), a2, voffA);
            PG8_BAR; PG8_WAIT_L(0); PG8_MMA(1, 0, At, B0); PG8_BAR; PG8_SCHED;
            PG8_STAGE(PG8_SB(0, 1), b2 + hstep, voffB);
            PG8_WAIT_V(6); PG8_BAR; PG8_MMA(1, 1, At, B1); PG8_BAR;
            PG8_LDB(B0, 1, 0); PG8_SCHED; PG8_LDA(At, 1, 0); PG8_STAGE(PG8_SA(0, 1), a2 + hstepA, voffA);
            PG8_WAIT_L(8); PG8_BAR; PG8_WAIT_L(0); PG8_MMA(0, 0, At, B0); PG8_BAR; PG8_SCHED;
            PG8_LDB(B1, 1, 1); PG8_STAGE(PG8_SB(1, 0), b3, voffB);
            PG8_BAR; PG8_WAIT_L(0); PG8_MMA(0, 1, At, B1); PG8_BAR;
            PG8_LDA(At, 1, 1); PG8_STAGE(PG8_SA(1, 0), a3, voffA);
            PG8_BAR; PG8_WAIT_L(0); PG8_MMA(1, 0, At, B0); PG8_BAR; PG8_SCHED;
            PG8_STAGE(PG8_SB(1, 1), b3 + hstep, voffB);
            PG8_WAIT_V(6); PG8_BAR; PG8_MMA(1, 1, At, B1); PG8_BAR;
            }
        }
        if constexpr (ALIGN_EPI) { if (wr == 0) PG8_BAR; }
        if constexpr (!Epi::AFTER_DRAIN) { E(acc, cur, wr, wc, fr, fq); S.done(cur); }
        if (!has_next) break;
#pragma unroll
        for (int a = 0; a < 2; ++a)
#pragma unroll
            for (int b = 0; b < 2; ++b)
#pragma unroll
                for (int m = 0; m < 4; ++m)
#pragma unroll
                    for (int n = 0; n < 2; ++n) acc[a][b][m][n] = (f32x4){0.f, 0.f, 0.f, 0.f};
        cur = nxt; cA = nA; cA2 = nA2; cB = nB; ++ui;
        if constexpr (ALIGN_EPI) { if (wr == 1) PG8_BAR; }
    }
    PG8_WAIT_V(0);
    if constexpr (!ALIGN_EPI) { if (wr == 0) PG8_BAR; }
    PG8_BAR;
    if constexpr (Epi::AFTER_DRAIN) { E.fused(acc, cur, wr, wc, fr, fq, lds, wid, lane); S.done(cur); }
#undef PG8_AP
#undef PG8_SA
#undef PG8_SB
#undef PG8_STAGE
#undef PG8_LDA
#undef PG8_LDB
#undef PG8_MMA
#undef PG8_WAIT_V
#undef PG8_WAIT_L
#undef PG8_BAR
#undef PG8_SCHED
}
}
constexpr int NWAVES = 8, NTHREADS = 512;
constexpr int D = 1024, BATCH = 16, SEQ = 2048, MTOK = BATCH * SEQ, DIN = 9224, NPROJ = 9216, DMIX = 2048;
constexpr int MH = 4, MHD = 256, AH = 8, AVD = 128, AQK = 64, MCH = 64;
constexpr int C_MQ = 0, C_MK = 1024, C_MV = 2048, C_MO = 3072, C_MZ = 4096, C_MI = 5120, C_MF = 5124, C_AQ = 5128, C_AK = 6152, C_AV = 7176, C_AZ = 8200;
constexpr float EPS = 1e-6f, LOG2E = 1.4426950408889634f;
constexpr float QSCALE = 0.125f * LOG2E;
constexpr size_t MiB = 1u << 20;
constexpr size_t WS_CTL = 0;
constexpr size_t WS_MOD = 1 * MiB;
constexpr size_t WS_LI = 2 * MiB;
constexpr size_t WS_LF = 2 * MiB + 512 * 1024;
constexpr size_t WS_RSS = 4 * MiB;
constexpr size_t WS_WIN = 8 * MiB;
constexpr size_t WS_WOUT = 26 * MiB;
constexpr size_t WS_HB = 32 * MiB;
constexpr size_t WS_MV = 96 * MiB;
constexpr size_t WS_GM = 160 * MiB;
constexpr size_t WS_AQ = 224 * MiB;
constexpr size_t WS_AK = 288 * MiB;
constexpr size_t WS_AV = 352 * MiB;
constexpr size_t WS_AZ = 416 * MiB;
constexpr size_t WS_END = 480 * MiB;
constexpr int CW_QUEUE = 64;
constexpr int LDS_BYTES = 155648;

#define LAS __attribute__((address_space(3)))
typedef unsigned short bf16;
typedef float f32x4 __attribute__((ext_vector_type(4)));
typedef float f32x16 __attribute__((ext_vector_type(16)));
typedef float f32x2 __attribute__((ext_vector_type(2)));
typedef short bf16x8 __attribute__((ext_vector_type(8)));
typedef short s16x4 __attribute__((ext_vector_type(4)));
typedef unsigned u32x4 __attribute__((ext_vector_type(4)));
typedef unsigned u32x2 __attribute__((ext_vector_type(2)));
typedef __bf16 bf16x2_t __attribute__((ext_vector_type(2)));

__device__ __forceinline__ unsigned pk2(float lo, float hi) { f32x2 v = {lo, hi}; bf16x2_t b = __builtin_convertvector(v, bf16x2_t); return __builtin_bit_cast(unsigned, b); }
__device__ __forceinline__ float bflo(unsigned u) { return __uint_as_float(u << 16); }
__device__ __forceinline__ float bfhi(unsigned u) { return __uint_as_float(u & 0xffff0000u); }
__device__ __forceinline__ float siluf(float x) { return x / (1.f + __expf(-x)); }
__device__ __forceinline__ float sigmf(float x) { return 1.f / (1.f + __expf(-x)); }
__device__ __forceinline__ float wave_sum(float v) {
#pragma unroll
    for (int o = 1; o < 64; o <<= 1) v += __shfl_xor(v, o);
    return v;
}

struct Args { const float* in[19]; float* out; unsigned char* ws; int ph_lo, ph_hi; };
typedef const __attribute__((address_space(4))) Args* KArgs;
__device__ __forceinline__ KArgs kargs() { KArgs p = (KArgs)__builtin_amdgcn_kernarg_segment_ptr(); asm volatile("" : "+s"(p)); return p; }

__device__ __forceinline__ int win_src_col(int n) {
    if (n < 3072) return n;
    if (n < 5120) { const int g = (n - 3072) >> 8, r = (n - 3072) & 255; return (r < 128) ? C_MO + 128 * g + r : C_MZ + 128 * g + (r - 128); }
    return n + 8;
}
__device__ __forceinline__ void p0_transpose_item(const float* W, int ldw, int K, bf16* WT, int k0, int n0, int sc0, LAS float* scr, int lane) {
#pragma unroll 8
    for (int i = 0; i < 32; ++i) { const int kk = 2 * i + (lane >> 5); scr[kk * 33 + (lane & 31)] = W[(size_t)(k0 + kk) * ldw + sc0 + (lane & 31)]; }
    asm volatile("s_waitcnt lgkmcnt(0)" ::: "memory");
    const int c = lane & 7;
#pragma unroll
    for (int j = 0; j < 4; ++j) { const int n = (lane >> 3) + 8 * j; const LAS float* s = scr + (8 * c) * 33 + n;
        u32x4 o; o.x = pk2(s[0 * 33], s[1 * 33]); o.y = pk2(s[2 * 33], s[3 * 33]); o.z = pk2(s[4 * 33], s[5 * 33]); o.w = pk2(s[6 * 33], s[7 * 33]);
        *(u32x4*)(WT + (size_t)(n0 + n) * K + k0 + 8 * c) = o; }
    asm volatile("s_waitcnt lgkmcnt(0)" ::: "memory");
}
__device__ __forceinline__ void phase0(KArgs a, LAS unsigned char* lds, int vcu, int G) {
    const int tid = threadIdx.x, lane = tid & 63, wave = __builtin_amdgcn_readfirstlane(tid >> 6);
    const float* c = a->in[1]; const float* w_ada = a->in[3]; const float* b_ada = a->in[4];
    float* mod = (float*)(a->ws + WS_MOD);
    if (blockIdx.x == 0 && tid == 0) ((unsigned*)(a->ws + WS_CTL))[CW_QUEUE] = 0u;
    for (int cgp = vcu; cgp < 256; cgp += G) {
        const int b = tid >> 5, part = tid & 31, j0 = 12 * cgp;
        float acc[12];
#pragma unroll
        for (int j = 0; j < 12; ++j) acc[j] = 0.f;
        for (int ii = 0; ii < 32; ++ii) { const int i = part + 32 * ii;
            const float s = c[b * 1024 + i]; const float sv = s / (1.f + expf(-s));
            const f32x4* wr = (const f32x4*)(w_ada + (size_t)i * 3072 + j0);
            const f32x4 w0 = wr[0], w1 = wr[1], w2 = wr[2];
            acc[0] += sv * w0[0]; acc[1] += sv * w0[1]; acc[2] += sv * w0[2]; acc[3] += sv * w0[3];
            acc[4] += sv * w1[0]; acc[5] += sv * w1[1]; acc[6] += sv * w1[2]; acc[7] += sv * w1[3];
            acc[8] += sv * w2[0]; acc[9] += sv * w2[1]; acc[10] += sv * w2[2]; acc[11] += sv * w2[3]; }
#pragma unroll
        for (int j = 0; j < 12; ++j) { float v = acc[j];
            v += __shfl_xor(v, 1); v += __shfl_xor(v, 2); v += __shfl_xor(v, 4); v += __shfl_xor(v, 8); v += __shfl_xor(v, 16);
            if (part == 0) mod[b * 3072 + j0 + j] = v + b_ada[j0 + j]; }
    }
    LAS float* scr = (LAS float*)(lds + wave * 16384);
    const int gw = vcu * NWAVES + wave, NGW = G * NWAVES;
    constexpr int I_IN = (1024 / 64) * (NPROJ / 32), I_OUT = (2048 / 64) * (1024 / 32);
    bf16* WinT = (bf16*)(a->ws + WS_WIN); bf16* WoutT = (bf16*)(a->ws + WS_WOUT);
    for (int it = gw; it < I_IN + I_OUT; it += NGW) {
        if (it < I_IN) { const int nb = it % (NPROJ / 32), kb = it / (NPROJ / 32); p0_transpose_item(a->in[5], DIN, 1024, WinT, 64 * kb, 32 * nb, win_src_col(32 * nb), scr, lane); }
        else { const int r = it - I_IN, nb = r % 32, kb = r / 32; p0_transpose_item(a->in[17], 1024, 2048, WoutT, 64 * kb, 32 * nb, 32 * nb, scr, lane); }
    }
}

__device__ __forceinline__ void phase1(KArgs a, LAS unsigned char* lds, int vcu, int G) {
    const int tid = threadIdx.x, lane = tid & 63, wave = __builtin_amdgcn_readfirstlane(tid >> 6);
    const float* x = a->in[0]; const float* norm_w = a->in[2]; const float* w_in = a->in[5]; const float* b_i = a->in[6]; const float* b_f = a->in[7];
    const float* mod = (const float*)(a->ws + WS_MOD);
    bf16* HB = (bf16*)(a->ws + WS_HB); float* LI = (float*)(a->ws + WS_LI); float* LF = (float*)(a->ws + WS_LF);
    LAS float* wg = (LAS float*)lds;
    for (int i = tid; i < 1024 * 8; i += NTHREADS) wg[i] = w_in[(size_t)(i >> 3) * DIN + C_MI + (i & 7)];
    __syncthreads();
    const int gw = vcu * NWAVES + wave, NGW = G * NWAVES;
    for (int grp = gw; grp < MTOK / 16; grp += NGW) {
        const int row0 = grp * 16, b = row0 / SEQ;
        f32x4 am[4], sh[4];
#pragma unroll
        for (int j = 0; j < 4; ++j) { const int col = 4 * lane + 256 * j;
            const f32x4 nw = *(const f32x4*)(norm_w + col), sc = *(const f32x4*)(mod + b * 3072 + 1024 + col);
            am[j] = nw * (sc + 1.0f); sh[j] = *(const f32x4*)(mod + b * 3072 + col); }
        for (int r = 0; r < 16; ++r) { const int row = row0 + r;
            LAS float* wgr = wg; asm volatile("" : "+v"(wgr));
            const f32x4* xr = (const f32x4*)(x + (size_t)row * D) + lane;
            f32x4 v[4]; float s = 0.f;
#pragma unroll
            for (int j = 0; j < 4; ++j) { v[j] = xr[64 * j]; s += (v[j][0] * v[j][0] + v[j][1] * v[j][1]) + (v[j][2] * v[j][2] + v[j][3] * v[j][3]); }
            const float rstd = 1.0f / sqrtf(wave_sum(s) * (1.f / D) + EPS);
            float g8[8];
#pragma unroll
            for (int q = 0; q < 8; ++q) g8[q] = 0.f;
            u32x2* o8 = (u32x2*)(HB + (size_t)row * D) + lane;
#pragma unroll
            for (int j = 0; j < 4; ++j) { const f32x4 hv = v[j] * rstd * am[j] + sh[j];
                u32x2 w; w.x = pk2(hv[0], hv[1]); w.y = pk2(hv[2], hv[3]); o8[64 * j] = w;
#pragma unroll
                for (int e = 0; e < 4; ++e) { const int k = 4 * lane + 256 * j + e;
                    const f32x4 w0 = *(const LAS f32x4*)(wgr + k * 8), w1 = *(const LAS f32x4*)(wgr + k * 8 + 4);
                    g8[0] += hv[e] * w0[0]; g8[1] += hv[e] * w0[1]; g8[2] += hv[e] * w0[2]; g8[3] += hv[e] * w0[3];
                    g8[4] += hv[e] * w1[0]; g8[5] += hv[e] * w1[1]; g8[6] += hv[e] * w1[2]; g8[7] += hv[e] * w1[3]; } }
#pragma unroll
            for (int q = 0; q < 8; ++q) g8[q] = wave_sum(g8[q]);
#pragma unroll
            for (int q = 0; q < 4; ++q) {
                if (lane == q) LI[(size_t)row * 4 + q] = g8[q] + b_i[q];
                if (lane == 4 + q) { const float xf = g8[4 + q] + b_f[q]; LF[(size_t)row * 4 + q] = fminf(xf, 0.f) - log1pf(expf(-fabsf(xf))); } }
        }
    }
}

struct EpiProj {
    static constexpr bool PERM = true, AFTER_DRAIN = false;
    bf16 *MQ, *MK, *MV, *GM, *AQ, *AK, *AV, *AZ;
    __device__ __forceinline__ void operator()(const pg8::f32x4 (&acc)[2][2][4][2], const pg8::Unit& u, int wr, int wc, int fr, int fq) const {
        const int pn = u.pn; const int row0 = u.pm * 256 + wr * 64 + fr;
        if (pn >= 12 && pn < 20) {
            const int col = 128 * (pn - 12) + wc * 32 + 8 * fq;
#pragma unroll
            for (int ai = 0; ai < 2; ++ai)
#pragma unroll
                for (int m = 0; m < 4; ++m) { bf16* p = GM + (size_t)(row0 + ai * 128 + m * 16) * 1024 + col;
                    float g[8];
#pragma unroll
                    for (int n = 0; n < 2; ++n)
#pragma unroll
                        for (int e = 0; e < 4; ++e) { const float o = acc[ai][0][m][n][e], z = acc[ai][1][m][n][e]; g[4 * n + e] = sigmf(o) * siluf(z); }
                    u32x4 w; w.x = pk2(g[0], g[1]); w.y = pk2(g[2], g[3]); w.z = pk2(g[4], g[5]); w.w = pk2(g[6], g[7]);
                    *(u32x4*)p = w; }
            return;
        }
        bf16* base; float sc = 1.f; int act = 0; int ct;
        if (pn < 4) { base = MQ; ct = pn; } else if (pn < 8) { base = MK; ct = pn - 4; } else if (pn < 12) { base = MV; ct = pn - 8; }
        else if (pn < 24) { base = AQ; ct = pn - 20; sc = QSCALE; } else if (pn < 28) { base = AK; ct = pn - 24; } else if (pn < 32) { base = AV; ct = pn - 28; }
        else { base = AZ; ct = pn - 32; act = 1; }
        const int col0 = ct * 256 + wc * 32 + 8 * fq;
#pragma unroll
        for (int ai = 0; ai < 2; ++ai)
#pragma unroll
            for (int m = 0; m < 4; ++m) { bf16* rowp = base + (size_t)(row0 + ai * 128 + m * 16) * 1024 + col0;
#pragma unroll
                for (int bj = 0; bj < 2; ++bj) { pg8::f32x4 v0 = acc[ai][bj][m][0], v1 = acc[ai][bj][m][1];
                    if (act) { v0 = (pg8::f32x4){siluf(v0[0]), siluf(v0[1]), siluf(v0[2]), siluf(v0[3])}; v1 = (pg8::f32x4){siluf(v1[0]), siluf(v1[1]), siluf(v1[2]), siluf(v1[3])}; }
                    v0 = v0 * sc; v1 = v1 * sc;
                    u32x4 w; w.x = pk2(v0[0], v0[1]); w.y = pk2(v0[2], v0[3]); w.z = pk2(v1[0], v1[1]); w.w = pk2(v1[2], v1[3]);
                    *(u32x4*)(rowp + bj * 128) = w; } }
    }
};
struct EpiOut {
    static constexpr bool PERM = false, AFTER_DRAIN = false;
    const float* x; const float* mod; float* out; float* rss;
    __device__ __forceinline__ void operator()(const pg8::f32x4 (&acc)[2][2][4][2], const pg8::Unit& u, int wr, int wc, int fr, int fq) const {
        const int col0 = u.pn * 256 + wc * 32 + 4 * fq; const int b = (u.pm * 256) / SEQ;
        pg8::f32x4 gv[2][2];
#pragma unroll
        for (int bj = 0; bj < 2; ++bj)
#pragma unroll
            for (int n = 0; n < 2; ++n) gv[bj][n] = *(const pg8::f32x4*)(mod + b * 3072 + 2048 + col0 + bj * 128 + n * 16);
#pragma unroll
        for (int ai = 0; ai < 2; ++ai)
#pragma unroll
            for (int m = 0; m < 4; ++m) { const int row = u.pm * 256 + ai * 128 + wr * 64 + m * 16 + fr; const size_t off = (size_t)row * D + col0; float ss = 0.f;
#pragma unroll
                for (int bj = 0; bj < 2; ++bj)
#pragma unroll
                    for (int n = 0; n < 2; ++n) { const pg8::f32x4 xv = *(const pg8::f32x4*)(x + off + bj * 128 + n * 16);
                        const pg8::f32x4 o = xv + gv[bj][n] * acc[ai][bj][m][n];
                        ss += (o[0] * o[0] + o[1] * o[1]) + (o[2] * o[2] + o[3] * o[3]);
                        *(pg8::f32x4*)(out + off + bj * 128 + n * 16) = o; }
                ss += __shfl_xor(ss, 16); ss += __shfl_xor(ss, 32);
                if (fq == 0) rss[(size_t)row * 16 + u.pn * 4 + wc] = ss; }
    }
};

__device__ __forceinline__ void phase5(KArgs a, int vcu, int G) {
    const int tid = threadIdx.x, lane = tid & 63, wave = __builtin_amdgcn_readfirstlane(tid >> 6);
    const float* fnw = a->in[18]; const float* rss = (const float*)(a->ws + WS_RSS); float* out = a->out;
    f32x4 fw[4];
#pragma unroll
    for (int j = 0; j < 4; ++j) fw[j] = *(const f32x4*)(fnw + 4 * lane + 256 * j);
    const int gw = vcu * NWAVES + wave, NGW = G * NWAVES;
    for (int grp = gw; grp < MTOK / 16; grp += NGW)
        for (int r = 0; r < 16; ++r) { const int row = grp * 16 + r;
            const f32x4* pr = (const f32x4*)(rss + (size_t)row * 16);
            const f32x4 p0 = pr[0], p1 = pr[1], p2 = pr[2], p3 = pr[3];
            const float tot = (((p0[0] + p0[1]) + (p0[2] + p0[3])) + ((p1[0] + p1[1]) + (p1[2] + p1[3]))) + (((p2[0] + p2[1]) + (p2[2] + p2[3])) + ((p3[0] + p3[1]) + (p3[2] + p3[3])));
            const float rstd = 1.0f / sqrtf(tot * (1.f / D) + EPS);
            f32x4* o = (f32x4*)(out + (size_t)row * D) + lane;
#pragma unroll
            for (int j = 0; j < 4; ++j) o[64 * j] = o[64 * j] * rstd * fw[j]; }
}
__device__ __forceinline__ int crow(int r, int hi) { return (r & 3) + 8 * (r >> 2) + 4 * hi; }
typedef short v4i16_t __attribute__((ext_vector_type(4)));
__device__ __forceinline__ s16x4 ldtr(const LAS unsigned char* p) { return __builtin_bit_cast(s16x4, __builtin_amdgcn_ds_read_tr16_b64_v4i16((LAS v4i16_t*)p)); }
__device__ __forceinline__ bf16x8 ldfrag(const LAS unsigned char* p) { return *(const LAS bf16x8*)p; }
__device__ __forceinline__ float halfswap_max(float m) { auto rr = __builtin_amdgcn_permlane32_swap(__float_as_uint(m), __float_as_uint(m), false, false); return fmaxf(__uint_as_float(rr[0]), __uint_as_float(rr[1])); }
__device__ __forceinline__ float halfswap_sum(float m) { auto rr = __builtin_amdgcn_permlane32_swap(__float_as_uint(m), __float_as_uint(m), false, false); return __uint_as_float(rr[0]) + __uint_as_float(rr[1]); }
__device__ __forceinline__ bf16x8 pack8(const f32x16& p, int base) {
    u32x4 w; w.x = pk2(p[base + 0], p[base + 1]); w.y = pk2(p[base + 2], p[base + 3]); w.z = pk2(p[base + 4], p[base + 5]); w.w = pk2(p[base + 6], p[base + 7]);
    return __builtin_bit_cast(bf16x8, w);
}
__device__ __forceinline__ int t5_bucket(int n) {
    if (n < 16) return n;
    int bkt = 16;
    bkt += (n >= 19); bkt += (n >= 21); bkt += (n >= 24); bkt += (n >= 27); bkt += (n >= 31); bkt += (n >= 35); bkt += (n >= 40); bkt += (n >= 46);
    bkt += (n >= 52); bkt += (n >= 59); bkt += (n >= 67); bkt += (n >= 77); bkt += (n >= 87); bkt += (n >= 99); bkt += (n >= 113);
    return bkt;
}

namespace att {
constexpr int L_RING = 0;
constexpr int L_TB = 65536;
constexpr int L_WSF = L_TB + 512;
constexpr int L_STAGE = L_WSF + 2048;
constexpr int SROW = 132;
constexpr float THR = 8.0f;

__device__ __forceinline__ void attn_unit(KArgs a, LAS unsigned char* lds, int b, int h, int qb, float lam) {
    int tid_ = threadIdx.x; asm volatile("" : "+v"(tid_));
    const int tid = tid_, lane = tid & 63, r32 = lane & 31, hi = lane >> 5, wave = __builtin_amdgcn_readfirstlane(tid >> 6);
    const int rb = wave & 3, mp = wave >> 2;
    bf16* AQ = (bf16*)(a->ws + WS_AQ); const bf16* AK = (const bf16*)(a->ws + WS_AK); const bf16* AV = (const bf16*)(a->ws + WS_AV); const bf16* AZ = (const bf16*)(a->ws + WS_AZ);
    const float* relb = a->in[16]; const float* anw = a->in[15];
    const size_t rowbase = (size_t)b * SEQ; const int q0 = qb * 128;
    const int qmin = q0 + 32 * rb, qrow = qmin + r32;
    LAS float* tb = (LAS float*)(lds + L_TB); LAS float* wsf = (LAS float*)(lds + L_WSF) + wave * 64; LAS float* stage = (LAS float*)(lds + L_STAGE);
    bf16x8 qf[4];
#pragma unroll
    for (int ks = 0; ks < 4; ++ks) qf[ks] = *(const bf16x8*)(AQ + (rowbase + qrow) * 1024 + h * 128 + mp * 64 + ks * 16 + hi * 8);
    if (tid < 128) tb[tid] = (tid < 113) ? (relb[t5_bucket(tid) * AH + h] - relb[31 * AH + h]) * LOG2E : 0.f;
    const int lc = tid & 15, lkv = tid >> 4;
    const bf16* kg = AK + (rowbase + lkv) * 1024 + h * 128 + lc * 8;
    const bf16* vg = AV + (rowbase + lkv) * 1024 + h * 128 + lc * 8;
    const int kofs0 = lc * 1024 + ((lkv ^ lc) * 16), kofs1 = lc * 1024 + (((lkv + 32) ^ lc) * 16);
    const int vofs0 = 16384 + (lc >> 2) * 4096 + (lkv >> 4) * 1024 + (lkv & 15) * 64 + (lc & 3) * 16, vofs1 = vofs0 + 2048;
    const int NT = 2 * qb + 2;
    u32x4 kr0, kr1, vr0, vr1;
    kr0 = *(const u32x4*)kg; kr1 = *(const u32x4*)(kg + 32 * 1024); vr0 = *(const u32x4*)vg; vr1 = *(const u32x4*)(vg + 32 * 1024);
    *(LAS u32x4*)(lds + L_RING + kofs0) = kr0; *(LAS u32x4*)(lds + L_RING + kofs1) = kr1; *(LAS u32x4*)(lds + L_RING + vofs0) = vr0; *(LAS u32x4*)(lds + L_RING + vofs1) = vr1;
    __syncthreads();
    f32x16 o[4];
#pragma unroll
    for (int e = 0; e < 4; ++e)
#pragma unroll
        for (int r = 0; r < 16; ++r) o[e][r] = 0.f;
    float mref = 0.f, lsum = 0.f;
    const int vlane = ((lane >> 4) & 1) * 32 + (lane & 3) * 8 + (4 * hi + ((lane & 15) >> 2)) * 64;
    for (int j = 0; j < NT; ++j) {
        const bool more = (j + 1 < NT);
        if (more) { const size_t go = (size_t)(j + 1) * 64 * 1024; kr0 = *(const u32x4*)(kg + go); kr1 = *(const u32x4*)(kg + go + 32 * 1024); vr0 = *(const u32x4*)(vg + go); vr1 = *(const u32x4*)(vg + go + 32 * 1024); }
        const int kv0 = 64 * j;
        if (kv0 <= qmin + 31) {
            const LAS unsigned char* kb = lds + L_RING + (j & 1) * 32768; const LAS unsigned char* vb = kb + 16384 + vlane;
            f32x16 s0, s1;
#pragma unroll
            for (int r = 0; r < 16; ++r) { s0[r] = 0.f; s1[r] = 0.f; }
#pragma unroll
            for (int ks = 0; ks < 4; ++ks) { const int cgi = mp * 8 + 2 * ks + hi;
                const bf16x8 a0 = ldfrag(kb + cgi * 1024 + ((r32 ^ cgi) * 16)), a1 = ldfrag(kb + cgi * 1024 + (((r32 + 32) ^ cgi) * 16));
                s0 = __builtin_amdgcn_mfma_f32_32x32x16_bf16(a0, qf[ks], s0, 0, 0, 0);
                s1 = __builtin_amdgcn_mfma_f32_32x32x16_bf16(a1, qf[ks], s1, 0, 0, 0); }
            if (qmin - (kv0 + 63) < 113) {
#pragma unroll
                for (int r = 0; r < 16; ++r) { const int d0 = qrow - (kv0 + crow(r, hi)); const int i0 = min(max(d0, 0), 127), i1 = min(max(d0 - 32, 0), 127);
                    s0[r] += tb[i0]; s1[r] += tb[i1]; }
            }
            if (kv0 + 63 > qmin) {
#pragma unroll
                for (int r = 0; r < 16; ++r) { const int kv = kv0 + crow(r, hi); if (kv > qrow) s0[r] = -INFINITY; if (kv + 32 > qrow) s1[r] = -INFINITY; }
            }
            float rm = fmaxf(s0[0], s1[0]);
#pragma unroll
            for (int r = 1; r < 16; ++r) rm = fmaxf(rm, fmaxf(s0[r], s1[r]));
            rm = halfswap_max(rm);
            if (j == 0) { mref = rm; }
            else if (__any(rm - mref > THR)) {
                const float mnew = fmaxf(mref, rm); const float f = __builtin_amdgcn_exp2f(mref - mnew); mref = mnew; lsum *= f;
                if (hi == 0) wsf[r32] = f;
#pragma unroll
                for (int r = 0; r < 16; ++r) { const float fr_ = wsf[crow(r, hi)];
#pragma unroll
                    for (int e = 0; e < 4; ++e) o[e][r] *= fr_; }
            }
            float ps = 0.f;
#pragma unroll
            for (int r = 0; r < 16; ++r) { s0[r] = __builtin_amdgcn_exp2f(s0[r] - mref); s1[r] = __builtin_amdgcn_exp2f(s1[r] - mref); ps += s0[r] + s1[r]; }
            lsum += ps;
            const bf16x8 pa0 = pack8(s0, 0), pa1 = pack8(s0, 8), pa2 = pack8(s1, 0), pa3 = pack8(s1, 8);
#pragma unroll
            for (int e = 0; e < 4; ++e) {
                s16x4 lo[4], hh[4];
#pragma unroll
                for (int ks = 0; ks < 4; ++ks) { lo[ks] = ldtr(vb + e * 4096 + ks * 1024); hh[ks] = ldtr(vb + e * 4096 + ks * 1024 + 512); }
#define ATT_VF(k) (bf16x8){lo[k][0], lo[k][1], lo[k][2], lo[k][3], hh[k][0], hh[k][1], hh[k][2], hh[k][3]}
                o[e] = __builtin_amdgcn_mfma_f32_32x32x16_bf16(pa0, ATT_VF(0), o[e], 0, 0, 0);
                o[e] = __builtin_amdgcn_mfma_f32_32x32x16_bf16(pa1, ATT_VF(1), o[e], 0, 0, 0);
                o[e] = __builtin_amdgcn_mfma_f32_32x32x16_bf16(pa2, ATT_VF(2), o[e], 0, 0, 0);
                o[e] = __builtin_amdgcn_mfma_f32_32x32x16_bf16(pa3, ATT_VF(3), o[e], 0, 0, 0);
#undef ATT_VF
            }
        }
        if (more) { LAS unsigned char* nb = lds + L_RING + ((j + 1) & 1) * 32768;
            *(LAS u32x4*)(nb + kofs0) = kr0; *(LAS u32x4*)(nb + kofs1) = kr1; *(LAS u32x4*)(nb + vofs0) = vr0; *(LAS u32x4*)(nb + vofs1) = vr1; }
        __syncthreads();
    }
    const float ltot = halfswap_sum(lsum);
    const float sc = (mp == 0 ? 1.0f : -lam) / ltot;
    if (hi == 0) wsf[r32] = sc;
    float scr[16];
#pragma unroll
    for (int r = 0; r < 16; ++r) scr[r] = wsf[crow(r, hi)];
    if (mp == 0) {
#pragma unroll
        for (int e = 0; e < 4; ++e)
#pragma unroll
            for (int r = 0; r < 16; ++r) stage[(32 * rb + crow(r, hi)) * SROW + 32 * e + r32] = o[e][r] * scr[r];
    }
    __syncthreads();
    if (mp == 1) {
#pragma unroll
        for (int e = 0; e < 4; ++e)
#pragma unroll
            for (int r = 0; r < 16; ++r) stage[(32 * rb + crow(r, hi)) * SROW + 32 * e + r32] += o[e][r] * scr[r];
    }
    __syncthreads();
    { const int row = tid >> 2, part = tid & 3;
      const LAS f32x4* sp = (const LAS f32x4*)(stage + row * SROW + 32 * part);
      f32x4 v[8]; float ss = 0.f;
#pragma unroll
      for (int i = 0; i < 8; ++i) { v[i] = sp[i]; ss += (v[i][0] * v[i][0] + v[i][1] * v[i][1]) + (v[i][2] * v[i][2] + v[i][3] * v[i][3]); }
      ss += __shfl_xor(ss, 1); ss += __shfl_xor(ss, 2);
      const float rs = 0.8f / sqrtf(ss * (1.f / 128.f) + EPS);
      const size_t go = (rowbase + q0 + row) * 1024 + h * 128 + 32 * part;
      const u32x4* zp = (const u32x4*)(AZ + go); u32x4* op = (u32x4*)(AQ + go); const f32x4* wp = (const f32x4*)(anw + 32 * part);
#pragma unroll
      for (int i = 0; i < 4; ++i) { const u32x4 z = zp[i]; const f32x4 w0 = wp[2 * i], w1 = wp[2 * i + 1]; const f32x4 x0 = v[2 * i] * rs * w0, x1 = v[2 * i + 1] * rs * w1;
          u32x4 w; w.x = pk2(x0[0] * bflo(z.x), x0[1] * bfhi(z.x)); w.y = pk2(x0[2] * bflo(z.y), x0[3] * bfhi(z.y));
          w.z = pk2(x1[0] * bflo(z.z), x1[1] * bfhi(z.z)); w.w = pk2(x1[2] * bflo(z.w), x1[3] * bfhi(z.w)); op[i] = w; } }
    __syncthreads();
}
}

namespace mls {
constexpr int L_Q = 0;
constexpr int L_K = 32768;
constexpr int L_STAGE = 0;
constexpr int L_KW = 66560;
constexpr int L_V = L_KW + 32768;
constexpr int L_P = L_V + 32768;
constexpr int L_SC = L_P + 8192;
constexpr int L_N = L_SC + 18 * 256;
constexpr int L_CW = L_N + 1024;
constexpr int L_END = L_CW + 8192;
static_assert(L_END <= LDS_BYTES, "mLSTM LDS map");
constexpr int SROW = 260;

__device__ __forceinline__ void mlstm_unit(KArgs a, LAS unsigned char* lds, int b, int h) {
    int tid_ = threadIdx.x; asm volatile("" : "+v"(tid_));
    const int tid = tid_, lane = tid & 63, r32 = lane & 31, hi = lane >> 5, wave = __builtin_amdgcn_readfirstlane(tid >> 6);
    const bf16* MQ = (const bf16*)a->out; const bf16* MK = (const bf16*)a->out + (size_t)MTOK * 1024; const bf16* MV = (const bf16*)(a->ws + WS_MV); const bf16* GM = (const bf16*)(a->ws + WS_GM);
    bf16* HM = (bf16*)(a->ws + WS_HB);
    const float* LI = (const float*)(a->ws + WS_LI); const float* LF = (const float*)(a->ws + WS_LF);
    const float* cqw = a->in[8]; const float* ckw = a->in[9]; const float* mnw = a->in[10];
    LAS float* S_psum = (LAS float*)(lds + L_SC) + 768; LAS float* S_qn = S_psum + 256;
    LAS float* nperm = (LAS float*)(lds + L_N); LAS float* cw = (LAS float*)(lds + L_CW); LAS float* stage = (LAS float*)(lds + L_STAGE);
    f32x16 X[8];
#pragma unroll
    for (int i = 0; i < 8; ++i)
#pragma unroll
        for (int r = 0; r < 16; ++r) X[i][r] = 0.f;
    if (tid < 256) nperm[tid] = 0.f;
    for (int i = tid; i < 2048; i += NTHREADS) { const int j = (i >> 8) & 3, d = i & 255; cw[i] = (i < 1024 ? cqw : ckw)[j * 1024 + h * 256 + d]; }
    float m_prev = 0.f;
    const int g6 = tid & 63, d0 = 4 * g6;
    const int qch = 2 * (g6 >> 2) + (g6 & 1), qbo = 8 * ((g6 >> 1) & 1);
    for (int c = 0; c < SEQ / MCH; ++c) {
        const size_t row0 = (size_t)b * SEQ + 64 * c;
        LAS float* S_alpha = (LAS float*)(lds + L_SC) + (c & 1) * 384; LAS float* S_beta = S_alpha + 64; LAS float* S_iw = S_alpha + 128; LAS float* S_clamp = S_alpha + 192; LAS float* S_ws = S_alpha + 256; LAS float* S_misc = S_alpha + 320;
        if (wave == 0) {
            const float lf = LF[(row0 + lane) * 4 + h], li = LI[(row0 + lane) * 4 + h];
            float bt = lf;
#pragma unroll
            for (int o = 1; o < 64; o <<= 1) { const float u = __shfl_up(bt, o); if (lane >= o) bt += u; }
            const float beta = li - bt; float cm = beta;
#pragma unroll
            for (int o = 1; o < 64; o <<= 1) { const float u = __shfl_up(cm, o); if (lane >= o) cm = fmaxf(cm, u); }
            const float mx = fmaxf(cm, m_prev);
            S_alpha[lane] = -mx; S_beta[lane] = beta; S_iw[lane] = expf(m_prev - mx); S_clamp[lane] = expf(-(bt + mx));
            const float cmL = __shfl(cm, 63), bL = __shfl(bt, 63); const float mxL = fmaxf(m_prev, cmL);
            S_ws[lane] = expf(beta - mxL);
            if (lane == 0) S_misc[0] = expf(m_prev - mxL);
            m_prev = bL + mxL;
        }
        __syncthreads();
#pragma unroll 1
        for (int rd = 0; rd < 2; ++rd) {
            const int t0 = 32 * rd + 4 * wave;
            u32x2 rq[7], rk[7], rv[4];
            {
              const size_t ub = ((size_t)b * SEQ + 64 * c + t0) * 1024 + h * 256;
              const bf16* qb_ = MQ + ub - 3 * 1024; const bf16* kb_ = MK + ub - 3 * 1024; const bf16* vb_ = MV + ub;
              const int t_first = 64 * c + t0 - 3;
#pragma unroll
              for (int i = 0; i < 7; ++i) {
                  if (t_first + i >= 0) { rq[i] = *(const u32x2*)(qb_ + (i * 1024 + d0)); rk[i] = *(const u32x2*)(kb_ + (i * 1024 + d0)); }
                  else { rq[i] = (u32x2){0u, 0u}; rk[i] = (u32x2){0u, 0u}; } }
#pragma unroll
              for (int i = 0; i < 4; ++i) rv[i] = *(const u32x2*)(vb_ + (i * 1024 + d0)); }
            { float qv[4][4];
#pragma unroll
              for (int t = 0; t < 4; ++t)
#pragma unroll
                  for (int e = 0; e < 4; ++e) qv[t][e] = 0.f;
#pragma unroll
              for (int j = 0; j < 4; ++j) { const f32x4 wq = *(const LAS f32x4*)(cw + j * 256 + d0);
#pragma unroll
                  for (int t = 0; t < 4; ++t) { const u32x2 uq = rq[t + j];
                      qv[t][0] += wq[0] * bflo(uq.x); qv[t][1] += wq[1] * bfhi(uq.x); qv[t][2] += wq[2] * bflo(uq.y); qv[t][3] += wq[3] * bfhi(uq.y); } }
#pragma unroll
              for (int t = 0; t < 4; ++t) { const int row = t0 + t;
#pragma unroll
                  for (int e = 0; e < 4; ++e) qv[t][e] = siluf(qv[t][e]) * 0.0625f;
                  u32x2 w; w.x = pk2(qv[t][0], qv[t][1]); w.y = pk2(qv[t][2], qv[t][3]); *(LAS u32x2*)(lds + L_Q + row * 512 + ((qch ^ (row & 15)) * 16) + qbo) = w; } }
            __builtin_amdgcn_sched_barrier(0);
            float kv[4][4];
#pragma unroll
            for (int t = 0; t < 4; ++t)
#pragma unroll
                for (int e = 0; e < 4; ++e) kv[t][e] = 0.f;
#pragma unroll
            for (int j = 0; j < 4; ++j) { const f32x4 wk = *(const LAS f32x4*)(cw + 1024 + j * 256 + d0);
#pragma unroll
                for (int t = 0; t < 4; ++t) { const u32x2 uk = rk[t + j];
                    kv[t][0] += wk[0] * bflo(uk.x); kv[t][1] += wk[1] * bfhi(uk.x); kv[t][2] += wk[2] * bflo(uk.y); kv[t][3] += wk[3] * bfhi(uk.y); } }
#pragma unroll
            for (int t = 0; t < 4; ++t) { const int row = t0 + t; const float wsr = S_ws[row];
#pragma unroll
                for (int e = 0; e < 4; ++e) kv[t][e] = siluf(kv[t][e]);
                u32x2 w; w.x = pk2(kv[t][0], kv[t][1]); w.y = pk2(kv[t][2], kv[t][3]); *(LAS u32x2*)(lds + L_K + row * 512 + ((qch ^ (row & 15)) * 16) + qbo) = w;
#pragma unroll
                for (int e = 0; e < 4; ++e) kv[t][e] *= wsr; }
            const int cs = t0 >> 3, bs = (t0 & 7) * 2;
#pragma unroll
            for (int e = 0; e < 4; ++e) { const int d = d0 + e; const int ro = d * 128 + ((cs ^ ((d >> 1) & 7)) * 16) + bs;
                u32x2 w; w.x = pk2(kv[0][e], kv[1][e]); w.y = pk2(kv[2][e], kv[3][e]); *(LAS u32x2*)(lds + L_KW + ro) = w;
                const unsigned sh = (e & 1) * 16;
                const unsigned v0 = ((e < 2 ? rv[0].x : rv[0].y) >> sh) & 0xffffu, v1 = ((e < 2 ? rv[1].x : rv[1].y) >> sh) & 0xffffu, v2 = ((e < 2 ? rv[2].x : rv[2].y) >> sh) & 0xffffu, v3 = ((e < 2 ? rv[3].x : rv[3].y) >> sh) & 0xffffu;
                u32x2 wv; wv.x = v0 | (v1 << 16); wv.y = v2 | (v3 << 16); *(LAS u32x2*)(lds + L_V + ro) = wv; }
        }
        __syncthreads();
        f32x16 num[2];
        {
            int lo_ = lane; asm volatile("" : "+v"(lo_));
            const int l15 = lo_ & 15, kq = lo_ >> 4, r32a = lo_ & 31, hia = lo_ >> 5;
            const int si = wave >> 1, ti0 = 2 * (wave & 1);
            f32x4 sa[2] = {(f32x4){0.f, 0.f, 0.f, 0.f}, (f32x4){0.f, 0.f, 0.f, 0.f}};
            { const int y = kq ^ l15; const int rowoff = l15 * 512;
              int b4[4];
#pragma unroll
              for (int j = 0; j < 4; ++j) b4[j] = rowoff + (((4 * j) ^ y) * 16);
              const LAS unsigned char* kbase = lds + L_K + si * 8192; const LAS unsigned char* qbase = lds + L_Q + ti0 * 8192;
#pragma unroll
              for (int kk = 0; kk < 8; ++kk) { const int o_ = b4[kk & 3] + (kk >> 2) * 256;
                  const bf16x8 ka = ldfrag(kbase + o_);
                  const bf16x8 q0_ = ldfrag(qbase + o_), q1_ = ldfrag(qbase + 8192 + o_);
                  sa[0] = __builtin_amdgcn_mfma_f32_16x16x32_bf16(ka, q0_, sa[0], 0, 0, 0);
                  sa[1] = __builtin_amdgcn_mfma_f32_16x16x32_bf16(ka, q1_, sa[1], 0, 0, 0); } }
#pragma unroll
            for (int u = 0; u < 2; ++u) { const int ti = ti0 + u, t = 16 * ti + l15, s_ = 16 * si + 4 * kq;
                const float al = S_alpha[t]; const f32x4 bt4 = *(const LAS f32x4*)(S_beta + s_); float pv_[4]; float psum = 0.f;
#pragma unroll
                for (int r = 0; r < 4; ++r) { pv_[r] = (s_ + r <= t) ? sa[u][r] * __expf(al + bt4[r]) : 0.f; psum += pv_[r]; }
                psum += __shfl_xor(psum, 16); psum += __shfl_xor(psum, 32);
                if (kq == 0) S_psum[si * 64 + t] = psum;
                u32x2 w; w.x = pk2(pv_[0], pv_[1]); w.y = pk2(pv_[2], pv_[3]);
                const int cp = 2 * si + (kq >> 1);
                *(LAS u32x2*)(lds + L_P + t * 128 + ((cp ^ ((t >> 1) & 7)) * 16) + 8 * (kq & 1)) = w; }
#pragma unroll
            for (int r = 0; r < 16; ++r) { num[0][r] = 0.f; num[1][r] = 0.f; }
            { const int yq = hia ^ (r32a & 15); const int rowoff = r32a * 512;
              int b8[8];
#pragma unroll
              for (int g = 0; g < 8; ++g) b8[g] = rowoff + (((2 * g) ^ yq) * 16);
              const LAS unsigned char* qbase = lds + L_Q;
#pragma unroll
              for (int dt = 0; dt < 8; ++dt) { __builtin_amdgcn_sched_barrier(0);
#pragma unroll
                  for (int sp = 0; sp < 2; ++sp) { const bf16x8 xb = pack8(X[dt], 8 * sp); const int G_ = 2 * dt + sp; const int o_ = b8[G_ & 7] + (G_ >> 3) * 256;
                      const bf16x8 qa0 = ldfrag(qbase + o_), qa1 = ldfrag(qbase + 16384 + o_);
                      num[0] = __builtin_amdgcn_mfma_f32_32x32x16_bf16(qa0, xb, num[0], 0, 0, 0);
                      num[1] = __builtin_amdgcn_mfma_f32_32x32x16_bf16(qa1, xb, num[1], 0, 0, 0); } } }
            __builtin_amdgcn_sched_barrier(0);
            { int to_ = tid; asm volatile("" : "+v"(to_));
              const int t = to_ >> 3, part = to_ & 7; float accn = 0.f;
#pragma unroll
              for (int i = 0; i < 4; ++i) { const int ch = 4 * part + i; const u32x4 qq = *(const LAS u32x4*)(lds + L_Q + t * 512 + ((ch ^ (t & 15)) * 16));
                  const f32x4 n0 = *(const LAS f32x4*)(nperm + 8 * ch), n1 = *(const LAS f32x4*)(nperm + 8 * ch + 4);
                  accn += bflo(qq.x) * n0[0] + bfhi(qq.x) * n0[1] + bflo(qq.y) * n0[2] + bfhi(qq.y) * n0[3] + bflo(qq.z) * n1[0] + bfhi(qq.z) * n1[1] + bflo(qq.w) * n1[2] + bfhi(qq.w) * n1[3]; }
              accn += __shfl_xor(accn, 1); accn += __shfl_xor(accn, 2); accn += __shfl_xor(accn, 4);
              if (part == 0) S_qn[t] = accn; }
        }
        __syncthreads();
        {
            int lo_ = lane; asm volatile("" : "+v"(lo_));
            const int r32a = lo_ & 31, hia = lo_ >> 5;
            const int e = 32 * wave + r32a;
            const int yk = hia ^ ((r32a >> 1) & 7); const int rowoff = r32a * 128;
            int b4[4];
#pragma unroll
            for (int ks = 0; ks < 4; ++ks) b4[ks] = rowoff + (((2 * ks) ^ yk) * 16);
            bf16x8 vf[4];
#pragma unroll
            for (int ks = 0; ks < 4; ++ks) vf[ks] = ldfrag(lds + L_V + wave * 4096 + b4[ks]);
#pragma unroll
            for (int tt = 0; tt < 2; ++tt) {
#pragma unroll
                for (int g = 0; g < 4; ++g) { const f32x4 iw4 = *(const LAS f32x4*)(S_iw + 32 * tt + 8 * g + 4 * hia);
#pragma unroll
                    for (int q = 0; q < 4; ++q) num[tt][4 * g + q] *= iw4[q]; }
#pragma unroll
                for (int ks = 0; ks < 4; ++ks) { const bf16x8 pa = ldfrag(lds + L_P + tt * 4096 + b4[ks]);
                    num[tt] = __builtin_amdgcn_mfma_f32_32x32x16_bf16(pa, vf[ks], num[tt], 0, 0, 0); }
#pragma unroll
                for (int r = 0; r < 16; ++r) stage[(32 * tt + crow(r, hia)) * SROW + e] = num[tt][r];
            }
            const float decay = S_misc[0];
#pragma unroll
            for (int dt = 0; dt < 8; ++dt) { __builtin_amdgcn_sched_barrier(0);
#pragma unroll
                for (int r = 0; r < 16; ++r) X[dt][r] *= decay;
#pragma unroll
                for (int ks = 0; ks < 4; ++ks) { const bf16x8 ka = ldfrag(lds + L_KW + dt * 4096 + b4[ks]);
                    X[dt] = __builtin_amdgcn_mfma_f32_32x32x16_bf16(ka, vf[ks], X[dt], 0, 0, 0); } }
            __builtin_amdgcn_sched_barrier(0);
            int to_ = tid; asm volatile("" : "+v"(to_));
            if (to_ < 256) { const int d = to_; float s = 0.f;
#pragma unroll
                for (int i = 0; i < 8; ++i) { const u32x4 kk = *(const LAS u32x4*)(lds + L_KW + d * 128 + i * 16);
                    s += (bflo(kk.x) + bfhi(kk.x)) + (bflo(kk.y) + bfhi(kk.y)) + (bflo(kk.z) + bfhi(kk.z)) + (bflo(kk.w) + bfhi(kk.w)); }
                const int p = (d & ~12) | ((d & 4) << 1) | ((d & 8) >> 1);
                nperm[p] = decay * nperm[p] + s; }
        }
        __syncthreads();
        { const int t = tid >> 3, part = tid & 7;
          const float den = S_iw[t] * S_qn[t] + ((S_psum[t] + S_psum[64 + t]) + (S_psum[128 + t] + S_psum[192 + t]));
          const float hd = 1.0f / fmaxf(fabsf(den), S_clamp[t]);
          const LAS f32x4* sp = (const LAS f32x4*)(stage + t * SROW + 32 * part);
          f32x4 v[8]; float s1 = 0.f;
#pragma unroll
          for (int i = 0; i < 8; ++i) { v[i] = sp[i] * hd; s1 += (v[i][0] + v[i][1]) + (v[i][2] + v[i][3]); }
          s1 += __shfl_xor(s1, 1); s1 += __shfl_xor(s1, 2); s1 += __shfl_xor(s1, 4);
          const float mu = s1 * (1.f / 256.f); float s2 = 0.f;
#pragma unroll
          for (int i = 0; i < 8; ++i) { v[i] = v[i] - mu; s2 += (v[i][0] * v[i][0] + v[i][1] * v[i][1]) + (v[i][2] * v[i][2] + v[i][3] * v[i][3]); }
          s2 += __shfl_xor(s2, 1); s2 += __shfl_xor(s2, 2); s2 += __shfl_xor(s2, 4);
          const float rs = 1.0f / sqrtf(s2 * (1.f / 256.f) + EPS);
          const size_t ub = row0 * 1024 + h * 256; const int lo2 = t * 1024 + 32 * part;
          const u32x4* gp = (const u32x4*)(GM + ub + lo2); u32x4* op = (u32x4*)(HM + ub + lo2); const f32x4* wp = (const f32x4*)(mnw + h * 256 + 32 * part);
#pragma unroll
          for (int i = 0; i < 4; ++i) { const u32x4 z = gp[i]; const f32x4 w0 = wp[2 * i], w1 = wp[2 * i + 1]; const f32x4 x0 = v[2 * i] * rs * w0, x1 = v[2 * i + 1] * rs * w1;
              u32x4 w; w.x = pk2(x0[0] * bflo(z.x), x0[1] * bfhi(z.x)); w.y = pk2(x0[2] * bflo(z.y), x0[3] * bfhi(z.y));
              w.z = pk2(x1[0] * bflo(z.z), x1[1] * bfhi(z.z)); w.w = pk2(x1[2] * bflo(z.w), x1[3] * bfhi(z.w)); op[i] = w; } }
    }
    __syncthreads();
}
}

__device__ __forceinline__ void phase3(KArgs a, LAS unsigned char* lds) {
    const int tid = threadIdx.x, lane = tid & 63;
    float s1 = a->in[11][lane] * a->in[12][lane], s2 = a->in[13][lane] * a->in[14][lane];
    s1 = wave_sum(s1); s2 = wave_sum(s2);
    const float lam = __uint_as_float(__builtin_amdgcn_readfirstlane(__float_as_uint(expf(s1) - expf(s2) + 0.2f)));
    unsigned* qhead = (unsigned*)(a->ws + WS_CTL) + CW_QUEUE;
    LAS unsigned* slot = (LAS unsigned*)(lds + LDS_BYTES - 64);
    constexpr unsigned N_M = BATCH * MH, N_A = BATCH * AH * (SEQ / 128);
    for (;;) {
        if (tid == 0) *slot = __hip_atomic_fetch_add(qhead, 1u, __ATOMIC_RELAXED, __HIP_MEMORY_SCOPE_AGENT);
        __syncthreads();
        const unsigned it = *slot;
        __syncthreads();
        if (it >= N_M + N_A) break;
        if (it < N_M) mls::mlstm_unit(a, lds, (int)(it >> 2), (int)(it & 3));
        else { const unsigned i = it - N_M; const int qb = 15 - (int)(i >> 7), bh = (int)(i & 127); att::attn_unit(a, lds, bh >> 3, bh & 7, qb, lam); }
    }
}
template <bool COOP>
__global__ void __launch_bounds__(NTHREADS, 2) fwd(Args args) {
    extern __shared__ __attribute__((aligned(16))) unsigned char lds_raw[];
    LAS unsigned char* lds = (LAS unsigned char*)lds_raw;
    const int G = gridDim.x, bx = blockIdx.x;
    const int vcu = (G % 8 == 0) ? (bx % 8) * (G / 8) + bx / 8 : bx;
    const int lo = args.ph_lo, hi = args.ph_hi;
#define IN(k) (lo <= (k) && (k) < hi)
#define SEAM(k) do { if constexpr (COOP) { if (IN(k) && IN((k) + 1)) cg::this_grid().sync(); } } while (0)
    if (IN(0)) phase0(kargs(), lds, vcu, G);
    SEAM(0);
    if (IN(1)) phase1(kargs(), lds, vcu, G);
    SEAM(1);
    if (IN(2)) {
        const KArgs ka = kargs(); unsigned char* ws_ = ka->ws; float* out_ = ka->out;
        pg8::Gemm g{(const bf16*)(ws_ + WS_HB), (const bf16*)(ws_ + WS_HB), (const bf16*)(ws_ + WS_WIN), MTOK, NPROJ, 1024, 1024, 16};
        pg8::StaticOrder S; S.init(MTOK, NPROJ, G, bx);
        EpiProj E{(bf16*)out_, (bf16*)out_ + (size_t)MTOK * 1024, (bf16*)(ws_ + WS_MV), (bf16*)(ws_ + WS_GM), (bf16*)(ws_ + WS_AQ), (bf16*)(ws_ + WS_AK), (bf16*)(ws_ + WS_AV), (bf16*)(ws_ + WS_AZ)};
        pg8::gemm_phase<EpiProj, pg8::StaticOrder, true, true>(lds, g, S, E);
    }
    SEAM(2);
    if (IN(3)) phase3(kargs(), lds);
    SEAM(3);
    if (IN(4)) {
        const KArgs ka = kargs(); unsigned char* ws_ = ka->ws; float* out_ = ka->out; const float* x_ = ka->in[0];
        pg8::Gemm g{(const bf16*)(ws_ + WS_HB), (const bf16*)(ws_ + WS_AQ), (const bf16*)(ws_ + WS_WOUT), MTOK, D, DMIX, 1024, 16};
        pg8::StaticOrder S; S.init(MTOK, D, G, bx);
        EpiOut E{x_, (const float*)(ws_ + WS_MOD), out_, (float*)(ws_ + WS_RSS)};
        pg8::gemm_phase<EpiOut, pg8::StaticOrder, true, true>(lds, g, S, E);
    }
    SEAM(4);
    if (IN(5)) phase5(kargs(), vcu, G);
#undef IN
#undef SEAM
}

#ifndef MK_MULTI
#define MK_MULTI 0
#endif
extern "C" void kernel_launch(void* const* d_in, const int* in_sizes, int n_in, void* d_out, int out_size, void* d_ws, size_t ws_size, hipStream_t stream) {
    static int grid = 0;
    if (grid == 0) {
        if (n_in != 19 || out_size != MTOK * D || ws_size < WS_END) { fprintf(stderr, "kernel_launch: unexpected shapes (n_in %d, out %d, ws %zu)\n", n_in, out_size, ws_size); grid = -1; return; }
        int dev = 0, cus = 0, per_cu = 0;
        hipGetDevice(&dev); hipDeviceGetAttribute(&cus, hipDeviceAttributeMultiprocessorCount, dev);
        hipFuncSetAttribute((const void*)fwd<true>, hipFuncAttributeMaxDynamicSharedMemorySize, LDS_BYTES);
        hipFuncSetAttribute((const void*)fwd<false>, hipFuncAttributeMaxDynamicSharedMemorySize, LDS_BYTES);
        hipOccupancyMaxActiveBlocksPerMultiprocessor(&per_cu, (const void*)fwd<true>, NTHREADS, LDS_BYTES);
        if (per_cu < 1) { fprintf(stderr, "kernel_launch: occupancy query says %d blocks per CU\n", per_cu); per_cu = 1; }
        (void)hipGetLastError();
        grid = cus * (per_cu > 1 ? 1 : per_cu);
    }
    if (grid < 0) return;
    hipMemsetAsync((char*)d_ws + WS_CTL, 0, 1 * MiB, stream);
    Args a{};
    for (int i = 0; i < 19; ++i) a.in[i] = (const float*)d_in[i];
    a.out = (float*)d_out; a.ws = (unsigned char*)d_ws;
#if MK_MULTI
    for (int ph = 0; ph < 6; ++ph) { a.ph_lo = ph; a.ph_hi = ph + 1; hipLaunchKernelGGL(fwd<false>, dim3(grid), dim3(NTHREADS), LDS_BYTES, stream, a); }
#else
    a.ph_lo = 0; a.ph_hi = 6;
    void* kargs[] = {&a};
    hipError_t e = hipLaunchCooperativeKernel((const void*)fwd<true>, dim3(grid), dim3(NTHREADS), kargs, LDS_BYTES, stream);
    if (e != hipSuccess) fprintf(stderr, "cooperative launch failed: %s (grid %d)\n", hipGetErrorString(e), grid);
#endif
}
```

```cpp
#include <hip/hip_runtime.h>
#include <hip/hip_cooperative_groups.h>
#include <cstdio>
#include <cstdint>
#include <cmath>
namespace cg = cooperative_groups;
namespace pg8 {
#define PG8_LAS __attribute__((address_space(3)))
typedef unsigned short bf16_t;
typedef short bf16x8 __attribute__((ext_vector_type(8)));
typedef float f32x4 __attribute__((ext_vector_type(4)));
typedef unsigned u32x4 __attribute__((ext_vector_type(4)));
constexpr int BM = 256, BK = 64, HALF = 128, HTB = HALF * BK * 2  , STAGE_BYTES = 8 * HTB, NXCD = 8, WGM = 8;

__host__ __device__ __forceinline__ int lds_byte(int r, int c) { const int st = (r >> 4) * 2 + (c >> 5), rr = r & 15, cc = c & 31, ob = rr * 64 + cc * 2; return st * 1024 + (ob ^ (((ob >> 9) & 1) << 5)); }
__host__ __device__ __forceinline__ void stage_rc(int b, int& R, int& C) { const int st = b / 1024, sb = b % 1024, swz = sb ^ (((sb >> 9) & 1) << 5); R = (st >> 1) * 16 + swz / 64; C = (st & 1) * 32 + (swz % 64) / 2; }
__host__ __device__ __forceinline__ int perm32(int rho) { const int n = rho >> 4, i = rho & 15; return 8 * (i >> 2) + 4 * n + (i & 3); }

struct Unit { int pm, pn; };
struct Gemm { const bf16_t* A; const bf16_t* A2; const bf16_t* Bt; int M, N, K, lda, nt1; };

struct StaticOrder {
    int nM, nN, nwg, G, c;
    __host__ __device__ void init(int M, int N, int G_, int c_) { nM = M / BM; nN = N / BM; nwg = nM * nN; G = G_; c = c_; }
    __host__ __device__ bool next(int i, Unit& u) const {
        const long L = (long)i * G + c; if (L >= nwg) return false;
        int wgid = (int)L; { const int q = nwg / NXCD, r = nwg % NXCD, xcd = wgid % NXCD, off = wgid / NXCD; wgid = (xcd < r ? xcd * (q + 1) : r * (q + 1) + (xcd - r) * q) + off; }
        const int nig = WGM * nN, gid = wgid / nig, fm = gid * WGM, gsz = (nM - fm) < WGM ? (nM - fm) : WGM;
        u.pm = fm + ((wgid % nig) % gsz); u.pn = (wgid % nig) / gsz; return true;
    }
    __device__ __forceinline__ void a_ready(const Unit&) const {}
    __device__ __forceinline__ void done(const Unit&) const {}
};

__device__ __forceinline__ unsigned cvt_pk_bf16(float lo, float hi) { unsigned r; asm volatile("v_cvt_pk_bf16_f32 %0, %1, %2" : "=v"(r) : "v"(lo), "v"(hi)); return r; }
template <class Epi, class Sched, bool ALIGN_EPI = false, bool SP2 = false>
__device__ __forceinline__ void gemm_phase(PG8_LAS unsigned char* lds, const Gemm g, const Sched& S, const Epi& E) {
    const int tid = threadIdx.x, wid = __builtin_amdgcn_readfirstlane(tid >> 6), lane = tid & 63, wr = wid >> 2, wc = wid & 3, fr = lane & 15, fq = lane >> 4;
    const int K = g.K, nt = K / BK;
    unsigned voffA[2], voffB[2];
#pragma unroll
    for (int i = 0; i < 2; ++i) { int R, C; stage_rc(tid * 16 + i * 8192, R, C); const int Rb = Epi::PERM ? ((R & ~31) + perm32(R & 31)) : R;
        voffA[i] = (unsigned)(R * g.lda + C) * 2u; voffB[i] = (unsigned)(Rb * K + C) * 2u; }
    const size_t kstep = (size_t)(BK * 2);
    const size_t hstep = (size_t)HALF * K * 2;
    const size_t tstep = 2 * hstep;
    const size_t hstepA = (size_t)HALF * g.lda * 2, tstepA = 2 * hstepA; const int nt1 = g.nt1;
#define PG8_AP(b1, b2, t) ((t) < nt1 ? (b1) + (size_t)(t) * kstep : (b2) + (size_t)((t) - nt1) * kstep)
    const unsigned ldsw = (unsigned)wid * 1024u;
    const int aoff = lds_byte(wr * 64 + fr, fq * 8), boff = lds_byte(wc * 32 + fr, fq * 8);
#define PG8_SA(b, h) (((b) * 2 + (h)) * HTB)
#define PG8_SB(b, h) ((4 + (b) * 2 + (h)) * HTB)
#define PG8_STAGE(bufoff, gbase, voff) do { _Pragma("unroll") for (int _i = 0; _i < 2; ++_i) \
        __builtin_amdgcn_global_load_lds((const unsigned*)((const char*)(gbase) + (voff)[_i]), (PG8_LAS unsigned*)(lds + (bufoff) + ldsw + _i * 8192), 16, 0, 0); } while (0)
#define PG8_LDA(dst, b, h) do { _Pragma("unroll") for (int m = 0; m < 4; ++m) _Pragma("unroll") for (int k = 0; k < 2; ++k) dst[m][k] = *(const PG8_LAS bf16x8*)(lds + PG8_SA(b, h) + aoff + m * 2048 + k * 1024); } while (0)
#define PG8_LDB(dst, b, h) do { _Pragma("unroll") for (int n = 0; n < 2; ++n) _Pragma("unroll") for (int k = 0; k < 2; ++k) dst[n][k] = *(const PG8_LAS bf16x8*)(lds + PG8_SB(b, h) + boff + n * 2048 + k * 1024); } while (0)
#define PG8_MMA(ai, bj, At, Bt) do { __builtin_amdgcn_s_setprio(1); _Pragma("unroll") for (int m = 0; m < 4; ++m) _Pragma("unroll") for (int n = 0; n < 2; ++n) _Pragma("unroll") for (int k = 0; k < 2; ++k) \
        acc[ai][bj][m][n] = __builtin_amdgcn_mfma_f32_16x16x32_bf16(Bt[n][k], At[m][k], acc[ai][bj][m][n], 0, 0, 0); __builtin_amdgcn_s_setprio(0); } while (0)
#define PG8_WAIT_V(n) asm volatile("s_waitcnt vmcnt(" #n ")" ::: "memory")
#define PG8_WAIT_L(n) asm volatile("s_waitcnt lgkmcnt(" #n ")" ::: "memory")
#define PG8_BAR __builtin_amdgcn_s_barrier()
#define PG8_SCHED __builtin_amdgcn_sched_barrier(0)
    Unit cur, nxt; int ui = 0;
    if (!S.next(0, cur)) return;
    f32x4 acc[2][2][4][2];
#pragma unroll
    for (int a = 0; a < 2; ++a)
#pragma unroll
        for (int b = 0; b < 2; ++b)
#pragma unroll
            for (int m = 0; m < 4; ++m)
#pragma unroll
                for (int n = 0; n < 2; ++n) acc[a][b][m][n] = (f32x4){0.f, 0.f, 0.f, 0.f};
    bf16x8 At[4][2], B0[2][2], B1[2][2];
    const char* cA = (const char*)g.A + (size_t)cur.pm * tstepA; const char* cA2 = (const char*)g.A2 + (size_t)cur.pm * tstepA; const char* cB = (const char*)g.Bt + (size_t)cur.pn * tstep;
    S.a_ready(cur);
    if constexpr (SP2) {
        PG8_STAGE(PG8_SB(0, 0), cB, voffB); PG8_STAGE(PG8_SB(0, 1), cB + hstep, voffB); PG8_STAGE(PG8_SA(0, 0), cA, voffA); PG8_STAGE(PG8_SA(0, 1), cA + hstepA, voffA);
        if (wr == 1) PG8_BAR;
        PG8_WAIT_V(2); PG8_BAR;
        PG8_STAGE(PG8_SB(1, 0), cB + kstep, voffB); PG8_STAGE(PG8_SA(1, 0), cA + kstep, voffA); PG8_STAGE(PG8_SB(1, 1), cB + hstep + kstep, voffB);
        PG8_WAIT_V(6); PG8_BAR;
    } else {
        PG8_STAGE(PG8_SB(0, 0), cB, voffB); PG8_STAGE(PG8_SA(0, 0), cA, voffA); PG8_STAGE(PG8_SB(0, 1), cB + hstep, voffB); PG8_STAGE(PG8_SA(0, 1), cA + hstepA, voffA);
        if (wr == 1) PG8_BAR;
        PG8_WAIT_V(4); PG8_BAR;
        PG8_STAGE(PG8_SB(1, 0), cB + kstep, voffB); PG8_STAGE(PG8_SA(1, 0), cA + kstep, voffA); PG8_STAGE(PG8_SB(1, 1), cB + hstep + kstep, voffB);
        PG8_WAIT_V(6); PG8_BAR;
    }
    for (;;) {
        const bool has_next = S.next(ui + 1, nxt);
        const char* nA = has_next ? (const char*)g.A + (size_t)nxt.pm * tstepA : cA; const char* nA2 = has_next ? (const char*)g.A2 + (size_t)nxt.pm * tstepA : cA2; const char* nB = has_next ? (const char*)g.Bt + (size_t)nxt.pn * tstep : cB;
        for (int t = 0; t < nt; t += 2) {
            const bool last = (t == nt - 2);
            const char* a1 = PG8_AP(cA, cA2, t + 1);
            const char* a2 = last ? nA : PG8_AP(cA, cA2, t + 2); const char* b2 = last ? nB : cB + (size_t)(t + 2) * kstep;
            const char* a3 = last ? nA + kstep : PG8_AP(cA, cA2, t + 3); const char* b3 = b2 + kstep;
            if (last && has_next) S.a_ready(nxt);
            if constexpr (SP2) {
            PG8_LDB(B0, 0, 0); PG8_LDB(B1, 0, 1); PG8_SCHED; PG8_LDA(At, 0, 0); PG8_STAGE(PG8_SA(1, 1), a1 + hstepA, voffA);
            PG8_WAIT_V(8); PG8_WAIT_L(0); PG8_BAR; PG8_MMA(0, 0, At, B0); PG8_MMA(0, 1, At, B1); PG8_BAR; PG8_SCHED;
            PG8_LDA(At, 0, 1); PG8_STAGE(PG8_SB(0, 0), b2, voffB); PG8_STAGE(PG8_SB(0, 1), b2 + hstep, voffB); PG8_STAGE(PG8_SA(0, 0), a2, voffA);
            PG8_WAIT_V(8); PG8_WAIT_L(0); PG8_BAR; PG8_MMA(1, 0, At, B0); PG8_MMA(1, 1, At, B1); PG8_BAR; PG8_SCHED;
            PG8_LDB(B0, 1, 0); PG8_LDB(B1, 1, 1); PG8_SCHED; PG8_LDA(At, 1, 0); PG8_STAGE(PG8_SA(0, 1), a2 + hstepA, voffA);
            PG8_WAIT_V(8); PG8_WAIT_L(0); PG8_BAR; PG8_MMA(0, 0, At, B0); PG8_MMA(0, 1, At, B1); PG8_BAR; PG8_SCHED;
            PG8_LDA(At, 1, 1); PG8_STAGE(PG8_SB(1, 0), b3, voffB); PG8_STAGE(PG8_SB(1, 1), b3 + hstep, voffB); PG8_STAGE(PG8_SA(1, 0), a3, voffA);
            PG8_WAIT_V(8); PG8_WAIT_L(0); PG8_BAR; PG8_MMA(1, 0, At, B0); PG8_MMA(1, 1, At, B1); PG8_BAR; PG8_SCHED;
            } else {
            PG8_LDB(B0, 0, 0); PG8_SCHED; PG8_LDA(At, 0, 0); PG8_STAGE(PG8_SA(1, 1), a1 + hstepA, voffA);
            PG8_WAIT_L(8); PG8_BAR; PG8_WAIT_L(0); PG8_MMA(0, 0, At, B0); PG8_BAR; PG8_SCHED;
            PG8_LDB(B1, 0, 1); PG8_STAGE(PG8_SB(0, 0), b2, voffB);
            PG8_BAR; PG8_WAIT_L(0); PG8_MMA(0, 1, At, B1); PG8_BAR;
            PG8_LDA(At, 0, 1); PG8_STAGE(PG8_SA(0, 0), a2, voffA);
            PG8_BAR; PG8_WAIT_L(0); PG8_MMA(1, 0, At, B0); PG8_BAR; PG8_SCHED;
            PG8_STAGE(PG8_SB(0, 1), b2 + hstep, voffB);
            PG8_WAIT_V(6); PG8_BAR; PG8_MMA(1, 1, At, B1); PG8_BAR;
            PG8_LDB(B0, 1, 0); PG8_SCHED; PG8_LDA(At, 1, 0); PG8_STAGE(PG8_SA(0, 1), a2 + hstepA, voffA);
            PG8_WAIT_L(8); PG8_BAR; PG8_WAIT_L(0); PG8_MMA(0, 0, At, B0); PG8_BAR; PG8_SCHED;
            PG8_LDB(B1, 1, 1); PG8_STAGE(PG8_SB(1, 0), b3, voffB);
            PG8_BAR; PG8_WAIT_L(0); PG8_MMA(0, 1, At, B1); PG8_BAR;
            PG8_LDA(At, 1, 1); PG8_STAGE(PG8_SA(1, 0), a3, voffA);
            PG8_BAR; PG8_WAIT_L(0); PG8_MMA(1, 0, At, B0); PG8_BAR; PG8_SCHED;
            PG8_STAGE(PG8_SB(1, 1), b3 + hstep, voffB);
            PG8_WAIT_V(6); PG8_BAR; PG8_MMA(1, 1, At, B1); PG8_BAR;
            }
        }
        if constexpr (ALIGN_EPI) { if (wr == 0) PG8_BAR; }
        if constexpr (!Epi::AFTER_DRAIN) { E(acc, cur, wr, wc, fr, fq); S.done(cur); }
        if (!has_next) break;
#pragma unroll
        for (int a = 0; a < 2; ++a)
#pragma unroll
            for (int b = 0; b < 2; ++b)
#pragma unroll
                for (int m = 0; m < 4; ++m)
#pragma unroll
                    for (int n = 0; n < 2; ++n) acc[a][b][m][n] = (f32x4){0.f, 0.f, 0.f, 0.f};
        cur = nxt; cA = nA; cA2 = nA2; cB = nB; ++ui;
        if constexpr (ALIGN_EPI) { if (wr == 1) PG8_BAR; }
    }
    PG8_WAIT_V(0);
    if constexpr (!ALIGN_EPI) { if (wr == 0) PG8_BAR; }
    PG8_BAR;
    if constexpr (Epi::AFTER_DRAIN) { E.fused(acc, cur, wr, wc, fr, fq, lds, wid, lane); S.done(cur); }
#undef PG8_AP
#undef PG8_SA
#undef PG8_SB
#undef PG8_STAGE
#undef PG8_LDA
#undef PG8_LDB
#undef PG8_MMA
#undef PG8_WAIT_V
#undef PG8_WAIT_L
#undef PG8_BAR
#undef PG8_SCHED
}
}
#ifndef REP_P0
#define REP_P0 1
#endif
#ifndef REP_P5
#define REP_P5 1
#endif
#ifndef REP_P1
#define REP_P1 1
#endif
#ifndef REP_P2
#define REP_P2 1
#endif
#ifndef REP_ML
#define REP_ML 1
#endif
#ifndef REP_AT
#define REP_AT 1
#endif
#ifndef REP_P4
#define REP_P4 1
#endif
constexpr int NWAVES = 8, NTHREADS = 512;
constexpr int D = 1024, BATCH = 16, SEQ = 2048, MTOK = BATCH * SEQ, DIN = 9224, NPROJ = 9216, DMIX = 2048;
constexpr int MH = 4, MHD = 256, AH = 8, AVD = 128, AQK = 64, MCH = 64;
constexpr int C_MQ = 0, C_MK = 1024, C_MV = 2048, C_MO = 3072, C_MZ = 4096, C_MI = 5120, C_MF = 5124, C_AQ = 5128, C_AK = 6152, C_AV = 7176, C_AZ = 8200;
constexpr float EPS = 1e-6f, LOG2E = 1.4426950408889634f;
constexpr float QSCALE = 0.125f * LOG2E;
constexpr size_t MiB = 1u << 20;
constexpr size_t WS_CTL = 0;
constexpr size_t WS_MOD = 1 * MiB;
constexpr size_t WS_LI = 2 * MiB;
constexpr size_t WS_LF = 2 * MiB + 512 * 1024;
constexpr size_t WS_RSS = 4 * MiB;
constexpr size_t WS_WIN = 8 * MiB;
constexpr size_t WS_WOUT = 26 * MiB;
constexpr size_t WS_HB = 32 * MiB;
constexpr size_t WS_MV = 96 * MiB;
constexpr size_t WS_GM = 160 * MiB;
constexpr size_t WS_AQ = 224 * MiB;
constexpr size_t WS_AK = 288 * MiB;
constexpr size_t WS_AV = 352 * MiB;
constexpr size_t WS_AZ = 416 * MiB;
constexpr size_t WS_END = 480 * MiB;
constexpr int CW_QUEUE = 64;
constexpr int LDS_BYTES = 155648;

#define LAS __attribute__((address_space(3)))
typedef unsigned short bf16;
typedef float f32x4 __attribute__((ext_vector_type(4)));
typedef float f32x16 __attribute__((ext_vector_type(16)));
typedef float f32x2 __attribute__((ext_vector_type(2)));
typedef short bf16x8 __attribute__((ext_vector_type(8)));
typedef short s16x4 __attribute__((ext_vector_type(4)));
typedef unsigned u32x4 __attribute__((ext_vector_type(4)));
typedef unsigned u32x2 __attribute__((ext_vector_type(2)));
typedef __bf16 bf16x2_t __attribute__((ext_vector_type(2)));

__device__ __forceinline__ unsigned pk2(float lo, float hi) { f32x2 v = {lo, hi}; bf16x2_t b = __builtin_convertvector(v, bf16x2_t); return __builtin_bit_cast(unsigned, b); }
__device__ __forceinline__ float bflo(unsigned u) { return __uint_as_float(u << 16); }
__device__ __forceinline__ float bfhi(unsigned u) { return __uint_as_float(u & 0xffff0000u); }
__device__ __forceinline__ float siluf(float x) { return x * __builtin_amdgcn_rcpf(1.f + __expf(-x)); }
__device__ __forceinline__ float sigmf(float x) { return __builtin_amdgcn_rcpf(1.f + __expf(-x)); }
__device__ __forceinline__ float wave_sum(float v) {
#pragma unroll
    for (int o = 1; o < 64; o <<= 1) v += __shfl_xor(v, o);
    return v;
}

struct Args { const float* in[19]; float* out; unsigned char* ws; int ph_lo, ph_hi; };
typedef const __attribute__((address_space(4))) Args* KArgs;
__device__ __forceinline__ KArgs kargs() { KArgs p = (KArgs)__builtin_amdgcn_kernarg_segment_ptr(); asm volatile("" : "+s"(p)); return p; }

__device__ __forceinline__ int win_src_col(int n) {
    if (n < 3072) return n;
    if (n < 5120) { const int g = (n - 3072) >> 8, r = (n - 3072) & 255; return (r < 128) ? C_MO + 128 * g + r : C_MZ + 128 * g + (r - 128); }
    return n + 8;
}
__device__ __forceinline__ void p0_transpose_item(const float* W, int ldw, int K, bf16* WT, int k0, int n0, int sc0, LAS float* scr, int lane) {
#pragma unroll 8
    for (int i = 0; i < 32; ++i) { const int kk = 2 * i + (lane >> 5); scr[kk * 33 + (lane & 31)] = W[(size_t)(k0 + kk) * ldw + sc0 + (lane & 31)]; }
    asm volatile("s_waitcnt lgkmcnt(0)" ::: "memory");
    const int c = lane & 7;
#pragma unroll
    for (int j = 0; j < 4; ++j) { const int n = (lane >> 3) + 8 * j; const LAS float* s = scr + (8 * c) * 33 + n;
        u32x4 o; o.x = pk2(s[0 * 33], s[1 * 33]); o.y = pk2(s[2 * 33], s[3 * 33]); o.z = pk2(s[4 * 33], s[5 * 33]); o.w = pk2(s[6 * 33], s[7 * 33]);
        *(u32x4*)(WT + (size_t)(n0 + n) * K + k0 + 8 * c) = o; }
    asm volatile("s_waitcnt lgkmcnt(0)" ::: "memory");
}
__device__ __forceinline__ void phase0(KArgs a, LAS unsigned char* lds, int vcu, int G) {
    const int tid = threadIdx.x, lane = tid & 63, wave = __builtin_amdgcn_readfirstlane(tid >> 6);
    const float* c = a->in[1]; const float* w_ada = a->in[3]; const float* b_ada = a->in[4];
    float* mod = (float*)(a->ws + WS_MOD);
    if (blockIdx.x == 0 && tid == 0) ((unsigned*)(a->ws + WS_CTL))[CW_QUEUE] = 0u;
    for (int cgp = vcu; cgp < 256; cgp += G) {
        const int b = tid >> 5, part = tid & 31, j0 = 12 * cgp;
        float acc[12];
#pragma unroll
        for (int j = 0; j < 12; ++j) acc[j] = 0.f;
#pragma unroll 8
        for (int ii = 0; ii < 32; ++ii) { const int i = part + 32 * ii;
            const float s = c[b * 1024 + i]; const float sv = s / (1.f + expf(-s));
            const f32x4* wr = (const f32x4*)(w_ada + (size_t)i * 3072 + j0);
            const f32x4 w0 = wr[0], w1 = wr[1], w2 = wr[2];
            acc[0] += sv * w0[0]; acc[1] += sv * w0[1]; acc[2] += sv * w0[2]; acc[3] += sv * w0[3];
            acc[4] += sv * w1[0]; acc[5] += sv * w1[1]; acc[6] += sv * w1[2]; acc[7] += sv * w1[3];
            acc[8] += sv * w2[0]; acc[9] += sv * w2[1]; acc[10] += sv * w2[2]; acc[11] += sv * w2[3]; }
#pragma unroll
        for (int j = 0; j < 12; ++j) { float v = acc[j];
            v += __shfl_xor(v, 1); v += __shfl_xor(v, 2); v += __shfl_xor(v, 4); v += __shfl_xor(v, 8); v += __shfl_xor(v, 16);
            if (part == 0) mod[b * 3072 + j0 + j] = v + b_ada[j0 + j]; }
    }
}

__device__ __forceinline__ void weight_copies(KArgs a, LAS float* scr, int vcu, int G, int wave, int lane) {
    const int gw = vcu * NWAVES + wave, NGW = G * NWAVES;
    constexpr int I_IN = (1024 / 64) * (NPROJ / 32), I_OUT = (2048 / 64) * (1024 / 32);
    bf16* WinT = (bf16*)(a->ws + WS_WIN); bf16* WoutT = (bf16*)(a->ws + WS_WOUT);
    for (int it = gw; it < I_IN + I_OUT; it += NGW) {
        if (it < I_IN) { const int nb = it % (NPROJ / 32), kb = it / (NPROJ / 32); p0_transpose_item(a->in[5], DIN, 1024, WinT, 64 * kb, 32 * nb, win_src_col(32 * nb), scr, lane); }
        else { const int r = it - I_IN, nb = r % 32, kb = r / 32; p0_transpose_item(a->in[17], 1024, 2048, WoutT, 64 * kb, 32 * nb, 32 * nb, scr, lane); }
    }
}

__device__ __forceinline__ void phase1(KArgs a, LAS unsigned char* lds, int vcu, int G) {
    const int tid = threadIdx.x, lane = tid & 63, wave = __builtin_amdgcn_readfirstlane(tid >> 6);
    const float* x = a->in[0]; const float* norm_w = a->in[2]; const float* w_in = a->in[5]; const float* b_i = a->in[6]; const float* b_f = a->in[7];
    const float* mod = (const float*)(a->ws + WS_MOD);
    bf16* HB = (bf16*)(a->ws + WS_HB); float* LI = (float*)(a->ws + WS_LI); float* LF = (float*)(a->ws + WS_LF);
    LAS float* wg = (LAS float*)lds;
    for (int i = tid; i < 1024 * 8; i += NTHREADS) { const int k = i >> 3, q = i & 7;
        wg[(((((k >> 8) * 4 + (k & 3)) * 2 + (q >> 2)) * 64 + ((k & 255) >> 2)) * 4) + (q & 3)] = w_in[(size_t)k * DIN + C_MI + q]; }
    weight_copies(a, (LAS float*)(lds + 32768 + wave * 8448), vcu, G, wave, lane);
    __syncthreads();
    const int gw = vcu * NWAVES + wave, NGW = G * NWAVES;
    for (int grp = gw; grp < MTOK / 16; grp += NGW) {
        const int row0 = grp * 16, b = row0 / SEQ;
        f32x4 am[4], sh[4];
#pragma unroll
        for (int j = 0; j < 4; ++j) { const int col = 4 * lane + 256 * j;
            const f32x4 nw = *(const f32x4*)(norm_w + col), sc = *(const f32x4*)(mod + b * 3072 + 1024 + col);
            am[j] = nw * (sc + 1.0f); sh[j] = *(const f32x4*)(mod + b * 3072 + col); }
        for (int r = 0; r < 16; ++r) { const int row = row0 + r;
            LAS float* wgr = wg; asm volatile("" : "+v"(wgr));
            const f32x4* xr = (const f32x4*)(x + (size_t)row * D) + lane;
            f32x4 v[4]; float s = 0.f;
#pragma unroll
            for (int j = 0; j < 4; ++j) { v[j] = xr[64 * j]; s += (v[j][0] * v[j][0] + v[j][1] * v[j][1]) + (v[j][2] * v[j][2] + v[j][3] * v[j][3]); }
            const float rstd = 1.0f / sqrtf(wave_sum(s) * (1.f / D) + EPS);
            float g8[8];
#pragma unroll
            for (int q = 0; q < 8; ++q) g8[q] = 0.f;
            u32x2* o8 = (u32x2*)(HB + (size_t)row * D) + lane;
#pragma unroll
            for (int j = 0; j < 4; ++j) { const f32x4 hv = v[j] * rstd * am[j] + sh[j];
                u32x2 w; w.x = pk2(hv[0], hv[1]); w.y = pk2(hv[2], hv[3]); o8[64 * j] = w;
#pragma unroll
                for (int e = 0; e < 4; ++e) {
                    const f32x4 w0 = *(const LAS f32x4*)(wgr + ((((j * 4 + e) * 2 + 0) * 64 + lane) * 4)), w1 = *(const LAS f32x4*)(wgr + ((((j * 4 + e) * 2 + 1) * 64 + lane) * 4));
                    g8[0] += hv[e] * w0[0]; g8[1] += hv[e] * w0[1]; g8[2] += hv[e] * w0[2]; g8[3] += hv[e] * w0[3];
                    g8[4] += hv[e] * w1[0]; g8[5] += hv[e] * w1[1]; g8[6] += hv[e] * w1[2]; g8[7] += hv[e] * w1[3]; } }
#pragma unroll
            for (int q = 0; q < 8; ++q) g8[q] = wave_sum(g8[q]);
#pragma unroll
            for (int q = 0; q < 4; ++q) {
                if (lane == q) LI[(size_t)row * 4 + q] = g8[q] + b_i[q];
                if (lane == 4 + q) { const float xf = g8[4 + q] + b_f[q]; LF[(size_t)row * 4 + q] = fminf(xf, 0.f) - log1pf(expf(-fabsf(xf))); } }
        }
    }
}

struct EpiProj {
    static constexpr bool PERM = true, AFTER_DRAIN = false;
    bf16 *MQ, *MK, *MV, *GM, *AQ, *AK, *AV, *AZ;
    __device__ __forceinline__ void operator()(const pg8::f32x4 (&acc)[2][2][4][2], const pg8::Unit& u, int wr, int wc, int fr, int fq) const {
        const int pn = u.pn; const int row0 = u.pm * 256 + wr * 64 + fr;
        if (pn >= 12 && pn < 20) {
            const int col = 128 * (pn - 12) + wc * 32 + 8 * fq;
#pragma unroll
            for (int ai = 0; ai < 2; ++ai)
#pragma unroll
                for (int m = 0; m < 4; ++m) { bf16* p = GM + (size_t)(row0 + ai * 128 + m * 16) * 1024 + col;
                    float g[8];
#pragma unroll
                    for (int n = 0; n < 2; ++n)
#pragma unroll
                        for (int e = 0; e < 4; ++e) { const float o = acc[ai][0][m][n][e], z = acc[ai][1][m][n][e]; g[4 * n + e] = z * __builtin_amdgcn_rcpf((1.f + __expf(-o)) * (1.f + __expf(-z))); }
                    u32x4 w; w.x = pk2(g[0], g[1]); w.y = pk2(g[2], g[3]); w.z = pk2(g[4], g[5]); w.w = pk2(g[6], g[7]);
                    *(u32x4*)p = w; }
            return;
        }
        bf16* base; float sc = 1.f; int act = 0; int ct;
        if (pn < 4) { base = MQ; ct = pn; } else if (pn < 8) { base = MK; ct = pn - 4; } else if (pn < 12) { base = MV; ct = pn - 8; }
        else if (pn < 24) { base = AQ; ct = pn - 20; sc = QSCALE; } else if (pn < 28) { base = AK; ct = pn - 24; } else if (pn < 32) { base = AV; ct = pn - 28; }
        else { base = AZ; ct = pn - 32; act = 1; }
        const int col0 = ct * 256 + wc * 32 + 8 * fq;
#pragma unroll
        for (int ai = 0; ai < 2; ++ai)
#pragma unroll
            for (int m = 0; m < 4; ++m) { bf16* rowp = base + (size_t)(row0 + ai * 128 + m * 16) * 1024 + col0;
#pragma unroll
                for (int bj = 0; bj < 2; ++bj) { pg8::f32x4 v0 = acc[ai][bj][m][0], v1 = acc[ai][bj][m][1];
                    if (act) { v0 = (pg8::f32x4){siluf(v0[0]), siluf(v0[1]), siluf(v0[2]), siluf(v0[3])}; v1 = (pg8::f32x4){siluf(v1[0]), siluf(v1[1]), siluf(v1[2]), siluf(v1[3])}; }
                    v0 = v0 * sc; v1 = v1 * sc;
                    u32x4 w; w.x = pk2(v0[0], v0[1]); w.y = pk2(v0[2], v0[3]); w.z = pk2(v1[0], v1[1]); w.w = pk2(v1[2], v1[3]);
                    *(u32x4*)(rowp + bj * 128) = w; } }
    }
};
struct EpiOut {
    static constexpr bool PERM = false, AFTER_DRAIN = false;
    const float* x; const float* mod; float* out; float* rss;
    __device__ __forceinline__ void operator()(const pg8::f32x4 (&acc)[2][2][4][2], const pg8::Unit& u, int wr, int wc, int fr, int fq) const {
        const int col0 = u.pn * 256 + wc * 32 + 4 * fq; const int b = (u.pm * 256) / SEQ;
        pg8::f32x4 gv[2][2];
#pragma unroll
        for (int bj = 0; bj < 2; ++bj)
#pragma unroll
            for (int n = 0; n < 2; ++n) gv[bj][n] = *(const pg8::f32x4*)(mod + b * 3072 + 2048 + col0 + bj * 128 + n * 16);
#pragma unroll
        for (int ai = 0; ai < 2; ++ai)
#pragma unroll
            for (int m = 0; m < 4; ++m) { const int row = u.pm * 256 + ai * 128 + wr * 64 + m * 16 + fr; const size_t off = (size_t)row * D + col0; float ss = 0.f;
#pragma unroll
                for (int bj = 0; bj < 2; ++bj)
#pragma unroll
                    for (int n = 0; n < 2; ++n) { const pg8::f32x4 xv = *(const pg8::f32x4*)(x + off + bj * 128 + n * 16);
                        const pg8::f32x4 o = xv + gv[bj][n] * acc[ai][bj][m][n];
                        ss += (o[0] * o[0] + o[1] * o[1]) + (o[2] * o[2] + o[3] * o[3]);
                        *(pg8::f32x4*)(out + off + bj * 128 + n * 16) = o; }
                ss += __shfl_xor(ss, 16); ss += __shfl_xor(ss, 32);
                if (fq == 0) rss[(size_t)row * 16 + u.pn * 4 + wc] = ss; }
    }
};

__device__ __forceinline__ void phase5(KArgs a, int vcu, int G) {
    const int tid = threadIdx.x, lane = tid & 63, wave = __builtin_amdgcn_readfirstlane(tid >> 6);
    const float* fnw = a->in[18]; const float* rss = (const float*)(a->ws + WS_RSS); float* out = a->out;
    f32x4 fw[4];
#pragma unroll
    for (int j = 0; j < 4; ++j) fw[j] = *(const f32x4*)(fnw + 4 * lane + 256 * j);
    const int gw = vcu * NWAVES + wave, NGW = G * NWAVES;
    for (int grp = gw; grp < MTOK / 16; grp += NGW)
        for (int r = 0; r < 16; ++r) { const int row = grp * 16 + r;
            const f32x4* pr = (const f32x4*)(rss + (size_t)row * 16);
            const f32x4 p0 = pr[0], p1 = pr[1], p2 = pr[2], p3 = pr[3];
            const float tot = (((p0[0] + p0[1]) + (p0[2] + p0[3])) + ((p1[0] + p1[1]) + (p1[2] + p1[3]))) + (((p2[0] + p2[1]) + (p2[2] + p2[3])) + ((p3[0] + p3[1]) + (p3[2] + p3[3])));
            const float rstd = 1.0f / sqrtf(tot * (1.f / D) + EPS);
            f32x4* o = (f32x4*)(out + (size_t)row * D) + lane;
#pragma unroll
            for (int j = 0; j < 4; ++j) o[64 * j] = o[64 * j] * rstd * fw[j]; }
}

__device__ __forceinline__ void phase5_touch(KArgs a, int vcu, int G) {
    const int tid = threadIdx.x, lane = tid & 63, wave = __builtin_amdgcn_readfirstlane(tid >> 6);
    const float* rss = (const float*)(a->ws + WS_RSS); float* out = a->out;
    const int gw = vcu * NWAVES + wave, NGW = G * NWAVES;
    for (int grp = gw; grp < MTOK / 16; grp += NGW)
        for (int r = 0; r < 16; ++r) { const int row = grp * 16 + r;
            const f32x4* pr = (const f32x4*)(rss + (size_t)row * 16);
            const f32x4 p0 = pr[0], p1 = pr[1], p2 = pr[2], p3 = pr[3];
            const float tot = (p0[0] + p1[0]) + (p2[0] + p3[0]);
            const float one = (tot == -1.2345f) ? 2.f : 1.f;
            f32x4* o = (f32x4*)(out + (size_t)row * D) + lane;
#pragma unroll
            for (int j = 0; j < 4; ++j) o[64 * j] = o[64 * j] * one; }
}
constexpr int CW_BAR = 4096;
#define XB_TMO      128
#define XB_XCNT(j)  (256  + 64 * (j))
#define XB_XSUB(j)  (1280 + 64 * (j))
#define XB_XGEN(j)  (2304 + 64 * (j))
#define XB_TOP      3328
#define XB_TOPGEN   3392
#define XCD_BAR_WORDS 3456
#define XB_SPIN_CAP (1u << 18)

__device__ __forceinline__ unsigned xb_ld(unsigned* p)              { return __hip_atomic_load(p, __ATOMIC_RELAXED, __HIP_MEMORY_SCOPE_AGENT); }
__device__ __forceinline__ unsigned xb_add(unsigned* p, unsigned v) { return __hip_atomic_fetch_add(p, v, __ATOMIC_RELAXED, __HIP_MEMORY_SCOPE_AGENT); }
__device__ __forceinline__ unsigned xb_xcc_id() { return (unsigned)__builtin_amdgcn_s_getreg((3 << 11) | 20) & 0xFu; }
#define XB_SPIN(cond, bar) do { unsigned _sp = 0; while (cond) { __builtin_amdgcn_s_sleep(1); \
    if ((++_sp & 255u) == 0u) { if (xb_ld(&(bar)[XB_TMO])) break; if (_sp > XB_SPIN_CAP) { atomicAdd(&(bar)[XB_TMO], 1u); break; } } } } while (0)

struct XcdBarrier {
    unsigned* bar; unsigned x;
    volatile LAS unsigned* st;
};

__device__ __forceinline__ XcdBarrier xcd_barrier_post(unsigned* bar, volatile LAS unsigned* st) {
    XcdBarrier b; b.bar = bar; b.x = xb_xcc_id(); b.st = st;
    if (threadIdx.x == 0) (void)xb_add(&bar[XB_XCNT(b.x)], 1u);
    return b;
}
__device__ __forceinline__ void xcd_barrier_complete(unsigned* bar, unsigned x, unsigned& nloc, unsigned& nx) {
    const unsigned G = gridDim.x * gridDim.y * gridDim.z;
    unsigned sum, cnt, mine, sp = 0u;
    for (;;) {
        sum = 0u; cnt = 0u; mine = 0u;
#pragma unroll
        for (unsigned j = 0; j < 16; ++j) { const unsigned c = xb_ld(&bar[XB_XCNT(j)]); sum += c; cnt += (c > 0u) ? 1u : 0u; mine = (j == x) ? c : mine; }
        if (sum == G) break;
        __builtin_amdgcn_s_sleep(1);
        if ((++sp & 255u) == 0u) { if (xb_ld(&bar[XB_TMO])) break; if (sp > XB_SPIN_CAP) { atomicAdd(&bar[XB_TMO], 1u); break; } }
    }
    nloc = mine > 0u ? mine : 1u; nx = cnt > 0u ? cnt : 1u;
}

__device__ __forceinline__ void xcd_barrier(const XcdBarrier& b) {
    asm volatile("s_waitcnt vmcnt(0)" ::: "memory");
    __syncthreads();
    if (threadIdx.x == 0) {
        unsigned* bar = b.bar;
        __builtin_amdgcn_s_waitcnt(0);
        unsigned nloc = b.st[0], nx = b.st[1];
        if (nloc == 0u) { xcd_barrier_complete(bar, b.x, nloc, nx); b.st[0] = nloc; b.st[1] = nx; }
        const unsigned old = xb_add(&bar[XB_XSUB(b.x)], 1u);
        const unsigned gen = old / nloc;
        if (old + 1u == (gen + 1u) * nloc) {
            __builtin_amdgcn_fence(__ATOMIC_RELEASE, "agent");
            asm volatile("s_waitcnt vmcnt(0)" ::: "memory");
            const unsigned og = xb_add(&bar[XB_TOP], 1u);
            const unsigned tg = og / nx;
            if (og + 1u == (tg + 1u) * nx) xb_add(&bar[XB_TOPGEN], 1u);
            else XB_SPIN(xb_ld(&bar[XB_TOPGEN]) == tg, bar);
            __builtin_amdgcn_fence(__ATOMIC_ACQUIRE, "agent");
            xb_add(&bar[XB_XGEN(b.x)], 1u);
            asm volatile("s_waitcnt vmcnt(0)" ::: "memory");
        } else {
            XB_SPIN(xb_ld(&bar[XB_XGEN(b.x)]) == gen, bar);
            __builtin_amdgcn_fence(__ATOMIC_ACQUIRE, "agent");
            asm volatile("s_waitcnt vmcnt(0)" ::: "memory");
        }
    }
    __syncthreads();
}

__device__ __forceinline__ int crow(int r, int hi) { return (r & 3) + 8 * (r >> 2) + 4 * hi; }
typedef short v4i16_t __attribute__((ext_vector_type(4)));
__device__ __forceinline__ s16x4 ldtr(const LAS unsigned char* p) { return __builtin_bit_cast(s16x4, __builtin_amdgcn_ds_read_tr16_b64_v4i16((LAS v4i16_t*)p)); }
__device__ __forceinline__ bf16x8 ldfrag(const LAS unsigned char* p) { return *(const LAS bf16x8*)p; }
__device__ __forceinline__ float halfswap_max(float m) { auto rr = __builtin_amdgcn_permlane32_swap(__float_as_uint(m), __float_as_uint(m), false, false); return fmaxf(__uint_as_float(rr[0]), __uint_as_float(rr[1])); }
__device__ __forceinline__ float halfswap_sum(float m) { auto rr = __builtin_amdgcn_permlane32_swap(__float_as_uint(m), __float_as_uint(m), false, false); return __uint_as_float(rr[0]) + __uint_as_float(rr[1]); }
__device__ __forceinline__ bf16x8 pack8(const f32x16& p, int base) {
    u32x4 w; w.x = pk2(p[base + 0], p[base + 1]); w.y = pk2(p[base + 2], p[base + 3]); w.z = pk2(p[base + 4], p[base + 5]); w.w = pk2(p[base + 6], p[base + 7]);
    return __builtin_bit_cast(bf16x8, w);
}
__device__ __forceinline__ int t5_bucket(int n) {
    if (n < 16) return n;
    int bkt = 16;
    bkt += (n >= 19); bkt += (n >= 21); bkt += (n >= 24); bkt += (n >= 27); bkt += (n >= 31); bkt += (n >= 35); bkt += (n >= 40); bkt += (n >= 46);
    bkt += (n >= 52); bkt += (n >= 59); bkt += (n >= 67); bkt += (n >= 77); bkt += (n >= 87); bkt += (n >= 99); bkt += (n >= 113);
    return bkt;
}

namespace att {
constexpr int L_RING = 0;
constexpr int L_TB = 65536;
constexpr int L_WSF = L_TB + 512;
constexpr int L_STAGE = L_WSF + 2048;
constexpr int SROW = 132;
constexpr float THR = 8.0f;

__device__ __forceinline__ void attn_unit(KArgs a, LAS unsigned char* lds, int b, int h, int qb, float lam, bool dummy = false) {
    int tid_ = threadIdx.x; asm volatile("" : "+v"(tid_));
    const int tid = tid_, lane = tid & 63, r32 = lane & 31, hi = lane >> 5, wave = __builtin_amdgcn_readfirstlane(tid >> 6);
    const int rb = wave & 3, mp = wave >> 2;
    bf16* AQ = (bf16*)(a->ws + WS_AQ); const bf16* AK = (const bf16*)(a->ws + WS_AK); const bf16* AV = (const bf16*)(a->ws + WS_AV); const bf16* AZ = (const bf16*)(a->ws + WS_AZ);
    const float* relb = a->in[16]; const float* anw = a->in[15];
    const size_t rowbase = (size_t)b * SEQ; const int q0 = qb * 128;
    const int qmin = q0 + 32 * rb, qrow = qmin + r32;
    LAS float* tb = (LAS float*)(lds + L_TB); LAS float* wsf = (LAS float*)(lds + L_WSF) + wave * 64; LAS float* stage = (LAS float*)(lds + L_STAGE);
    bf16x8 qf[4];
#pragma unroll
    for (int ks = 0; ks < 4; ++ks) qf[ks] = *(const bf16x8*)(AQ + (rowbase + qrow) * 1024 + h * 128 + mp * 64 + ks * 16 + hi * 8);
    if (tid < 128) tb[tid] = (tid < 113) ? (relb[t5_bucket(tid) * AH + h] - relb[31 * AH + h]) * LOG2E : 0.f;
    const int lc = tid & 15, lkv = tid >> 4;
    const bf16* kg = AK + (rowbase + lkv) * 1024 + h * 128 + lc * 8;
    const bf16* vg = AV + (rowbase + lkv) * 1024 + h * 128 + lc * 8;
    const int kofs0 = lc * 1024 + ((lkv ^ lc) * 16), kofs1 = lc * 1024 + (((lkv + 32) ^ lc) * 16);
    const int vofs0 = 16384 + (lc >> 2) * 4096 + (lkv >> 4) * 1024 + (lkv & 15) * 64 + (lc & 3) * 16, vofs1 = vofs0 + 2048;
    const int NT = 2 * qb + 2;
    u32x4 kr0, kr1, vr0, vr1;
    kr0 = *(const u32x4*)kg; kr1 = *(const u32x4*)(kg + 32 * 1024); vr0 = *(const u32x4*)vg; vr1 = *(const u32x4*)(vg + 32 * 1024);
    *(LAS u32x4*)(lds + L_RING + kofs0) = kr0; *(LAS u32x4*)(lds + L_RING + kofs1) = kr1; *(LAS u32x4*)(lds + L_RING + vofs0) = vr0; *(LAS u32x4*)(lds + L_RING + vofs1) = vr1;
    __syncthreads();
    f32x16 o[4];
#pragma unroll
    for (int e = 0; e < 4; ++e)
#pragma unroll
        for (int r = 0; r < 16; ++r) o[e][r] = 0.f;
    float mref = 0.f, lsum = 0.f;
    const int vlane = ((lane >> 4) & 1) * 32 + (lane & 3) * 8 + (4 * hi + ((lane & 15) >> 2)) * 64;
    for (int j = 0; j < NT; ++j) {
        const bool more = (j + 1 < NT);
        if (more) { const size_t go = (size_t)(j + 1) * 64 * 1024; kr0 = *(const u32x4*)(kg + go); kr1 = *(const u32x4*)(kg + go + 32 * 1024); vr0 = *(const u32x4*)(vg + go); vr1 = *(const u32x4*)(vg + go + 32 * 1024); }
        const int kv0 = 64 * j;
        if (kv0 <= qmin + 31) {
            const LAS unsigned char* kb = lds + L_RING + (j & 1) * 32768; const LAS unsigned char* vb = kb + 16384 + vlane;
            f32x16 s0, s1;
#pragma unroll
            for (int r = 0; r < 16; ++r) { s0[r] = 0.f; s1[r] = 0.f; }
#pragma unroll
            for (int ks = 0; ks < 4; ++ks) { const int cgi = mp * 8 + 2 * ks + hi;
                const bf16x8 a0 = ldfrag(kb + cgi * 1024 + ((r32 ^ cgi) * 16)), a1 = ldfrag(kb + cgi * 1024 + (((r32 + 32) ^ cgi) * 16));
                s0 = __builtin_amdgcn_mfma_f32_32x32x16_bf16(a0, qf[ks], s0, 0, 0, 0);
                s1 = __builtin_amdgcn_mfma_f32_32x32x16_bf16(a1, qf[ks], s1, 0, 0, 0); }
            if (qmin - (kv0 + 63) < 113) {
#pragma unroll
                for (int r = 0; r < 16; ++r) { const int d0 = qrow - (kv0 + crow(r, hi)); const int i0 = min(max(d0, 0), 127), i1 = min(max(d0 - 32, 0), 127);
                    s0[r] += tb[i0]; s1[r] += tb[i1]; }
            }
            if (kv0 + 63 > qmin) {
#pragma unroll
                for (int r = 0; r < 16; ++r) { const int kv = kv0 + crow(r, hi); if (kv > qrow) s0[r] = -INFINITY; if (kv + 32 > qrow) s1[r] = -INFINITY; }
            }
            float rm = fmaxf(s0[0], s1[0]);
#pragma unroll
            for (int r = 1; r < 16; ++r) rm = fmaxf(rm, fmaxf(s0[r], s1[r]));
            rm = halfswap_max(rm);
            if (j == 0) { mref = rm; }
            else if (__any(rm - mref > THR)) {
                const float mnew = fmaxf(mref, rm); const float f = __builtin_amdgcn_exp2f(mref - mnew); mref = mnew; lsum *= f;
                if (hi == 0) wsf[r32] = f;
#pragma unroll
                for (int r = 0; r < 16; ++r) { const float fr_ = wsf[crow(r, hi)];
#pragma unroll
                    for (int e = 0; e < 4; ++e) o[e][r] *= fr_; }
            }
            float ps = 0.f;
#pragma unroll
            for (int r = 0; r < 16; ++r) { s0[r] = __builtin_amdgcn_exp2f(s0[r] - mref); s1[r] = __builtin_amdgcn_exp2f(s1[r] - mref); ps += s0[r] + s1[r]; }
            lsum += ps;
            const bf16x8 pa0 = pack8(s0, 0), pa1 = pack8(s0, 8), pa2 = pack8(s1, 0), pa3 = pack8(s1, 8);
#pragma unroll
            for (int e = 0; e < 4; ++e) {
                s16x4 lo[4], hh[4];
#pragma unroll
                for (int ks = 0; ks < 4; ++ks) { lo[ks] = ldtr(vb + e * 4096 + ks * 1024); hh[ks] = ldtr(vb + e * 4096 + ks * 1024 + 512); }
#define ATT_VF(k) (bf16x8){lo[k][0], lo[k][1], lo[k][2], lo[k][3], hh[k][0], hh[k][1], hh[k][2], hh[k][3]}
                o[e] = __builtin_amdgcn_mfma_f32_32x32x16_bf16(pa0, ATT_VF(0), o[e], 0, 0, 0);
                o[e] = __builtin_amdgcn_mfma_f32_32x32x16_bf16(pa1, ATT_VF(1), o[e], 0, 0, 0);
                o[e] = __builtin_amdgcn_mfma_f32_32x32x16_bf16(pa2, ATT_VF(2), o[e], 0, 0, 0);
                o[e] = __builtin_amdgcn_mfma_f32_32x32x16_bf16(pa3, ATT_VF(3), o[e], 0, 0, 0);
#undef ATT_VF
            }
        }
        if (more) { LAS unsigned char* nb = lds + L_RING + ((j + 1) & 1) * 32768;
            *(LAS u32x4*)(nb + kofs0) = kr0; *(LAS u32x4*)(nb + kofs1) = kr1; *(LAS u32x4*)(nb + vofs0) = vr0; *(LAS u32x4*)(nb + vofs1) = vr1; }
        __syncthreads();
    }
    const float ltot = halfswap_sum(lsum);
    const float sc = (mp == 0 ? 1.0f : -lam) / ltot;
    if (hi == 0) wsf[r32] = sc;
    float scr[16];
#pragma unroll
    for (int r = 0; r < 16; ++r) scr[r] = wsf[crow(r, hi)];
    if (mp == 0) {
#pragma unroll
        for (int e = 0; e < 4; ++e)
#pragma unroll
            for (int r = 0; r < 16; ++r) stage[(32 * rb + crow(r, hi)) * SROW + 32 * e + r32] = o[e][r] * scr[r];
    }
    __syncthreads();
    if (mp == 1) {
#pragma unroll
        for (int e = 0; e < 4; ++e)
#pragma unroll
            for (int r = 0; r < 16; ++r) stage[(32 * rb + crow(r, hi)) * SROW + 32 * e + r32] += o[e][r] * scr[r];
    }
    __syncthreads();
    { const int row = tid >> 2, part = tid & 3;
      const LAS f32x4* sp = (const LAS f32x4*)(stage + row * SROW + 32 * part);
      f32x4 v[8]; float ss = 0.f;
#pragma unroll
      for (int i = 0; i < 8; ++i) { v[i] = sp[i]; ss += (v[i][0] * v[i][0] + v[i][1] * v[i][1]) + (v[i][2] * v[i][2] + v[i][3] * v[i][3]); }
      ss += __shfl_xor(ss, 1); ss += __shfl_xor(ss, 2);
      const float rs = 0.8f / sqrtf(ss * (1.f / 128.f) + EPS);
      const size_t go = (rowbase + q0 + row) * 1024 + h * 128 + 32 * part;
      const u32x4* zp = (const u32x4*)(AZ + go); u32x4* op = dummy ? (u32x4*)((bf16*)(a->ws + WS_END) + (size_t)row * 1024 + h * 128 + 32 * part) : (u32x4*)(AQ + go); const f32x4* wp = (const f32x4*)(anw + 32 * part);
#pragma unroll
      for (int i = 0; i < 4; ++i) { const u32x4 z = zp[i]; const f32x4 w0 = wp[2 * i], w1 = wp[2 * i + 1]; const f32x4 x0 = v[2 * i] * rs * w0, x1 = v[2 * i + 1] * rs * w1;
          u32x4 w; w.x = pk2(x0[0] * bflo(z.x), x0[1] * bfhi(z.x)); w.y = pk2(x0[2] * bflo(z.y), x0[3] * bfhi(z.y));
          w.z = pk2(x1[0] * bflo(z.z), x1[1] * bfhi(z.z)); w.w = pk2(x1[2] * bflo(z.w), x1[3] * bfhi(z.w)); op[i] = w; } }
    __syncthreads();
}
}

namespace mls {
constexpr int L_Q = 0;
constexpr int L_K = 32768;
constexpr int L_STAGE = 0;
constexpr int L_KW = 66560;
constexpr int L_V = L_KW + 32768;
constexpr int L_P = L_V + 32768;
constexpr int L_SC = L_P + 8192;
constexpr int L_N = L_SC + 18 * 256;
constexpr int L_CW = L_N + 1024;
constexpr int L_END = L_CW + 8192;
static_assert(L_END <= LDS_BYTES, "mLSTM LDS map");
constexpr int SROW = 260;

__device__ __forceinline__ void mlstm_unit(KArgs a, LAS unsigned char* lds, int b, int h) {
    int tid_ = threadIdx.x; asm volatile("" : "+v"(tid_));
    const int tid = tid_, lane = tid & 63, r32 = lane & 31, hi = lane >> 5, wave = __builtin_amdgcn_readfirstlane(tid >> 6);
    const bf16* MQ = (const bf16*)a->out; const bf16* MK = (const bf16*)a->out + (size_t)MTOK * 1024; const bf16* MV = (const bf16*)(a->ws + WS_MV); const bf16* GM = (const bf16*)(a->ws + WS_GM);
    bf16* HM = (bf16*)(a->ws + WS_HB);
    const float* LI = (const float*)(a->ws + WS_LI); const float* LF = (const float*)(a->ws + WS_LF);
    const float* cqw = a->in[8]; const float* ckw = a->in[9]; const float* mnw = a->in[10];
    LAS float* S_psum = (LAS float*)(lds + L_SC) + 768; LAS float* S_qn = S_psum + 256;
    LAS float* nperm = (LAS float*)(lds + L_N); LAS float* cw = (LAS float*)(lds + L_CW); LAS float* stage = (LAS float*)(lds + L_STAGE);
    f32x16 X[8];
#pragma unroll
    for (int i = 0; i < 8; ++i)
#pragma unroll
        for (int r = 0; r < 16; ++r) X[i][r] = 0.f;
    if (tid < 256) nperm[tid] = 0.f;
    for (int i = tid; i < 2048; i += NTHREADS) { const int j = (i >> 8) & 3, d = i & 255; cw[i] = (i < 1024 ? cqw : ckw)[j * 1024 + h * 256 + d]; }
    float m_prev = 0.f;
    const int g6 = tid & 63, d0 = 4 * g6;
    const int qch = 2 * (g6 >> 2) + (g6 & 1), qbo = 8 * ((g6 >> 1) & 1);
    for (int c = 0; c < SEQ / MCH; ++c) {
        const size_t row0 = (size_t)b * SEQ + 64 * c;
        LAS float* S_alpha = (LAS float*)(lds + L_SC) + (c & 1) * 384; LAS float* S_beta = S_alpha + 64; LAS float* S_iw = S_alpha + 128; LAS float* S_clamp = S_alpha + 192; LAS float* S_ws = S_alpha + 256; LAS float* S_misc = S_alpha + 320;
        if (wave == 0) {
            const float lf = LF[(row0 + lane) * 4 + h], li = LI[(row0 + lane) * 4 + h];
            float bt = lf;
#pragma unroll
            for (int o = 1; o < 64; o <<= 1) { const float u = __shfl_up(bt, o); if (lane >= o) bt += u; }
            const float beta = li - bt; float cm = beta;
#pragma unroll
            for (int o = 1; o < 64; o <<= 1) { const float u = __shfl_up(cm, o); if (lane >= o) cm = fmaxf(cm, u); }
            const float mx = fmaxf(cm, m_prev);
            S_alpha[lane] = -mx; S_beta[lane] = beta; S_iw[lane] = expf(m_prev - mx); S_clamp[lane] = expf(-(bt + mx));
            const float cmL = __shfl(cm, 63), bL = __shfl(bt, 63); const float mxL = fmaxf(m_prev, cmL);
            S_ws[lane] = expf(beta - mxL);
            if (lane == 0) S_misc[0] = expf(m_prev - mxL);
            m_prev = bL + mxL;
        }
        __syncthreads();
#pragma unroll 1
        for (int rd = 0; rd < 2; ++rd) {
            const int t0 = 32 * rd + 4 * wave;
            u32x2 rq[7], rk[7], rv[4];
            {
              const size_t ub = ((size_t)b * SEQ + 64 * c + t0) * 1024 + h * 256;
              const bf16* qb_ = MQ + ub - 3 * 1024; const bf16* kb_ = MK + ub - 3 * 1024; const bf16* vb_ = MV + ub;
              const int t_first = 64 * c + t0 - 3;
#pragma unroll
              for (int i = 0; i < 7; ++i) {
                  if (t_first + i >= 0) { rq[i] = *(const u32x2*)(qb_ + (i * 1024 + d0)); rk[i] = *(const u32x2*)(kb_ + (i * 1024 + d0)); }
                  else { rq[i] = (u32x2){0u, 0u}; rk[i] = (u32x2){0u, 0u}; } }
#pragma unroll
              for (int i = 0; i < 4; ++i) rv[i] = *(const u32x2*)(vb_ + (i * 1024 + d0)); }
            { float qv[4][4];
#pragma unroll
              for (int t = 0; t < 4; ++t)
#pragma unroll
                  for (int e = 0; e < 4; ++e) qv[t][e] = 0.f;
#pragma unroll
              for (int j = 0; j < 4; ++j) { const f32x4 wq = *(const LAS f32x4*)(cw + j * 256 + d0);
#pragma unroll
                  for (int t = 0; t < 4; ++t) { const u32x2 uq = rq[t + j];
                      qv[t][0] += wq[0] * bflo(uq.x); qv[t][1] += wq[1] * bfhi(uq.x); qv[t][2] += wq[2] * bflo(uq.y); qv[t][3] += wq[3] * bfhi(uq.y); } }
#pragma unroll
              for (int t = 0; t < 4; ++t) { const int row = t0 + t;
#pragma unroll
                  for (int e = 0; e < 4; ++e) qv[t][e] = siluf(qv[t][e]) * 0.0625f;
                  u32x2 w; w.x = pk2(qv[t][0], qv[t][1]); w.y = pk2(qv[t][2], qv[t][3]); *(LAS u32x2*)(lds + L_Q + row * 512 + ((qch ^ (row & 15)) * 16) + qbo) = w; } }
            __builtin_amdgcn_sched_barrier(0);
            float kv[4][4];
#pragma unroll
            for (int t = 0; t < 4; ++t)
#pragma unroll
                for (int e = 0; e < 4; ++e) kv[t][e] = 0.f;
#pragma unroll
            for (int j = 0; j < 4; ++j) { const f32x4 wk = *(const LAS f32x4*)(cw + 1024 + j * 256 + d0);
#pragma unroll
                for (int t = 0; t < 4; ++t) { const u32x2 uk = rk[t + j];
                    kv[t][0] += wk[0] * bflo(uk.x); kv[t][1] += wk[1] * bfhi(uk.x); kv[t][2] += wk[2] * bflo(uk.y); kv[t][3] += wk[3] * bfhi(uk.y); } }
#pragma unroll
            for (int t = 0; t < 4; ++t) { const int row = t0 + t; const float wsr = S_ws[row];
#pragma unroll
                for (int e = 0; e < 4; ++e) kv[t][e] = siluf(kv[t][e]);
                u32x2 w; w.x = pk2(kv[t][0], kv[t][1]); w.y = pk2(kv[t][2], kv[t][3]); *(LAS u32x2*)(lds + L_K + row * 512 + ((qch ^ (row & 15)) * 16) + qbo) = w;
#pragma unroll
                for (int e = 0; e < 4; ++e) kv[t][e] *= wsr; }
            const int cs = t0 >> 3, bs = (t0 & 7) * 2;
#pragma unroll
            for (int e = 0; e < 4; ++e) { const int d = d0 + e; const int ro = d * 128 + ((cs ^ ((d >> 1) & 7)) * 16) + bs;
                u32x2 w; w.x = pk2(kv[0][e], kv[1][e]); w.y = pk2(kv[2][e], kv[3][e]); *(LAS u32x2*)(lds + L_KW + ro) = w;
                const unsigned sh = (e & 1) * 16;
                const unsigned v0 = ((e < 2 ? rv[0].x : rv[0].y) >> sh) & 0xffffu, v1 = ((e < 2 ? rv[1].x : rv[1].y) >> sh) & 0xffffu, v2 = ((e < 2 ? rv[2].x : rv[2].y) >> sh) & 0xffffu, v3 = ((e < 2 ? rv[3].x : rv[3].y) >> sh) & 0xffffu;
                u32x2 wv; wv.x = v0 | (v1 << 16); wv.y = v2 | (v3 << 16); *(LAS u32x2*)(lds + L_V + ro) = wv; }
        }
        __syncthreads();
        f32x16 num[2];
        {
            int lo_ = lane; asm volatile("" : "+v"(lo_));
            const int l15 = lo_ & 15, kq = lo_ >> 4, r32a = lo_ & 31, hia = lo_ >> 5;
            const int si = wave >> 1, ti0 = 2 * (wave & 1);
            f32x4 sa[2] = {(f32x4){0.f, 0.f, 0.f, 0.f}, (f32x4){0.f, 0.f, 0.f, 0.f}};
            { const int y = kq ^ l15; const int rowoff = l15 * 512;
              int b4[4];
#pragma unroll
              for (int j = 0; j < 4; ++j) b4[j] = rowoff + (((4 * j) ^ y) * 16);
              const LAS unsigned char* kbase = lds + L_K + si * 8192; const LAS unsigned char* qbase = lds + L_Q + ti0 * 8192;
#pragma unroll
              for (int kk = 0; kk < 8; ++kk) { const int o_ = b4[kk & 3] + (kk >> 2) * 256;
                  const bf16x8 ka = ldfrag(kbase + o_);
                  const bf16x8 q0_ = ldfrag(qbase + o_), q1_ = ldfrag(qbase + 8192 + o_);
                  sa[0] = __builtin_amdgcn_mfma_f32_16x16x32_bf16(ka, q0_, sa[0], 0, 0, 0);
                  sa[1] = __builtin_amdgcn_mfma_f32_16x16x32_bf16(ka, q1_, sa[1], 0, 0, 0); } }
#pragma unroll
            for (int u = 0; u < 2; ++u) { const int ti = ti0 + u, t = 16 * ti + l15, s_ = 16 * si + 4 * kq;
                const float al = S_alpha[t]; const f32x4 bt4 = *(const LAS f32x4*)(S_beta + s_); float pv_[4]; float psum = 0.f;
#pragma unroll
                for (int r = 0; r < 4; ++r) { pv_[r] = (s_ + r <= t) ? sa[u][r] * __expf(al + bt4[r]) : 0.f; psum += pv_[r]; }
                psum += __shfl_xor(psum, 16); psum += __shfl_xor(psum, 32);
                if (kq == 0) S_psum[si * 64 + t] = psum;
                u32x2 w; w.x = pk2(pv_[0], pv_[1]); w.y = pk2(pv_[2], pv_[3]);
                const int cp = 2 * si + (kq >> 1);
                *(LAS u32x2*)(lds + L_P + t * 128 + ((cp ^ ((t >> 1) & 7)) * 16) + 8 * (kq & 1)) = w; }
#pragma unroll
            for (int r = 0; r < 16; ++r) { num[0][r] = 0.f; num[1][r] = 0.f; }
            { const int yq = hia ^ (r32a & 15); const int rowoff = r32a * 512;
              int b8[8];
#pragma unroll
              for (int g = 0; g < 8; ++g) b8[g] = rowoff + (((2 * g) ^ yq) * 16);
              const LAS unsigned char* qbase = lds + L_Q;
#pragma unroll
              for (int dt = 0; dt < 8; ++dt) { __builtin_amdgcn_sched_barrier(0);
#pragma unroll
                  for (int sp = 0; sp < 2; ++sp) { const bf16x8 xb = pack8(X[dt], 8 * sp); const int G_ = 2 * dt + sp; const int o_ = b8[G_ & 7] + (G_ >> 3) * 256;
                      const bf16x8 qa0 = ldfrag(qbase + o_), qa1 = ldfrag(qbase + 16384 + o_);
                      num[0] = __builtin_amdgcn_mfma_f32_32x32x16_bf16(qa0, xb, num[0], 0, 0, 0);
                      num[1] = __builtin_amdgcn_mfma_f32_32x32x16_bf16(qa1, xb, num[1], 0, 0, 0); } } }
            __builtin_amdgcn_sched_barrier(0);
            { int to_ = tid; asm volatile("" : "+v"(to_));
              const int t = to_ >> 3, part = to_ & 7; float accn = 0.f;
#pragma unroll
              for (int i = 0; i < 4; ++i) { const int ch = 4 * part + i; const u32x4 qq = *(const LAS u32x4*)(lds + L_Q + t * 512 + ((ch ^ (t & 15)) * 16));
                  const f32x4 n0 = *(const LAS f32x4*)(nperm + 8 * ch), n1 = *(const LAS f32x4*)(nperm + 8 * ch + 4);
                  accn += bflo(qq.x) * n0[0] + bfhi(qq.x) * n0[1] + bflo(qq.y) * n0[2] + bfhi(qq.y) * n0[3] + bflo(qq.z) * n1[0] + bfhi(qq.z) * n1[1] + bflo(qq.w) * n1[2] + bfhi(qq.w) * n1[3]; }
              accn += __shfl_xor(accn, 1); accn += __shfl_xor(accn, 2); accn += __shfl_xor(accn, 4);
              if (part == 0) S_qn[t] = accn; }
        }
        __syncthreads();
        {
            int lo_ = lane; asm volatile("" : "+v"(lo_));
            const int r32a = lo_ & 31, hia = lo_ >> 5;
            const int e = 32 * wave + r32a;
            const int yk = hia ^ ((r32a >> 1) & 7); const int rowoff = r32a * 128;
            int b4[4];
#pragma unroll
            for (int ks = 0; ks < 4; ++ks) b4[ks] = rowoff + (((2 * ks) ^ yk) * 16);
            bf16x8 vf[4];
#pragma unroll
            for (int ks = 0; ks < 4; ++ks) vf[ks] = ldfrag(lds + L_V + wave * 4096 + b4[ks]);
#pragma unroll
            for (int tt = 0; tt < 2; ++tt) {
#pragma unroll
                for (int g = 0; g < 4; ++g) { const f32x4 iw4 = *(const LAS f32x4*)(S_iw + 32 * tt + 8 * g + 4 * hia);
#pragma unroll
                    for (int q = 0; q < 4; ++q) num[tt][4 * g + q] *= iw4[q]; }
#pragma unroll
                for (int ks = 0; ks < 4; ++ks) { const bf16x8 pa = ldfrag(lds + L_P + tt * 4096 + b4[ks]);
                    num[tt] = __builtin_amdgcn_mfma_f32_32x32x16_bf16(pa, vf[ks], num[tt], 0, 0, 0); }
#pragma unroll
                for (int r = 0; r < 16; ++r) stage[(32 * tt + crow(r, hia)) * SROW + e] = num[tt][r];
            }
            const float decay = S_misc[0];
#pragma unroll
            for (int dt = 0; dt < 8; ++dt) { __builtin_amdgcn_sched_barrier(0);
#pragma unroll
                for (int r = 0; r < 16; ++r) X[dt][r] *= decay;
#pragma unroll
                for (int ks = 0; ks < 4; ++ks) { const bf16x8 ka = ldfrag(lds + L_KW + dt * 4096 + b4[ks]);
                    X[dt] = __builtin_amdgcn_mfma_f32_32x32x16_bf16(ka, vf[ks], X[dt], 0, 0, 0); } }
            __builtin_amdgcn_sched_barrier(0);
            int to_ = tid; asm volatile("" : "+v"(to_));
            if (to_ < 256) { const int d = to_; float s = 0.f;
#pragma unroll
                for (int i = 0; i < 8; ++i) { const u32x4 kk = *(const LAS u32x4*)(lds + L_KW + d * 128 + i * 16);
                    s += (bflo(kk.x) + bfhi(kk.x)) + (bflo(kk.y) + bfhi(kk.y)) + (bflo(kk.z) + bfhi(kk.z)) + (bflo(kk.w) + bfhi(kk.w)); }
                const int p = (d & ~12) | ((d & 4) << 1) | ((d & 8) >> 1);
                nperm[p] = decay * nperm[p] + s; }
        }
        __syncthreads();
        { const int t = tid >> 3, part = tid & 7;
          const float den = S_iw[t] * S_qn[t] + ((S_psum[t] + S_psum[64 + t]) + (S_psum[128 + t] + S_psum[192 + t]));
          const float hd = 1.0f / fmaxf(fabsf(den), S_clamp[t]);
          const LAS f32x4* sp = (const LAS f32x4*)(stage + t * SROW + 32 * part);
          f32x4 v[8]; float s1 = 0.f;
#pragma unroll
          for (int i = 0; i < 8; ++i) { v[i] = sp[i] * hd; s1 += (v[i][0] + v[i][1]) + (v[i][2] + v[i][3]); }
          s1 += __shfl_xor(s1, 1); s1 += __shfl_xor(s1, 2); s1 += __shfl_xor(s1, 4);
          const float mu = s1 * (1.f / 256.f); float s2 = 0.f;
#pragma unroll
          for (int i = 0; i < 8; ++i) { v[i] = v[i] - mu; s2 += (v[i][0] * v[i][0] + v[i][1] * v[i][1]) + (v[i][2] * v[i][2] + v[i][3] * v[i][3]); }
          s2 += __shfl_xor(s2, 1); s2 += __shfl_xor(s2, 2); s2 += __shfl_xor(s2, 4);
          const float rs = 1.0f / sqrtf(s2 * (1.f / 256.f) + EPS);
          const size_t ub = row0 * 1024 + h * 256; const int lo2 = t * 1024 + 32 * part;
          const u32x4* gp = (const u32x4*)(GM + ub + lo2); u32x4* op = (u32x4*)(HM + ub + lo2); const f32x4* wp = (const f32x4*)(mnw + h * 256 + 32 * part);
#pragma unroll
          for (int i = 0; i < 4; ++i) { const u32x4 z = gp[i]; const f32x4 w0 = wp[2 * i], w1 = wp[2 * i + 1]; const f32x4 x0 = v[2 * i] * rs * w0, x1 = v[2 * i + 1] * rs * w1;
              u32x4 w; w.x = pk2(x0[0] * bflo(z.x), x0[1] * bfhi(z.x)); w.y = pk2(x0[2] * bflo(z.y), x0[3] * bfhi(z.y));
              w.z = pk2(x1[0] * bflo(z.z), x1[1] * bfhi(z.z)); w.w = pk2(x1[2] * bflo(z.w), x1[3] * bfhi(z.w)); op[i] = w; } }
    }
    __syncthreads();
}
}

__device__ __forceinline__ void phase3(KArgs a, LAS unsigned char* lds) {
    const int tid = threadIdx.x, lane = tid & 63;
    float s1 = a->in[11][lane] * a->in[12][lane], s2 = a->in[13][lane] * a->in[14][lane];
    s1 = wave_sum(s1); s2 = wave_sum(s2);
    const float lam = __uint_as_float(__builtin_amdgcn_readfirstlane(__float_as_uint(expf(s1) - expf(s2) + 0.2f)));
    unsigned* qhead = (unsigned*)(a->ws + WS_CTL) + CW_QUEUE;
    LAS unsigned* slot = (LAS unsigned*)(lds + LDS_BYTES - 64);
    constexpr unsigned N_M1 = BATCH * MH, N_A1 = BATCH * AH * (SEQ / 128);
    constexpr unsigned N_M = N_M1 * REP_ML, N_AD = N_A1 * (REP_AT - 1), N_A = N_AD + N_A1;
    for (;;) {
        if (tid == 0) *slot = __hip_atomic_fetch_add(qhead, 1u, __ATOMIC_RELAXED, __HIP_MEMORY_SCOPE_AGENT);
        __syncthreads();
        const unsigned it = *slot;
        __syncthreads();
        if (it >= N_M + N_A) break;
        if (it < N_M) { const unsigned u = it % N_M1; mls::mlstm_unit(a, lds, (int)(u >> 2), (int)(u & 3)); }
        else { const unsigned i0 = it - N_M; const bool dummy = i0 < N_AD; const unsigned i = i0 % N_A1; const int qb = 15 - (int)(i >> 7), bh = (int)(i & 127); att::attn_unit(a, lds, bh >> 3, bh & 7, qb, lam, dummy); }
    }
}
template <bool COOP>
__global__ void __launch_bounds__(NTHREADS, 2) fwd(Args args) {
    extern __shared__ __attribute__((aligned(16))) unsigned char lds_raw[];
    LAS unsigned char* lds = (LAS unsigned char*)lds_raw;
    const int G = gridDim.x, bx = blockIdx.x;
    const int vcu = (G % 8 == 0) ? (bx % 8) * (G / 8) + bx / 8 : bx;
    const int lo = args.ph_lo, hi = args.ph_hi;
    volatile LAS unsigned* MISC = (volatile LAS unsigned*)(lds + LDS_BYTES - 128);
    if (threadIdx.x < 32) MISC[threadIdx.x] = 0u;
    __syncthreads();
    XcdBarrier bar; bar.bar = nullptr; bar.x = 0; bar.st = nullptr;
    if constexpr (COOP) bar = xcd_barrier_post((unsigned*)(kargs()->ws + WS_CTL) + CW_BAR, MISC + 8);
#define IN(k) (lo <= (k) && (k) < hi)
#define SEAM(k) do { if constexpr (COOP) { if (IN(k) && IN((k) + 1)) { if ((k) == 0) cg::this_grid().sync(); else xcd_barrier(bar); } } } while (0)
    if (IN(0)) for (int rep = 0; rep < REP_P0; ++rep) { phase0(kargs(), lds, vcu, G); __syncthreads(); }
    SEAM(0);
    if (IN(1)) for (int rep = 0; rep < REP_P1; ++rep) { phase1(kargs(), lds, vcu, G); __syncthreads(); }
    SEAM(1);
    if (IN(2)) {
#pragma unroll 1
        for (int rep = 0; rep < REP_P2; ++rep) {
        const KArgs ka = kargs(); unsigned char* ws_ = ka->ws; float* out_ = ka->out;
        pg8::Gemm g{(const bf16*)(ws_ + WS_HB), (const bf16*)(ws_ + WS_HB), (const bf16*)(ws_ + WS_WIN), MTOK, NPROJ, 1024, 1024, 16};
        pg8::StaticOrder S; S.init(MTOK, NPROJ, G, bx);
        EpiProj E{(bf16*)out_, (bf16*)out_ + (size_t)MTOK * 1024, (bf16*)(ws_ + WS_MV), (bf16*)(ws_ + WS_GM), (bf16*)(ws_ + WS_AQ), (bf16*)(ws_ + WS_AK), (bf16*)(ws_ + WS_AV), (bf16*)(ws_ + WS_AZ)};
        pg8::gemm_phase<EpiProj, pg8::StaticOrder, true, true>(lds, g, S, E);
        }
    }
    SEAM(2);
    if (IN(3)) phase3(kargs(), lds);
    SEAM(3);
    if (IN(4)) {
#pragma unroll 1
        for (int rep = 0; rep < REP_P4; ++rep) {
        const KArgs ka = kargs(); unsigned char* ws_ = ka->ws; float* out_ = ka->out; const float* x_ = ka->in[0];
        pg8::Gemm g{(const bf16*)(ws_ + WS_HB), (const bf16*)(ws_ + WS_AQ), (const bf16*)(ws_ + WS_WOUT), MTOK, D, DMIX, 1024, 16};
        pg8::StaticOrder S; S.init(MTOK, D, G, bx);
        EpiOut E{x_, (const float*)(ws_ + WS_MOD), out_, (float*)(ws_ + WS_RSS)};
        pg8::gemm_phase<EpiOut, pg8::StaticOrder, true, true>(lds, g, S, E);
        }
    }
    SEAM(4);
    if (IN(5)) phase5(kargs(), vcu, G);
#if REP_P5 > 1
    if (IN(5)) { __syncthreads(); phase5_touch(kargs(), vcu, G); }
#endif
#undef IN
#undef SEAM
}

#ifndef MK_MULTI
#define MK_MULTI 0
#endif
extern "C" void kernel_launch(void* const* d_in, const int* in_sizes, int n_in, void* d_out, int out_size, void* d_ws, size_t ws_size, hipStream_t stream) {
    static int grid = 0;
    if (grid == 0) {
        if (n_in != 19 || out_size != MTOK * D || ws_size < WS_END) { fprintf(stderr, "kernel_launch: unexpected shapes (n_in %d, out %d, ws %zu)\n", n_in, out_size, ws_size); grid = -1; return; }
        int dev = 0, cus = 0, per_cu = 0;
        (void)hipGetDevice(&dev); (void)hipDeviceGetAttribute(&cus, hipDeviceAttributeMultiprocessorCount, dev);
        (void)hipFuncSetAttribute((const void*)fwd<!MK_MULTI>, hipFuncAttributeMaxDynamicSharedMemorySize, LDS_BYTES);
        (void)hipOccupancyMaxActiveBlocksPerMultiprocessor(&per_cu, (const void*)fwd<!MK_MULTI>, NTHREADS, LDS_BYTES);
        if (per_cu < 1) { fprintf(stderr, "kernel_launch: occupancy query says %d blocks per CU\n", per_cu); per_cu = 1; }
        (void)hipGetLastError();
        grid = cus * (per_cu > 1 ? 1 : per_cu);
    }
    if (grid < 0) return;
    (void)hipMemsetAsync((char*)d_ws + WS_CTL, 0, 1 * MiB, stream);
    Args a{};
    for (int i = 0; i < 19; ++i) a.in[i] = (const float*)d_in[i];
    a.out = (float*)d_out; a.ws = (unsigned char*)d_ws;
#if MK_MULTI
    for (int ph = 0; ph < 6; ++ph) { a.ph_lo = ph; a.ph_hi = ph + 1; hipLaunchKernelGGL(fwd<false>, dim3(grid), dim3(NTHREADS), LDS_BYTES, stream, a); }
#else
    a.ph_lo = 0; a.ph_hi = 6;
    void* kargs[] = {&a};
    hipError_t e = hipLaunchCooperativeKernel((const void*)fwd<true>, dim3(grid), dim3(NTHREADS), kargs, LDS_BYTES, stream);
    if (e != hipSuccess) fprintf(stderr, "cooperative launch failed: %s (grid %d)\n", hipGetErrorString(e), grid);
#endif
}
```

```cpp
#include <hip/hip_runtime.h>
#include <hip/hip_cooperative_groups.h>
#include <cstdio>
#include <cstdint>
#include <cmath>
namespace cg = cooperative_groups;
namespace pg8 {
#define PG8_LAS __attribute__((address_space(3)))
typedef unsigned short bf16_t;
typedef short bf16x8 __attribute__((ext_vector_type(8)));
typedef float f32x4 __attribute__((ext_vector_type(4)));
typedef unsigned u32x4 __attribute__((ext_vector_type(4)));
constexpr int BM = 256, BK = 64, HALF = 128, HTB = HALF * BK * 2  , STAGE_BYTES = 8 * HTB, NXCD = 8, WGM = 8;

__host__ __device__ __forceinline__ int lds_byte(int r, int c) { const int st = (r >> 4) * 2 + (c >> 5), rr = r & 15, cc = c & 31, ob = rr * 64 + cc * 2; return st * 1024 + (ob ^ (((ob >> 9) & 1) << 5)); }
__host__ __device__ __forceinline__ void stage_rc(int b, int& R, int& C) { const int st = b / 1024, sb = b % 1024, swz = sb ^ (((sb >> 9) & 1) << 5); R = (st >> 1) * 16 + swz / 64; C = (st & 1) * 32 + (swz % 64) / 2; }
__host__ __device__ __forceinline__ int perm32(int rho) { const int n = rho >> 4, i = rho & 15; return 8 * (i >> 2) + 4 * n + (i & 3); }

struct Unit { int pm, pn; };
struct Gemm { const bf16_t* A; const bf16_t* A2; const bf16_t* Bt; int M, N, K, lda, nt1; };

struct StaticOrder {
    int nM, nN, nwg, G, c;
    __host__ __device__ void init(int M, int N, int G_, int c_) { nM = M / BM; nN = N / BM; nwg = nM * nN; G = G_; c = c_; }
    __host__ __device__ bool next(int i, Unit& u) const {
        const long L = (long)i * G + c; if (L >= nwg) return false;
        int wgid = (int)L; { const int q = nwg / NXCD, r = nwg % NXCD, xcd = wgid % NXCD, off = wgid / NXCD; wgid = (xcd < r ? xcd * (q + 1) : r * (q + 1) + (xcd - r) * q) + off; }
        const int nig = WGM * nN, gid = wgid / nig, fm = gid * WGM, gsz = (nM - fm) < WGM ? (nM - fm) : WGM;
        u.pm = fm + ((wgid % nig) % gsz); u.pn = (wgid % nig) / gsz; return true;
    }
    __device__ __forceinline__ void a_ready(const Unit&) const {}
    __device__ __forceinline__ void done(const Unit&) const {}
};

__device__ __forceinline__ unsigned cvt_pk_bf16(float lo, float hi) { unsigned r; asm volatile("v_cvt_pk_bf16_f32 %0, %1, %2" : "=v"(r) : "v"(lo), "v"(hi)); return r; }
template <class Epi, class Sched, bool ALIGN_EPI = false, bool SP2 = false>
__device__ __forceinline__ void gemm_phase(PG8_LAS unsigned char* lds, const Gemm g, const Sched& S, const Epi& E, const int wid) {
    const int lane = (int)__builtin_amdgcn_mbcnt_hi(~0u, __builtin_amdgcn_mbcnt_lo(~0u, 0u)), tid = wid * 64 + lane, wr = wid >> 2, wc = wid & 3, fr = lane & 15, fq = lane >> 4;
    const int K = g.K, nt = K / BK;
    unsigned voffA[2], voffB[2];
#pragma unroll
    for (int i = 0; i < 2; ++i) { int R, C; stage_rc(tid * 16 + i * 8192, R, C); const int Rb = Epi::PERM ? ((R & ~31) + perm32(R & 31)) : R;
        voffA[i] = (unsigned)(R * g.lda + C) * 2u; voffB[i] = (unsigned)(Rb * K + C) * 2u; }
    const size_t kstep = (size_t)(BK * 2);
    const size_t hstep = (size_t)HALF * K * 2;
    const size_t tstep = 2 * hstep;
    const size_t hstepA = (size_t)HALF * g.lda * 2, tstepA = 2 * hstepA; const int nt1 = g.nt1;
#define PG8_AP(b1, b2, t) ((t) < nt1 ? (b1) + (size_t)(t) * kstep : (b2) + (size_t)((t) - nt1) * kstep)
    const unsigned ldsw = (unsigned)wid * 1024u;
    const int aoff = lds_byte(wr * 64 + fr, fq * 8), boff = lds_byte(wc * 32 + fr, fq * 8);
#define PG8_SA(b, h) (((b) * 2 + (h)) * HTB)
#define PG8_SB(b, h) ((4 + (b) * 2 + (h)) * HTB)
#define PG8_STAGE(bufoff, gbase, voff) do { _Pragma("unroll") for (int _i = 0; _i < 2; ++_i) \
        __builtin_amdgcn_global_load_lds((const unsigned*)((const char*)(gbase) + (voff)[_i]), (PG8_LAS unsigned*)(lds + (bufoff) + ldsw + _i * 8192), 16, 0, 0); } while (0)
#define PG8_LDA(dst, b, h) do { _Pragma("unroll") for (int m = 0; m < 4; ++m) _Pragma("unroll") for (int k = 0; k < 2; ++k) dst[m][k] = *(const PG8_LAS bf16x8*)(lds + PG8_SA(b, h) + aoff + m * 2048 + k * 1024); } while (0)
#define PG8_LDB(dst, b, h) do { _Pragma("unroll") for (int n = 0; n < 2; ++n) _Pragma("unroll") for (int k = 0; k < 2; ++k) dst[n][k] = *(const PG8_LAS bf16x8*)(lds + PG8_SB(b, h) + boff + n * 2048 + k * 1024); } while (0)
#define PG8_MMA(ai, bj, At, Bt) do { __builtin_amdgcn_s_setprio(1); _Pragma("unroll") for (int m = 0; m < 4; ++m) _Pragma("unroll") for (int n = 0; n < 2; ++n) _Pragma("unroll") for (int k = 0; k < 2; ++k) \
        acc[ai][bj][m][n] = __builtin_amdgcn_mfma_f32_16x16x32_bf16(Bt[n][k], At[m][k], acc[ai][bj][m][n], 0, 0, 0); __builtin_amdgcn_s_setprio(0); } while (0)
#define PG8_WAIT_V(n) asm volatile("s_waitcnt vmcnt(" #n ")" ::: "memory")
#define PG8_WAIT_L(n) asm volatile("s_waitcnt lgkmcnt(" #n ")" ::: "memory")
#define PG8_BAR __builtin_amdgcn_s_barrier()
#define PG8_SCHED __builtin_amdgcn_sched_barrier(0)
    Unit cur, nxt; int ui = 0;
    if (!S.next(0, cur)) return;
    f32x4 acc[2][2][4][2];
#pragma unroll
    for (int a = 0; a < 2; ++a)
#pragma unroll
        for (int b = 0; b < 2; ++b)
#pragma unroll
            for (int m = 0; m < 4; ++m)
#pragma unroll
                for (int n = 0; n < 2; ++n) acc[a][b][m][n] = (f32x4){0.f, 0.f, 0.f, 0.f};
    bf16x8 At[4][2], B0[2][2], B1[2][2];
    const char* cA = (const char*)g.A + (size_t)cur.pm * tstepA; const char* cA2 = (const char*)g.A2 + (size_t)cur.pm * tstepA; const char* cB = (const char*)g.Bt + (size_t)cur.pn * tstep;
    S.a_ready(cur);
    if constexpr (SP2) {
        PG8_STAGE(PG8_SB(0, 0), cB, voffB); PG8_STAGE(PG8_SB(0, 1), cB + hstep, voffB); PG8_STAGE(PG8_SA(0, 0), cA, voffA); PG8_STAGE(PG8_SA(0, 1), cA + hstepA, voffA);
        if (wr == 1) PG8_BAR;
        PG8_WAIT_V(2); PG8_BAR;
        PG8_STAGE(PG8_SB(1, 0), cB + kstep, voffB); PG8_STAGE(PG8_SA(1, 0), cA + kstep, voffA); PG8_STAGE(PG8_SB(1, 1), cB + hstep + kstep, voffB);
        PG8_WAIT_V(6); PG8_BAR;
    } else {
        PG8_STAGE(PG8_SB(0, 0), cB, voffB); PG8_STAGE(PG8_SA(0, 0), cA, voffA); PG8_STAGE(PG8_SB(0, 1), cB + hstep, voffB); PG8_STAGE(PG8_SA(0, 1), cA + hstepA, voffA);
        if (wr == 1) PG8_BAR;
        PG8_WAIT_V(4); PG8_BAR;
        PG8_STAGE(PG8_SB(1, 0), cB + kstep, voffB); PG8_STAGE(PG8_SA(1, 0), cA + kstep, voffA); PG8_STAGE(PG8_SB(1, 1), cB + hstep + kstep, voffB);
        PG8_WAIT_V(6); PG8_BAR;
    }
    for (;;) {
        const bool has_next = S.next(ui + 1, nxt);
        const char* nA = has_next ? (const char*)g.A + (size_t)nxt.pm * tstepA : cA; const char* nA2 = has_next ? (const char*)g.A2 + (size_t)nxt.pm * tstepA : cA2; const char* nB = has_next ? (const char*)g.Bt + (size_t)nxt.pn * tstep : cB;
        for (int t = 0; t < nt; t += 2) {
            const bool last = (t == nt - 2);
            const char* a1 = PG8_AP(cA, cA2, t + 1);
            const char* a2 = last ? nA : PG8_AP(cA, cA2, t + 2); const char* b2 = last ? nB : cB + (size_t)(t + 2) * kstep;
            const char* a3 = last ? nA + kstep : PG8_AP(cA, cA2, t + 3); const char* b3 = b2 + kstep;
            if (last && has_next) S.a_ready(nxt);
            if constexpr (SP2) {
            PG8_LDB(B0, 0, 0); PG8_LDB(B1, 0, 1); PG8_SCHED; PG8_LDA(At, 0, 0); PG8_STAGE(PG8_SA(1, 1), a1 + hstepA, voffA);
            PG8_WAIT_V(8); PG8_WAIT_L(0); PG8_BAR; PG8_MMA(0, 0, At, B0); PG8_MMA(0, 1, At, B1); PG8_BAR; PG8_SCHED;
            PG8_LDA(At, 0, 1); PG8_STAGE(PG8_SB(0, 0), b2, voffB); PG8_STAGE(PG8_SB(0, 1), b2 + hstep, voffB); PG8_STAGE(PG8_SA(0, 0), a2, voffA);
            PG8_WAIT_V(8); PG8_WAIT_L(0); PG8_BAR; PG8_MMA(1, 0, At, B0); PG8_MMA(1, 1, At, B1); PG8_BAR; PG8_SCHED;
            PG8_LDB(B0, 1, 0); PG8_LDB(B1, 1, 1); PG8_SCHED; PG8_LDA(At, 1, 0); PG8_STAGE(PG8_SA(0, 1), a2 + hstepA, voffA);
            PG8_WAIT_V(8); PG8_WAIT_L(0); PG8_BAR; PG8_MMA(0, 0, At, B0); PG8_MMA(0, 1, At, B1); PG8_BAR; PG8_SCHED;
            PG8_LDA(At, 1, 1); PG8_STAGE(PG8_SB(1, 0), b3, voffB); PG8_STAGE(PG8_SB(1, 1), b3 + hstep, voffB); PG8_STAGE(PG8_SA(1, 0), a3, voffA);
            PG8_WAIT_V(8); PG8_WAIT_L(0); PG8_BAR; PG8_MMA(1, 0, At, B0); PG8_MMA(1, 1, At, B1); PG8_BAR; PG8_SCHED;
            } else {
            PG8_LDB(B0, 0, 0); PG8_SCHED; PG8_LDA(At, 0, 0); PG8_STAGE(PG8_SA(1, 1), a1 + hstepA, voffA);
            PG8_WAIT_L(8); PG8_BAR; PG8_WAIT_L(0); PG8_MMA(0, 0, At, B0); PG8_BAR; PG8_SCHED;
            PG8_LDB(B1, 0, 1); PG8_STAGE(PG8_SB(0, 0), b2, voffB);
            PG8_BAR; PG8_WAIT_L(0); PG8_MMA(0, 1, At, B1); PG8_BAR;
            PG8_LDA(At, 0, 1); PG8_STAGE(PG8_SA(0, 0), a2, voffA);
            PG8_BAR; PG8_WAIT_L(0); PG8_MMA(1, 0, At, B0); PG8_BAR; PG8_SCHED;
            PG8_STAGE(PG8_SB(0, 1), b2 + hstep, voffB);
            PG8_WAIT_V(6); PG8_BAR; PG8_MMA(1, 1, At, B1); PG8_BAR;
            PG8_LDB(B0, 1, 0); PG8_SCHED; PG8_LDA(At, 1, 0); PG8_STAGE(PG8_SA(0, 1), a2 + hstepA, voffA);
            PG8_WAIT_L(8); PG8_BAR; PG8_WAIT_L(0); PG8_MMA(0, 0, At, B0); PG8_BAR; PG8_SCHED;
            PG8_LDB(B1, 1, 1); PG8_STAGE(PG8_SB(1, 0), b3, voffB);
            PG8_BAR; PG8_WAIT_L(0); PG8_MMA(0, 1, At, B1); PG8_BAR;
            PG8_LDA(At, 1, 1); PG8_STAGE(PG8_SA(1, 0), a3, voffA);
            PG8_BAR; PG8_WAIT_L(0); PG8_MMA(1, 0, At, B0); PG8_BAR; PG8_SCHED;
            PG8_STAGE(PG8_SB(1, 1), b3 + hstep, voffB);
            PG8_WAIT_V(6); PG8_BAR; PG8_MMA(1, 1, At, B1); PG8_BAR;
            }
        }
        if constexpr (ALIGN_EPI) { if (wr == 0) PG8_BAR; }
        if constexpr (!Epi::AFTER_DRAIN) { E(acc, cur, wr, wc, fr, fq); S.done(cur); }
        if (!has_next) break;
#pragma unroll
        for (int a = 0; a < 2; ++a)
#pragma unroll
            for (int b = 0; b < 2; ++b)
#pragma unroll
                for (int m = 0; m < 4; ++m)
#pragma unroll
                    for (int n = 0; n < 2; ++n) acc[a][b][m][n] = (f32x4){0.f, 0.f, 0.f, 0.f};
        cur = nxt; cA = nA; cA2 = nA2; cB = nB; ++ui;
        if constexpr (ALIGN_EPI) { if (wr == 1) PG8_BAR; }
    }
    PG8_WAIT_V(0);
    if constexpr (!ALIGN_EPI) { if (wr == 0) PG8_BAR; }
    PG8_BAR;
    if constexpr (Epi::AFTER_DRAIN) { E.fused(acc, cur, wr, wc, fr, fq, lds, wid, lane); S.done(cur); }
#undef PG8_AP
#undef PG8_SA
#undef PG8_SB
#undef PG8_STAGE
#undef PG8_LDA
#undef PG8_LDB
#undef PG8_MMA
#undef PG8_WAIT_V
#undef PG8_WAIT_L
#undef PG8_BAR
#undef PG8_SCHED
}
}
#ifndef REP_P0
#define REP_P0 1
#endif
#ifndef REP_P5
#define REP_P5 1
#endif
#ifndef REP_P1
#define REP_P1 1
#endif
#ifndef REP_P2
#define REP_P2 1
#endif
#ifndef REP_ML
#define REP_ML 1
#endif
#ifndef REP_AT
#define REP_AT 1
#endif
#ifndef REP_P4
#define REP_P4 1
#endif
constexpr int NWAVES = 8, NTHREADS = 512;
constexpr int D = 1024, BATCH = 16, SEQ = 2048, MTOK = BATCH * SEQ, DIN = 9224, NPROJ = 9216, DMIX = 2048;
constexpr int MH = 4, MHD = 256, AH = 8, AVD = 128, AQK = 64, MCH = 64;
constexpr int C_MQ = 0, C_MK = 1024, C_MV = 2048, C_MO = 3072, C_MZ = 4096, C_MI = 5120, C_MF = 5124, C_AQ = 5128, C_AK = 6152, C_AV = 7176, C_AZ = 8200;
constexpr float EPS = 1e-6f, LOG2E = 1.4426950408889634f;
constexpr float QSCALE = 0.125f * LOG2E;
constexpr size_t MiB = 1u << 20;
constexpr size_t WS_CTL = 0;
constexpr size_t WS_MOD = 1 * MiB;
constexpr size_t WS_LI = 2 * MiB;
constexpr size_t WS_LF = 2 * MiB + 512 * 1024;
constexpr size_t WS_RSS = 4 * MiB;
constexpr size_t WS_WIN = 8 * MiB;
constexpr size_t WS_WOUT = 26 * MiB;
constexpr size_t WS_HB = 32 * MiB;
constexpr size_t WS_MV = 96 * MiB;
constexpr size_t WS_GM = 160 * MiB;
constexpr size_t WS_AQ = 224 * MiB;
constexpr size_t WS_AK = 288 * MiB;
constexpr size_t WS_AV = 352 * MiB;
constexpr size_t WS_AZ = 416 * MiB;
constexpr size_t WS_END = 480 * MiB;
constexpr int CW_QUEUE = 64;
constexpr int LDS_BYTES = 155648;

#define LAS __attribute__((address_space(3)))
typedef unsigned short bf16;
typedef float f32x4 __attribute__((ext_vector_type(4)));
typedef float f32x16 __attribute__((ext_vector_type(16)));
typedef float f32x2 __attribute__((ext_vector_type(2)));
typedef short bf16x8 __attribute__((ext_vector_type(8)));
typedef short s16x4 __attribute__((ext_vector_type(4)));
typedef unsigned u32x4 __attribute__((ext_vector_type(4)));
typedef unsigned u32x2 __attribute__((ext_vector_type(2)));
typedef __bf16 bf16x2_t __attribute__((ext_vector_type(2)));

__device__ __forceinline__ unsigned pk2(float lo, float hi) { f32x2 v = {lo, hi}; bf16x2_t b = __builtin_convertvector(v, bf16x2_t); return __builtin_bit_cast(unsigned, b); }
__device__ __forceinline__ float bflo(unsigned u) { return __uint_as_float(u << 16); }
__device__ __forceinline__ float bfhi(unsigned u) { return __uint_as_float(u & 0xffff0000u); }
__device__ __forceinline__ float siluf(float x) { return x * __builtin_amdgcn_rcpf(1.f + __expf(-x)); }
__device__ __forceinline__ float sigmf(float x) { return __builtin_amdgcn_rcpf(1.f + __expf(-x)); }
__device__ __forceinline__ int lane_id() { return (int)__builtin_amdgcn_mbcnt_hi(~0u, __builtin_amdgcn_mbcnt_lo(~0u, 0u)); }
#define TID_OF(wv) ((wv) * 64 + lane_id())
__device__ __forceinline__ float wave_sum(float v) {
#pragma unroll
    for (int o = 1; o < 64; o <<= 1) v += __shfl_xor(v, o);
    return v;
}

struct Args { const float* in[19]; float* out; unsigned char* ws; int ph_lo, ph_hi; };
typedef const __attribute__((address_space(4))) Args* KArgs;
__device__ __forceinline__ KArgs kargs() { KArgs p = (KArgs)__builtin_amdgcn_kernarg_segment_ptr(); asm volatile("" : "+s"(p)); return p; }

__device__ __forceinline__ int win_src_col(int n) {
    if (n < 3072) return n;
    if (n < 5120) { const int g = (n - 3072) >> 8, r = (n - 3072) & 255; return (r < 128) ? C_MO + 128 * g + r : C_MZ + 128 * g + (r - 128); }
    return n + 8;
}
__device__ __forceinline__ void p0_transpose_item(const float* W, int ldw, int K, bf16* WT, int k0, int n0, int sc0, LAS float* scr, int lane) {
#pragma unroll
    for (int i = 0; i < 32; ++i) { const int kk = 2 * i + (lane >> 5); scr[kk * 33 + (lane & 31)] = W[(size_t)(k0 + kk) * ldw + sc0 + (lane & 31)]; }
    asm volatile("s_waitcnt lgkmcnt(0)" ::: "memory");
    const int c = lane & 7;
#pragma unroll
    for (int j = 0; j < 4; ++j) { const int n = (lane >> 3) + 8 * j; const LAS float* s = scr + (8 * c) * 33 + n;
        u32x4 o; o.x = pk2(s[0 * 33], s[1 * 33]); o.y = pk2(s[2 * 33], s[3 * 33]); o.z = pk2(s[4 * 33], s[5 * 33]); o.w = pk2(s[6 * 33], s[7 * 33]);
        *(u32x4*)(WT + (size_t)(n0 + n) * K + k0 + 8 * c) = o; }
    asm volatile("s_waitcnt lgkmcnt(0)" ::: "memory");
}
__device__ __forceinline__ void phase0(KArgs a, LAS unsigned char* lds, int vcu, int G, int WV) {
    const int tid = TID_OF(WV), lane = tid & 63, wave = WV;
    const float* c = a->in[1]; const float* w_ada = a->in[3]; const float* b_ada = a->in[4];
    float* mod = (float*)(a->ws + WS_MOD);
    if (blockIdx.x == 0 && tid == 0) ((unsigned*)(a->ws + WS_CTL))[CW_QUEUE] = 0u;
    for (int cgp = vcu; cgp < 256; cgp += G) {
        const int b = tid >> 5, part = tid & 31, j0 = 12 * cgp;
        float acc[12];
#pragma unroll
        for (int j = 0; j < 12; ++j) acc[j] = 0.f;
#pragma unroll 8
        for (int ii = 0; ii < 32; ++ii) { const int i = part + 32 * ii;
            const float s = c[b * 1024 + i]; const float sv = s / (1.f + expf(-s));
            const f32x4* wr = (const f32x4*)(w_ada + (size_t)i * 3072 + j0);
            const f32x4 w0 = wr[0], w1 = wr[1], w2 = wr[2];
            acc[0] += sv * w0[0]; acc[1] += sv * w0[1]; acc[2] += sv * w0[2]; acc[3] += sv * w0[3];
            acc[4] += sv * w1[0]; acc[5] += sv * w1[1]; acc[6] += sv * w1[2]; acc[7] += sv * w1[3];
            acc[8] += sv * w2[0]; acc[9] += sv * w2[1]; acc[10] += sv * w2[2]; acc[11] += sv * w2[3]; }
#pragma unroll
        for (int j = 0; j < 12; ++j) { float v = acc[j];
            v += __shfl_xor(v, 1); v += __shfl_xor(v, 2); v += __shfl_xor(v, 4); v += __shfl_xor(v, 8); v += __shfl_xor(v, 16);
            if (part == 0) mod[b * 3072 + j0 + j] = v + b_ada[j0 + j]; }
    }
}

__device__ __forceinline__ void weight_copies(KArgs a, LAS float* scr, int vcu, int G, int wave, int lane) {
    const int gw = vcu * NWAVES + wave, NGW = G * NWAVES;
    constexpr int I_IN = (1024 / 64) * (NPROJ / 32), I_OUT = (2048 / 64) * (1024 / 32);
    bf16* WinT = (bf16*)(a->ws + WS_WIN); bf16* WoutT = (bf16*)(a->ws + WS_WOUT);
    for (int it = gw; it < I_IN + I_OUT; it += NGW) {
        if (it < I_IN) { const int nb = it % (NPROJ / 32), kb = it / (NPROJ / 32); p0_transpose_item(a->in[5], DIN, 1024, WinT, 64 * kb, 32 * nb, win_src_col(32 * nb), scr, lane); }
        else { const int r = it - I_IN, nb = r % 32, kb = r / 32; p0_transpose_item(a->in[17], 1024, 2048, WoutT, 64 * kb, 32 * nb, 32 * nb, scr, lane); }
    }
}

__device__ __forceinline__ void phase1(KArgs a, LAS unsigned char* lds, int vcu, int G, int WV) {
    const int tid = TID_OF(WV), lane = tid & 63, wave = WV;
    const float* x = a->in[0]; const float* norm_w = a->in[2]; const float* w_in = a->in[5]; const float* b_i = a->in[6]; const float* b_f = a->in[7];
    const float* mod = (const float*)(a->ws + WS_MOD);
    bf16* HB = (bf16*)(a->ws + WS_HB); float* LI = (float*)(a->ws + WS_LI); float* LF = (float*)(a->ws + WS_LF);
    LAS float* wg = (LAS float*)lds;
#pragma unroll
    for (int i = tid; i < 1024 * 8; i += NTHREADS) { const int k = i >> 3, q = i & 7;
        wg[(((((k >> 8) * 4 + (k & 3)) * 2 + (q >> 2)) * 64 + ((k & 255) >> 2)) * 4) + (q & 3)] = w_in[(size_t)k * DIN + C_MI + q]; }
    weight_copies(a, (LAS float*)(lds + 32768 + wave * 8448), vcu, G, wave, lane);
    __syncthreads();
    const int gw = vcu * NWAVES + wave, NGW = G * NWAVES;
    for (int grp = gw; grp < MTOK / 16; grp += NGW) {
        const int row0 = grp * 16, b = row0 / SEQ;
        f32x4 am[4], sh[4];
#pragma unroll
        for (int j = 0; j < 4; ++j) { const int col = 4 * lane + 256 * j;
            const f32x4 nw = *(const f32x4*)(norm_w + col), sc = *(const f32x4*)(mod + b * 3072 + 1024 + col);
            am[j] = nw * (sc + 1.0f); sh[j] = *(const f32x4*)(mod + b * 3072 + col); }
        f32x4 vn[4];
        { const f32x4* xr = (const f32x4*)(x + (size_t)row0 * D) + lane;
#pragma unroll
          for (int j = 0; j < 4; ++j) vn[j] = xr[64 * j]; }
        for (int r = 0; r < 16; ++r) { const int row = row0 + r;
            LAS float* wgr = wg; asm volatile("" : "+v"(wgr));
            f32x4 v[4]; float s = 0.f;
#pragma unroll
            for (int j = 0; j < 4; ++j) { v[j] = vn[j]; s += (v[j][0] * v[j][0] + v[j][1] * v[j][1]) + (v[j][2] * v[j][2] + v[j][3] * v[j][3]); }
            if (r < 15) { const f32x4* xr = (const f32x4*)(x + (size_t)(row + 1) * D) + lane;
#pragma unroll
                for (int j = 0; j < 4; ++j) vn[j] = xr[64 * j]; }
            const float rstd = 1.0f / sqrtf(wave_sum(s) * (1.f / D) + EPS);
            float g8[8];
#pragma unroll
            for (int q = 0; q < 8; ++q) g8[q] = 0.f;
            u32x2* o8 = (u32x2*)(HB + (size_t)row * D) + lane;
#pragma unroll
            for (int j = 0; j < 4; ++j) { const f32x4 hv = v[j] * rstd * am[j] + sh[j];
                u32x2 w; w.x = pk2(hv[0], hv[1]); w.y = pk2(hv[2], hv[3]); o8[64 * j] = w;
#pragma unroll
                for (int e = 0; e < 4; ++e) {
                    const f32x4 w0 = *(const LAS f32x4*)(wgr + ((((j * 4 + e) * 2 + 0) * 64 + lane) * 4)), w1 = *(const LAS f32x4*)(wgr + ((((j * 4 + e) * 2 + 1) * 64 + lane) * 4));
                    g8[0] += hv[e] * w0[0]; g8[1] += hv[e] * w0[1]; g8[2] += hv[e] * w0[2]; g8[3] += hv[e] * w0[3];
                    g8[4] += hv[e] * w1[0]; g8[5] += hv[e] * w1[1]; g8[6] += hv[e] * w1[2]; g8[7] += hv[e] * w1[3]; } }
#pragma unroll
            for (int q = 0; q < 8; ++q) g8[q] = wave_sum(g8[q]);
#pragma unroll
            for (int q = 0; q < 4; ++q) {
                if (lane == q) LI[(size_t)row * 4 + q] = g8[q] + b_i[q];
                if (lane == 4 + q) { const float xf = g8[4 + q] + b_f[q]; LF[(size_t)row * 4 + q] = fminf(xf, 0.f) - log1pf(expf(-fabsf(xf))); } }
        }
    }
}

struct EpiProj {
    static constexpr bool PERM = true, AFTER_DRAIN = false;
    bf16 *MQ, *MK, *MV, *GM, *AQ, *AK, *AV, *AZ;
    __device__ __forceinline__ void operator()(const pg8::f32x4 (&acc)[2][2][4][2], const pg8::Unit& u, int wr, int wc, int fr, int fq) const {
        const int pn = u.pn; const int row0 = u.pm * 256 + wr * 64 + fr;
        if (pn >= 12 && pn < 20) {
            const int col = 128 * (pn - 12) + wc * 32 + 8 * fq;
#pragma unroll
            for (int ai = 0; ai < 2; ++ai)
#pragma unroll
                for (int m = 0; m < 4; ++m) { bf16* p = GM + (size_t)(row0 + ai * 128 + m * 16) * 1024 + col;
                    float g[8];
#pragma unroll
                    for (int n = 0; n < 2; ++n)
#pragma unroll
                        for (int e = 0; e < 4; ++e) { const float o = acc[ai][0][m][n][e], z = acc[ai][1][m][n][e]; g[4 * n + e] = z * __builtin_amdgcn_rcpf((1.f + __expf(-o)) * (1.f + __expf(-z))); }
                    u32x4 w; w.x = pk2(g[0], g[1]); w.y = pk2(g[2], g[3]); w.z = pk2(g[4], g[5]); w.w = pk2(g[6], g[7]);
                    *(u32x4*)p = w; }
            return;
        }
        bf16* base; float sc = 1.f; int act = 0; int ct;
        if (pn < 4) { base = MQ; ct = pn; } else if (pn < 8) { base = MK; ct = pn - 4; } else if (pn < 12) { base = MV; ct = pn - 8; }
        else if (pn < 24) { base = AQ; ct = pn - 20; sc = QSCALE; } else if (pn < 28) { base = AK; ct = pn - 24; } else if (pn < 32) { base = AV; ct = pn - 28; }
        else { base = AZ; ct = pn - 32; act = 1; }
        const int col0 = ct * 256 + wc * 32 + 8 * fq;
#pragma unroll
        for (int ai = 0; ai < 2; ++ai)
#pragma unroll
            for (int m = 0; m < 4; ++m) { bf16* rowp = base + (size_t)(row0 + ai * 128 + m * 16) * 1024 + col0;
#pragma unroll
                for (int bj = 0; bj < 2; ++bj) { pg8::f32x4 v0 = acc[ai][bj][m][0], v1 = acc[ai][bj][m][1];
                    if (act) { v0 = (pg8::f32x4){siluf(v0[0]), siluf(v0[1]), siluf(v0[2]), siluf(v0[3])}; v1 = (pg8::f32x4){siluf(v1[0]), siluf(v1[1]), siluf(v1[2]), siluf(v1[3])}; }
                    v0 = v0 * sc; v1 = v1 * sc;
                    u32x4 w; w.x = pk2(v0[0], v0[1]); w.y = pk2(v0[2], v0[3]); w.z = pk2(v1[0], v1[1]); w.w = pk2(v1[2], v1[3]);
                    *(u32x4*)(rowp + bj * 128) = w; } }
    }
};
struct EpiOut {
    static constexpr bool PERM = false, AFTER_DRAIN = false;
    const float* x; const float* mod; float* out; float* rss;
    __device__ __forceinline__ void operator()(const pg8::f32x4 (&acc)[2][2][4][2], const pg8::Unit& u, int wr, int wc, int fr, int fq) const {
        const int col0 = u.pn * 256 + wc * 32 + 4 * fq; const int b = (u.pm * 256) / SEQ;
        pg8::f32x4 gv[2][2];
#pragma unroll
        for (int bj = 0; bj < 2; ++bj)
#pragma unroll
            for (int n = 0; n < 2; ++n) gv[bj][n] = *(const pg8::f32x4*)(mod + b * 3072 + 2048 + col0 + bj * 128 + n * 16);
#pragma unroll
        for (int ai = 0; ai < 2; ++ai)
#pragma unroll
            for (int m = 0; m < 4; ++m) { const int row = u.pm * 256 + ai * 128 + wr * 64 + m * 16 + fr; const size_t off = (size_t)row * D + col0; float ss = 0.f;
#pragma unroll
                for (int bj = 0; bj < 2; ++bj)
#pragma unroll
                    for (int n = 0; n < 2; ++n) { const pg8::f32x4 xv = *(const pg8::f32x4*)(x + off + bj * 128 + n * 16);
                        const pg8::f32x4 o = xv + gv[bj][n] * acc[ai][bj][m][n];
                        ss += (o[0] * o[0] + o[1] * o[1]) + (o[2] * o[2] + o[3] * o[3]);
                        *(pg8::f32x4*)(out + off + bj * 128 + n * 16) = o; }
                ss += __shfl_xor(ss, 16); ss += __shfl_xor(ss, 32);
                if (fq == 0) rss[(size_t)row * 16 + u.pn * 4 + wc] = ss; }
    }
};

__device__ __forceinline__ void phase5(KArgs a, int vcu, int G, int WV) {
    const int tid = TID_OF(WV), lane = tid & 63, wave = WV;
    const float* fnw = a->in[18]; const float* rss = (const float*)(a->ws + WS_RSS); float* out = a->out;
    f32x4 fw[4];
#pragma unroll
    for (int j = 0; j < 4; ++j) fw[j] = *(const f32x4*)(fnw + 4 * lane + 256 * j);
    const int gw = vcu * NWAVES + wave, NGW = G * NWAVES;
    for (int grp = gw; grp < MTOK / 16; grp += NGW)
        for (int r = 0; r < 16; ++r) { const int row = grp * 16 + r;
            const f32x4* pr = (const f32x4*)(rss + (size_t)row * 16);
            const f32x4 p0 = pr[0], p1 = pr[1], p2 = pr[2], p3 = pr[3];
            const float tot = (((p0[0] + p0[1]) + (p0[2] + p0[3])) + ((p1[0] + p1[1]) + (p1[2] + p1[3]))) + (((p2[0] + p2[1]) + (p2[2] + p2[3])) + ((p3[0] + p3[1]) + (p3[2] + p3[3])));
            const float rstd = 1.0f / sqrtf(tot * (1.f / D) + EPS);
            f32x4* o = (f32x4*)(out + (size_t)row * D) + lane;
#pragma unroll
            for (int j = 0; j < 4; ++j) o[64 * j] = o[64 * j] * rstd * fw[j]; }
}

__device__ __forceinline__ void phase5_touch(KArgs a, int vcu, int G, int WV) {
    const int tid = TID_OF(WV), lane = tid & 63, wave = WV;
    const float* rss = (const float*)(a->ws + WS_RSS); float* out = a->out;
    const int gw = vcu * NWAVES + wave, NGW = G * NWAVES;
    for (int grp = gw; grp < MTOK / 16; grp += NGW)
        for (int r = 0; r < 16; ++r) { const int row = grp * 16 + r;
            const f32x4* pr = (const f32x4*)(rss + (size_t)row * 16);
            const f32x4 p0 = pr[0], p1 = pr[1], p2 = pr[2], p3 = pr[3];
            const float tot = (p0[0] + p1[0]) + (p2[0] + p3[0]);
            const float one = (tot == -1.2345f) ? 2.f : 1.f;
            f32x4* o = (f32x4*)(out + (size_t)row * D) + lane;
#pragma unroll
            for (int j = 0; j < 4; ++j) o[64 * j] = o[64 * j] * one; }
}
constexpr int CW_BAR = 4096;
#define XB_TMO      128
#define XB_XCNT(j)  (256  + 64 * (j))
#define XB_XSUB(j)  (1280 + 64 * (j))
#define XB_XGEN(j)  (2304 + 64 * (j))
#define XB_TOP      3328
#define XB_TOPGEN   3392
#define XCD_BAR_WORDS 3456
#define XB_SPIN_CAP (1u << 18)

__device__ __forceinline__ unsigned xb_ld(unsigned* p)              { return __hip_atomic_load(p, __ATOMIC_RELAXED, __HIP_MEMORY_SCOPE_AGENT); }
__device__ __forceinline__ unsigned xb_add(unsigned* p, unsigned v) { return __hip_atomic_fetch_add(p, v, __ATOMIC_RELAXED, __HIP_MEMORY_SCOPE_AGENT); }
__device__ __forceinline__ unsigned xb_xcc_id() { return (unsigned)__builtin_amdgcn_s_getreg((3 << 11) | 20) & 0xFu; }
#define XB_SPIN(cond, bar) do { unsigned _sp = 0; while (cond) { __builtin_amdgcn_s_sleep(1); \
    if ((++_sp & 255u) == 0u) { if (xb_ld(&(bar)[XB_TMO])) break; if (_sp > XB_SPIN_CAP) { atomicAdd(&(bar)[XB_TMO], 1u); break; } } } } while (0)

struct XcdBarrier {
    unsigned* bar; unsigned x;
    volatile LAS unsigned* st;
};

__device__ __forceinline__ XcdBarrier xcd_barrier_post(unsigned* bar, volatile LAS unsigned* st, bool t0) {
    XcdBarrier b; b.bar = bar; b.x = xb_xcc_id(); b.st = st;
    if (t0) (void)xb_add(&bar[XB_XCNT(b.x)], 1u);
    return b;
}
__device__ __forceinline__ void xcd_barrier_complete(unsigned* bar, unsigned x, unsigned& nloc, unsigned& nx) {
    const unsigned G = gridDim.x * gridDim.y * gridDim.z;
    unsigned sum, cnt, mine, sp = 0u;
    for (;;) {
        sum = 0u; cnt = 0u; mine = 0u;
#pragma unroll
        for (unsigned j = 0; j < 16; ++j) { const unsigned c = xb_ld(&bar[XB_XCNT(j)]); sum += c; cnt += (c > 0u) ? 1u : 0u; mine = (j == x) ? c : mine; }
        if (sum == G) break;
        __builtin_amdgcn_s_sleep(1);
        if ((++sp & 255u) == 0u) { if (xb_ld(&bar[XB_TMO])) break; if (sp > XB_SPIN_CAP) { atomicAdd(&bar[XB_TMO], 1u); break; } }
    }
    nloc = mine > 0u ? mine : 1u; nx = cnt > 0u ? cnt : 1u;
}

__device__ __forceinline__ void xcd_barrier(const XcdBarrier& b, bool t0) {
    asm volatile("s_waitcnt vmcnt(0)" ::: "memory");
    __syncthreads();
    if (t0) {
        unsigned* bar = b.bar;
        __builtin_amdgcn_s_waitcnt(0);
        unsigned nloc = b.st[0], nx = b.st[1];
        if (nloc == 0u) { xcd_barrier_complete(bar, b.x, nloc, nx); b.st[0] = nloc; b.st[1] = nx; }
        const unsigned old = xb_add(&bar[XB_XSUB(b.x)], 1u);
        const unsigned gen = old / nloc;
        if (old + 1u == (gen + 1u) * nloc) {
            __builtin_amdgcn_fence(__ATOMIC_RELEASE, "agent");
            asm volatile("s_waitcnt vmcnt(0)" ::: "memory");
            const unsigned og = xb_add(&bar[XB_TOP], 1u);
            const unsigned tg = og / nx;
            if (og + 1u == (tg + 1u) * nx) xb_add(&bar[XB_TOPGEN], 1u);
            else XB_SPIN(xb_ld(&bar[XB_TOPGEN]) == tg, bar);
            __builtin_amdgcn_fence(__ATOMIC_ACQUIRE, "agent");
            xb_add(&bar[XB_XGEN(b.x)], 1u);
            asm volatile("s_waitcnt vmcnt(0)" ::: "memory");
        } else {
            XB_SPIN(xb_ld(&bar[XB_XGEN(b.x)]) == gen, bar);
            __builtin_amdgcn_fence(__ATOMIC_ACQUIRE, "agent");
            asm volatile("s_waitcnt vmcnt(0)" ::: "memory");
        }
    }
    __syncthreads();
}

__device__ __forceinline__ int crow(int r, int hi) { return (r & 3) + 8 * (r >> 2) + 4 * hi; }
typedef short v4i16_t __attribute__((ext_vector_type(4)));
__device__ __forceinline__ s16x4 ldtr(const LAS unsigned char* p) { return __builtin_bit_cast(s16x4, __builtin_amdgcn_ds_read_tr16_b64_v4i16((LAS v4i16_t*)p)); }
__device__ __forceinline__ bf16x8 ldfrag(const LAS unsigned char* p) { return *(const LAS bf16x8*)p; }
__device__ __forceinline__ float halfswap_max(float m) { auto rr = __builtin_amdgcn_permlane32_swap(__float_as_uint(m), __float_as_uint(m), false, false); return fmaxf(__uint_as_float(rr[0]), __uint_as_float(rr[1])); }
__device__ __forceinline__ float halfswap_sum(float m) { auto rr = __builtin_amdgcn_permlane32_swap(__float_as_uint(m), __float_as_uint(m), false, false); return __uint_as_float(rr[0]) + __uint_as_float(rr[1]); }
__device__ __forceinline__ bf16x8 pack8(const f32x16& p, int base) {
    u32x4 w; w.x = pk2(p[base + 0], p[base + 1]); w.y = pk2(p[base + 2], p[base + 3]); w.z = pk2(p[base + 4], p[base + 5]); w.w = pk2(p[base + 6], p[base + 7]);
    return __builtin_bit_cast(bf16x8, w);
}
__device__ __forceinline__ int t5_bucket(int n) {
    if (n < 16) return n;
    int bkt = 16;
    bkt += (n >= 19); bkt += (n >= 21); bkt += (n >= 24); bkt += (n >= 27); bkt += (n >= 31); bkt += (n >= 35); bkt += (n >= 40); bkt += (n >= 46);
    bkt += (n >= 52); bkt += (n >= 59); bkt += (n >= 67); bkt += (n >= 77); bkt += (n >= 87); bkt += (n >= 99); bkt += (n >= 113);
    return bkt;
}

namespace att {
constexpr int L_RING = 0;
constexpr int L_TB = 65536;
constexpr int L_WSF = L_TB + 512;
constexpr int L_STAGE = L_WSF + 2048;
constexpr int SROW = 132;
constexpr float THR = 8.0f;

__device__ __forceinline__ void attn_unit(KArgs a, LAS unsigned char* lds, int WV, int b, int h, int qb, float lam, bool dummy = false) {
    int tid_ = TID_OF(WV); asm volatile("" : "+v"(tid_));
    const int tid = tid_, lane = tid & 63, r32 = lane & 31, hi = lane >> 5, wave = WV;
    const int rb = wave & 3, mp = wave >> 2;
    bf16* AQ = (bf16*)(a->ws + WS_AQ); const bf16* AK = (const bf16*)(a->ws + WS_AK); const bf16* AV = (const bf16*)(a->ws + WS_AV); const bf16* AZ = (const bf16*)(a->ws + WS_AZ);
    const float* relb = a->in[16]; const float* anw = a->in[15];
    const size_t rowbase = (size_t)b * SEQ; const int q0 = qb * 128;
    const int qmin = q0 + 32 * rb, qrow = qmin + r32;
    LAS float* tb = (LAS float*)(lds + L_TB); LAS float* wsf = (LAS float*)(lds + L_WSF) + wave * 64; LAS float* stage = (LAS float*)(lds + L_STAGE);
    bf16x8 qf[4];
#pragma unroll
    for (int ks = 0; ks < 4; ++ks) qf[ks] = *(const bf16x8*)(AQ + (rowbase + qrow) * 1024 + h * 128 + mp * 64 + ks * 16 + hi * 8);
    if (tid < 128) tb[tid] = (tid < 113) ? (relb[t5_bucket(tid) * AH + h] - relb[31 * AH + h]) * LOG2E : 0.f;
    const int lc = tid & 15, lkv = tid >> 4;
    const bf16* kg = AK + (rowbase + lkv) * 1024 + h * 128 + lc * 8;
    const bf16* vg = AV + (rowbase + lkv) * 1024 + h * 128 + lc * 8;
    const int kofs0 = lc * 1024 + ((lkv ^ lc) * 16), kofs1 = lc * 1024 + (((lkv + 32) ^ lc) * 16);
    const int vofs0 = 16384 + (lc >> 2) * 4096 + (lkv >> 4) * 1024 + (lkv & 15) * 64 + (lc & 3) * 16, vofs1 = vofs0 + 2048;
    const int NT = 2 * qb + 2;
    u32x4 kr0, kr1, vr0, vr1;
    kr0 = *(const u32x4*)kg; kr1 = *(const u32x4*)(kg + 32 * 1024); vr0 = *(const u32x4*)vg; vr1 = *(const u32x4*)(vg + 32 * 1024);
    *(LAS u32x4*)(lds + L_RING + kofs0) = kr0; *(LAS u32x4*)(lds + L_RING + kofs1) = kr1; *(LAS u32x4*)(lds + L_RING + vofs0) = vr0; *(LAS u32x4*)(lds + L_RING + vofs1) = vr1;
    __syncthreads();
    f32x16 o[4];
#pragma unroll
    for (int e = 0; e < 4; ++e)
#pragma unroll
        for (int r = 0; r < 16; ++r) o[e][r] = 0.f;
    float mref = 0.f, lsum = 0.f;
    const int vlane = ((lane >> 4) & 1) * 32 + (lane & 3) * 8 + (4 * hi + ((lane & 15) >> 2)) * 64;
    for (int j = 0; j < NT; ++j) {
        const bool more = (j + 1 < NT);
        if (more) { const size_t go = (size_t)(j + 1) * 64 * 1024; kr0 = *(const u32x4*)(kg + go); kr1 = *(const u32x4*)(kg + go + 32 * 1024); vr0 = *(const u32x4*)(vg + go); vr1 = *(const u32x4*)(vg + go + 32 * 1024); }
        const int kv0 = 64 * j;
        if (kv0 <= qmin + 31) {
            const LAS unsigned char* kb = lds + L_RING + (j & 1) * 32768; const LAS unsigned char* vb = kb + 16384 + vlane;
            f32x16 s0, s1;
#pragma unroll
            for (int r = 0; r < 16; ++r) { s0[r] = 0.f; s1[r] = 0.f; }
#pragma unroll
            for (int ks = 0; ks < 4; ++ks) { const int cgi = mp * 8 + 2 * ks + hi;
                const bf16x8 a0 = ldfrag(kb + cgi * 1024 + ((r32 ^ cgi) * 16)), a1 = ldfrag(kb + cgi * 1024 + (((r32 + 32) ^ cgi) * 16));
                s0 = __builtin_amdgcn_mfma_f32_32x32x16_bf16(a0, qf[ks], s0, 0, 0, 0);
                s1 = __builtin_amdgcn_mfma_f32_32x32x16_bf16(a1, qf[ks], s1, 0, 0, 0); }
            if (qmin - (kv0 + 63) < 113) {
#pragma unroll
                for (int r = 0; r < 16; ++r) { const int d0 = qrow - (kv0 + crow(r, hi)); const int i0 = min(max(d0, 0), 127), i1 = min(max(d0 - 32, 0), 127);
                    s0[r] += tb[i0]; s1[r] += tb[i1]; }
            }
            if (kv0 + 63 > qmin) {
#pragma unroll
                for (int r = 0; r < 16; ++r) { const int kv = kv0 + crow(r, hi); if (kv > qrow) s0[r] = -INFINITY; if (kv + 32 > qrow) s1[r] = -INFINITY; }
            }
            float rm = fmaxf(s0[0], s1[0]);
#pragma unroll
            for (int r = 1; r < 16; ++r) rm = fmaxf(rm, fmaxf(s0[r], s1[r]));
            rm = halfswap_max(rm);
            if (j == 0) { mref = rm; }
            else if (__any(rm - mref > THR)) {
                const float mnew = fmaxf(mref, rm); const float f = __builtin_amdgcn_exp2f(mref - mnew); mref = mnew; lsum *= f;
                if (hi == 0) wsf[r32] = f;
#pragma unroll
                for (int r = 0; r < 16; ++r) { const float fr_ = wsf[crow(r, hi)];
#pragma unroll
                    for (int e = 0; e < 4; ++e) o[e][r] *= fr_; }
            }
            float ps = 0.f;
#pragma unroll
            for (int r = 0; r < 16; ++r) { s0[r] = __builtin_amdgcn_exp2f(s0[r] - mref); s1[r] = __builtin_amdgcn_exp2f(s1[r] - mref); ps += s0[r] + s1[r]; }
            lsum += ps;
            const bf16x8 pa0 = pack8(s0, 0), pa1 = pack8(s0, 8), pa2 = pack8(s1, 0), pa3 = pack8(s1, 8);
#pragma unroll
            for (int e = 0; e < 4; ++e) {
                s16x4 lo[4], hh[4];
#pragma unroll
                for (int ks = 0; ks < 4; ++ks) { lo[ks] = ldtr(vb + e * 4096 + ks * 1024); hh[ks] = ldtr(vb + e * 4096 + ks * 1024 + 512); }
#define ATT_VF(k) (bf16x8){lo[k][0], lo[k][1], lo[k][2], lo[k][3], hh[k][0], hh[k][1], hh[k][2], hh[k][3]}
                o[e] = __builtin_amdgcn_mfma_f32_32x32x16_bf16(pa0, ATT_VF(0), o[e], 0, 0, 0);
                o[e] = __builtin_amdgcn_mfma_f32_32x32x16_bf16(pa1, ATT_VF(1), o[e], 0, 0, 0);
                o[e] = __builtin_amdgcn_mfma_f32_32x32x16_bf16(pa2, ATT_VF(2), o[e], 0, 0, 0);
                o[e] = __builtin_amdgcn_mfma_f32_32x32x16_bf16(pa3, ATT_VF(3), o[e], 0, 0, 0);
#undef ATT_VF
            }
        }
        if (more) { LAS unsigned char* nb = lds + L_RING + ((j + 1) & 1) * 32768;
            *(LAS u32x4*)(nb + kofs0) = kr0; *(LAS u32x4*)(nb + kofs1) = kr1; *(LAS u32x4*)(nb + vofs0) = vr0; *(LAS u32x4*)(nb + vofs1) = vr1; }
        __syncthreads();
    }
    const float ltot = halfswap_sum(lsum);
    const float sc = (mp == 0 ? 1.0f : -lam) / ltot;
    if (hi == 0) wsf[r32] = sc;
    float scr[16];
#pragma unroll
    for (int r = 0; r < 16; ++r) scr[r] = wsf[crow(r, hi)];
    if (mp == 0) {
#pragma unroll
        for (int e = 0; e < 4; ++e)
#pragma unroll
            for (int r = 0; r < 16; ++r) stage[(32 * rb + crow(r, hi)) * SROW + 32 * e + r32] = o[e][r] * scr[r];
    }
    __syncthreads();
    if (mp == 1) {
#pragma unroll
        for (int e = 0; e < 4; ++e)
#pragma unroll
            for (int r = 0; r < 16; ++r) stage[(32 * rb + crow(r, hi)) * SROW + 32 * e + r32] += o[e][r] * scr[r];
    }
    __syncthreads();
    { const int row = tid >> 2, part = tid & 3;
      const LAS f32x4* sp = (const LAS f32x4*)(stage + row * SROW + 32 * part);
      f32x4 v[8]; float ss = 0.f;
#pragma unroll
      for (int i = 0; i < 8; ++i) { v[i] = sp[i]; ss += (v[i][0] * v[i][0] + v[i][1] * v[i][1]) + (v[i][2] * v[i][2] + v[i][3] * v[i][3]); }
      ss += __shfl_xor(ss, 1); ss += __shfl_xor(ss, 2);
      const float rs = 0.8f / sqrtf(ss * (1.f / 128.f) + EPS);
      const size_t go = (rowbase + q0 + row) * 1024 + h * 128 + 32 * part;
      const u32x4* zp = (const u32x4*)(AZ + go); u32x4* op = dummy ? (u32x4*)((bf16*)(a->ws + WS_END) + (size_t)row * 1024 + h * 128 + 32 * part) : (u32x4*)(AQ + go); const f32x4* wp = (const f32x4*)(anw + 32 * part);
#pragma unroll
      for (int i = 0; i < 4; ++i) { const u32x4 z = zp[i]; const f32x4 w0 = wp[2 * i], w1 = wp[2 * i + 1]; const f32x4 x0 = v[2 * i] * rs * w0, x1 = v[2 * i + 1] * rs * w1;
          u32x4 w; w.x = pk2(x0[0] * bflo(z.x), x0[1] * bfhi(z.x)); w.y = pk2(x0[2] * bflo(z.y), x0[3] * bfhi(z.y));
          w.z = pk2(x1[0] * bflo(z.z), x1[1] * bfhi(z.z)); w.w = pk2(x1[2] * bflo(z.w), x1[3] * bfhi(z.w)); op[i] = w; } }
    __syncthreads();
}
}

namespace mls {
#ifdef MLS_KEEP_SB
#define MLS_SB __builtin_amdgcn_sched_barrier(0)
#else
#define MLS_SB do { } while (0)
#endif
constexpr int L_Q = 0;
constexpr int L_K = 32768;
constexpr int L_STAGE = 0;
constexpr int L_KW = 66560;
constexpr int L_V = L_KW + 32768;
constexpr int L_P = L_V + 32768;
constexpr int L_SC = L_P + 8192;
constexpr int L_N = L_SC + 18 * 256;
constexpr int L_CW = L_N + 1024;
constexpr int L_MW = L_CW + 8192;
constexpr int L_END = L_MW + 1024;
static_assert(L_END <= LDS_BYTES, "mLSTM LDS map");
constexpr int SROW = 260;

__device__ __forceinline__ void mlstm_unit(KArgs a, LAS unsigned char* lds, int WV, int b, int h) {
    int tid_ = TID_OF(WV); asm volatile("" : "+v"(tid_));
    const int tid = tid_, lane = tid & 63, r32 = lane & 31, hi = lane >> 5, wave = WV;
    const bf16* MQ = (const bf16*)a->out; unsigned char* wsb = a->ws;
#define MK (MQ + (size_t)MTOK * 1024)
#define MV ((const bf16*)(wsb + WS_MV))
#define GM ((const bf16*)(wsb + WS_GM))
#define HM ((bf16*)(wsb + WS_HB))
#define LI ((const float*)(wsb + WS_LI))
#define LF ((const float*)(wsb + WS_LF))
    const float* cqw = a->in[8]; const float* ckw = a->in[9];
    LAS float* S_psum = (LAS float*)(lds + L_SC) + 768; LAS float* S_qn = S_psum + 256;
    LAS float* nperm = (LAS float*)(lds + L_N); LAS float* cw = (LAS float*)(lds + L_CW); LAS float* stage = (LAS float*)(lds + L_STAGE);
    f32x16 X[8];
#pragma unroll
    for (int i = 0; i < 8; ++i)
#pragma unroll
        for (int r = 0; r < 16; ++r) X[i][r] = 0.f;
    if (tid < 256) nperm[tid] = 0.f;
    for (int i = tid; i < 2048; i += NTHREADS) { const int j = (i >> 8) & 3, d = i & 255; cw[i] = (i < 1024 ? cqw : ckw)[j * 1024 + h * 256 + d]; }
    if (tid < 256) ((LAS float*)(lds + L_MW))[tid] = a->in[10][h * 256 + tid];
    float m_prev = 0.f;
    const int tg = WV >> 1;
#define MLS_LANE_IDS int tf_ = tid; asm volatile("" : "+v"(tf_));   \
    const int dp = tf_ & 127, d0 = 2 * dp; \
    const int ppos = (d0 & ~12) | ((d0 & 4) << 1) | ((d0 & 8) >> 1);     \
    const int qch = ppos >> 3, qbo = (ppos & 7) * 2;
#define MLS_LOAD_ROUND(Rq, Rk, Rv, cc, rd) do { const int t0_ = 16 * (rd) + 4 * tg; int tl_ = tid; asm volatile("" : "+v"(tl_)); const int d0 = 2 * (tl_ & 127);     \
        const size_t ub_ = ((size_t)b * SEQ + 64 * (cc) + t0_) * 1024 + h * 256; \
        const bf16* qb_ = MQ + ub_ - 3 * 1024; const bf16* kb_ = MK + ub_ - 3 * 1024; const bf16* vb_ = MV + ub_; const int tf_ = 64 * (cc) + t0_ - 3; \
        _Pragma("unroll") for (int i = 0; i < 7; ++i) { if (tf_ + i >= 0) { Rq[i] = *(const unsigned*)(qb_ + (i * 1024 + d0)); Rk[i] = *(const unsigned*)(kb_ + (i * 1024 + d0)); } else { Rq[i] = 0u; Rk[i] = 0u; } } \
        _Pragma("unroll") for (int i = 0; i < 4; ++i) Rv[i] = *(const unsigned*)(vb_ + (i * 1024 + d0)); } while (0)
#define MLS_FILL_ROUND(Rq, Rk, Rv, rd) do { const int t0_ = 16 * (rd) + 4 * tg; MLS_LANE_IDS \
        f32x2 wq_[4], wk_[4]; \
        _Pragma("unroll") for (int j = 0; j < 4; ++j) { wq_[j] = *(const LAS f32x2*)(cw + j * 256 + d0); wk_[j] = *(const LAS f32x2*)(cw + 1024 + j * 256 + d0); } \
        float kw0_[4], kw1_[4]; \
        _Pragma("unroll") for (int t = 0; t < 4; ++t) { const int row = t0_ + t; \
            float q0 = 0.f, q1 = 0.f, k0 = 0.f, k1 = 0.f; \
            _Pragma("unroll") for (int j = 0; j < 4; ++j) { const unsigned uq = Rq[t + j], uk = Rk[t + j]; \
                q0 += wq_[j][0] * bflo(uq); q1 += wq_[j][1] * bfhi(uq); k0 += wk_[j][0] * bflo(uk); k1 += wk_[j][1] * bfhi(uk); } \
            q0 = siluf(q0) * 0.0625f; q1 = siluf(q1) * 0.0625f; k0 = siluf(k0); k1 = siluf(k1); \
            const int ro_ = row * 512 + ((qch ^ (row & 15)) * 16) + qbo; \
            *(LAS unsigned*)(lds + L_Q + ro_) = pk2(q0, q1); *(LAS unsigned*)(lds + L_K + ro_) = pk2(k0, k1); \
            const float wsr = S_ws[row]; kw0_[t] = k0 * wsr; kw1_[t] = k1 * wsr; } \
        const int cs_ = t0_ >> 3, bs_ = (t0_ & 7) * 2; \
        { const int d = d0; const int ro_ = d * 128 + ((cs_ ^ ((d >> 1) & 7)) * 16) + bs_; \
          u32x2 w; w.x = pk2(kw0_[0], kw0_[1]); w.y = pk2(kw0_[2], kw0_[3]); *(LAS u32x2*)(lds + L_KW + ro_) = w; \
          u32x2 wv; wv.x = (Rv[0] & 0xffffu) | (Rv[1] << 16); wv.y = (Rv[2] & 0xffffu) | (Rv[3] << 16); *(LAS u32x2*)(lds + L_V + ro_) = wv; } \
        { const int d = d0 + 1; const int ro_ = d * 128 + ((cs_ ^ ((d >> 1) & 7)) * 16) + bs_; \
          u32x2 w; w.x = pk2(kw1_[0], kw1_[1]); w.y = pk2(kw1_[2], kw1_[3]); *(LAS u32x2*)(lds + L_KW + ro_) = w; \
          u32x2 wv; wv.x = (Rv[0] >> 16) | (Rv[1] & 0xffff0000u); wv.y = (Rv[2] >> 16) | (Rv[3] & 0xffff0000u); *(LAS u32x2*)(lds + L_V + ro_) = wv; } \
    } while (0)
    unsigned RAq[7], RAk[7], RAv[4];
    MLS_LOAD_ROUND(RAq, RAk, RAv, 0, 0);
    float pf_lf = 0.f, pf_li = 0.f;
    if (wave == 0) { const size_t ub_ = (size_t)b * SEQ * 4 + h; pf_lf = (LF + ub_)[lane * 4]; pf_li = (LI + ub_)[lane * 4]; }
#ifdef STAMP_SEG
    unsigned long long seg_acc = 0ull, seg_t = __builtin_amdgcn_s_memrealtime();
#define SEGT(k) do { const unsigned long long n_ = __builtin_amdgcn_s_memrealtime(); if ((k) == STAMP_SEG) seg_acc += n_ - seg_t; seg_t = n_; } while (0)
#else
#define SEGT(k) do { } while (0)
#endif
    for (int c = 0; c < SEQ / MCH; ++c) {
        const size_t row0 = (size_t)b * SEQ + 64 * c;
        LAS float* S_alpha = (LAS float*)(lds + L_SC) + (c & 1) * 384; LAS float* S_beta = S_alpha + 64; LAS float* S_iw = S_alpha + 128; LAS float* S_clamp = S_alpha + 192; LAS float* S_ws = S_alpha + 256; LAS float* S_misc = S_alpha + 320;
        if (wave == 0) {
            const float lf = pf_lf, li = pf_li;
            if (c + 1 < SEQ / MCH) { const size_t ub_ = (row0 + 64) * 4 + h; pf_lf = (LF + ub_)[lane * 4]; pf_li = (LI + ub_)[lane * 4]; }
#define MLS_DPP(old_, src_, ctrl_, rmask_) __uint_as_float((unsigned)__builtin_amdgcn_update_dpp((int)__float_as_uint(old_), (int)__float_as_uint(src_), ctrl_, rmask_, 0xf, false))
            float bt = lf;
            bt += MLS_DPP(0.f, bt, 0x111, 0xf); bt += MLS_DPP(0.f, bt, 0x112, 0xf); bt += MLS_DPP(0.f, bt, 0x114, 0xf); bt += MLS_DPP(0.f, bt, 0x118, 0xf);
            bt += MLS_DPP(0.f, bt, 0x142, 0xa); bt += MLS_DPP(0.f, bt, 0x143, 0xc);
            const float beta = li - bt; float cm = beta; const float ninf = -INFINITY;
            cm = fmaxf(cm, MLS_DPP(ninf, cm, 0x111, 0xf)); cm = fmaxf(cm, MLS_DPP(ninf, cm, 0x112, 0xf)); cm = fmaxf(cm, MLS_DPP(ninf, cm, 0x114, 0xf)); cm = fmaxf(cm, MLS_DPP(ninf, cm, 0x118, 0xf));
            cm = fmaxf(cm, MLS_DPP(ninf, cm, 0x142, 0xa)); cm = fmaxf(cm, MLS_DPP(ninf, cm, 0x143, 0xc));
#undef MLS_DPP
            const float mx = fmaxf(cm, m_prev);
            S_alpha[lane] = -mx; S_beta[lane] = beta; S_iw[lane] = __expf(m_prev - mx); S_clamp[lane] = __expf(-(bt + mx));
            const float cmL = __shfl(cm, 63), bL = __shfl(bt, 63); const float mxL = fmaxf(m_prev, cmL);
            S_ws[lane] = __expf(beta - mxL);
            if (lane == 0) S_misc[0] = __expf(m_prev - mxL);
            m_prev = bL + mxL;
        }
        __syncthreads();
        SEGT(0);
        unsigned tch0 = 0u, tch1 = 0u;
        { unsigned RBq[7], RBk[7], RBv[4];
          MLS_LOAD_ROUND(RBq, RBk, RBv, c, 1);
          MLS_FILL_ROUND(RAq, RAk, RAv, 0);
          __builtin_amdgcn_sched_barrier(0);
          MLS_LOAD_ROUND(RAq, RAk, RAv, c, 2);
          MLS_FILL_ROUND(RBq, RBk, RBv, 1);
          __builtin_amdgcn_sched_barrier(0);
          MLS_LOAD_ROUND(RBq, RBk, RBv, c, 3);
          MLS_FILL_ROUND(RAq, RAk, RAv, 2);
          __builtin_amdgcn_sched_barrier(0);
          MLS_FILL_ROUND(RBq, RBk, RBv, 3); }
        __builtin_amdgcn_sched_barrier(0);
        if (c + 1 < SEQ / MCH) { int tt_ = tid; asm volatile("" : "+v"(tt_));
            const int row = (tt_ >> 2) & 63, seg = tt_ & 3, mt = tt_ >> 8;
            const size_t eo = (row0 + 64 + row) * 1024 + h * 256 + seg * 64;
            tch0 = *(const unsigned*)((mt ? MK : MQ) + eo); tch1 = *(const unsigned*)((mt ? GM : MV) + eo); }
        __syncthreads();
        SEGT(1);
        f32x16 num[2];
        {
            int lo_ = lane; asm volatile("" : "+v"(lo_));
            const int l15 = lo_ & 15, kq = lo_ >> 4, r32a = lo_ & 31, hia = lo_ >> 5;
            const int si = wave >> 1, ti0 = 2 * (wave & 1);
            f32x4 sa[2] = {(f32x4){0.f, 0.f, 0.f, 0.f}, (f32x4){0.f, 0.f, 0.f, 0.f}};
            { const int y = kq ^ l15; const int rowoff = l15 * 512;
              int b4[4];
#pragma unroll
              for (int j = 0; j < 4; ++j) b4[j] = rowoff + (((4 * j) ^ y) * 16);
              const LAS unsigned char* kbase = lds + L_K + si * 8192; const LAS unsigned char* qbase = lds + L_Q + ti0 * 8192;
#pragma unroll
              for (int kk = 0; kk < 8; ++kk) { const int o_ = b4[kk & 3] + (kk >> 2) * 256;
                  const bf16x8 ka = ldfrag(kbase + o_);
                  const bf16x8 q0_ = ldfrag(qbase + o_), q1_ = ldfrag(qbase + 8192 + o_);
                  sa[0] = __builtin_amdgcn_mfma_f32_16x16x32_bf16(ka, q0_, sa[0], 0, 0, 0);
                  sa[1] = __builtin_amdgcn_mfma_f32_16x16x32_bf16(ka, q1_, sa[1], 0, 0, 0); } }
#pragma unroll
            for (int u = 0; u < 2; ++u) { const int ti = ti0 + u, t = 16 * ti + l15, s_ = 16 * si + 4 * kq;
                const float al = S_alpha[t]; const f32x4 bt4 = *(const LAS f32x4*)(S_beta + s_); float pv_[4]; float psum = 0.f;
#pragma unroll
                for (int r = 0; r < 4; ++r) { pv_[r] = (s_ + r <= t) ? sa[u][r] * __expf(al + bt4[r]) : 0.f; psum += pv_[r]; }
                psum += __shfl_xor(psum, 16); psum += __shfl_xor(psum, 32);
                if (kq == 0) S_psum[si * 64 + t] = psum;
                u32x2 w; w.x = pk2(pv_[0], pv_[1]); w.y = pk2(pv_[2], pv_[3]);
                const int cp = 2 * si + (kq >> 1);
                *(LAS u32x2*)(lds + L_P + t * 128 + ((cp ^ ((t >> 1) & 7)) * 16) + 8 * (kq & 1)) = w; }
#pragma unroll
            for (int r = 0; r < 16; ++r) { num[0][r] = 0.f; num[1][r] = 0.f; }
            { const int yq = hia ^ (r32a & 15); const int rowoff = r32a * 512;
              int b8[8];
#pragma unroll
              for (int g = 0; g < 8; ++g) b8[g] = rowoff + (((2 * g) ^ yq) * 16);
              const LAS unsigned char* qbase = lds + L_Q;
#pragma unroll
              for (int dt = 0; dt < 8; ++dt) { MLS_SB;
#pragma unroll
                  for (int sp = 0; sp < 2; ++sp) { const bf16x8 xb = pack8(X[dt], 8 * sp); const int G_ = 2 * dt + sp; const int o_ = b8[G_ & 7] + (G_ >> 3) * 256;
                      const bf16x8 qa0 = ldfrag(qbase + o_), qa1 = ldfrag(qbase + 16384 + o_);
                      num[0] = __builtin_amdgcn_mfma_f32_32x32x16_bf16(qa0, xb, num[0], 0, 0, 0);
                      num[1] = __builtin_amdgcn_mfma_f32_32x32x16_bf16(qa1, xb, num[1], 0, 0, 0); } } }
            __builtin_amdgcn_sched_barrier(0);
            { int to_ = tid; asm volatile("" : "+v"(to_));
              const int t = to_ >> 3, part = to_ & 7; float accn = 0.f;
#pragma unroll
              for (int i = 0; i < 4; ++i) { const int ch = 4 * part + i; const u32x4 qq = *(const LAS u32x4*)(lds + L_Q + t * 512 + ((ch ^ (t & 15)) * 16));
                  const f32x4 n0 = *(const LAS f32x4*)(nperm + 8 * ch), n1 = *(const LAS f32x4*)(nperm + 8 * ch + 4);
                  accn += bflo(qq.x) * n0[0] + bfhi(qq.x) * n0[1] + bflo(qq.y) * n0[2] + bfhi(qq.y) * n0[3] + bflo(qq.z) * n1[0] + bfhi(qq.z) * n1[1] + bflo(qq.w) * n1[2] + bfhi(qq.w) * n1[3]; }
              accn += __shfl_xor(accn, 1); accn += __shfl_xor(accn, 2); accn += __shfl_xor(accn, 4);
              if (part == 0) S_qn[t] = accn; }
        }
        __syncthreads();
        SEGT(2);
        u32x4 gz[4];
        {
            int lo_ = lane; asm volatile("" : "+v"(lo_));
            const int r32a = lo_ & 31, hia = lo_ >> 5;
            const int e = 32 * wave + r32a;
            const int yk = hia ^ ((r32a >> 1) & 7); const int rowoff = r32a * 128;
            int b4[4];
#pragma unroll
            for (int ks = 0; ks < 4; ++ks) b4[ks] = rowoff + (((2 * ks) ^ yk) * 16);
            bf16x8 vf[4];
#pragma unroll
            for (int ks = 0; ks < 4; ++ks) vf[ks] = ldfrag(lds + L_V + wave * 4096 + b4[ks]);
#pragma unroll
            for (int tt = 0; tt < 2; ++tt) {
#pragma unroll
                for (int g = 0; g < 4; ++g) { const f32x4 iw4 = *(const LAS f32x4*)(S_iw + 32 * tt + 8 * g + 4 * hia);
#pragma unroll
                    for (int q = 0; q < 4; ++q) num[tt][4 * g + q] *= iw4[q]; }
#pragma unroll
                for (int ks = 0; ks < 4; ++ks) { const bf16x8 pa = ldfrag(lds + L_P + tt * 4096 + b4[ks]);
                    num[tt] = __builtin_amdgcn_mfma_f32_32x32x16_bf16(pa, vf[ks], num[tt], 0, 0, 0); }
#pragma unroll
                for (int r = 0; r < 16; ++r) stage[(32 * tt + crow(r, hia)) * SROW + e] = num[tt][r];
            }
            if (c + 1 < SEQ / MCH) MLS_LOAD_ROUND(RAq, RAk, RAv, c + 1, 0);
#ifndef MLS_GATE_LATE
            { int to2_ = tid; asm volatile("" : "+v"(to2_)); const int t = to2_ >> 3, part = to2_ & 7;
              const u32x4* gp = (const u32x4*)(GM + row0 * 1024 + h * 256 + (t * 1024 + 32 * part));
#pragma unroll
              for (int i = 0; i < 4; ++i) gz[i] = gp[i]; }
#endif
            const float decay = S_misc[0];
#pragma unroll
            for (int dt = 0; dt < 8; ++dt) { MLS_SB;
#pragma unroll
                for (int r = 0; r < 16; ++r) X[dt][r] *= decay;
#pragma unroll
                for (int ks = 0; ks < 4; ++ks) { const bf16x8 ka = ldfrag(lds + L_KW + dt * 4096 + b4[ks]);
                    X[dt] = __builtin_amdgcn_mfma_f32_32x32x16_bf16(ka, vf[ks], X[dt], 0, 0, 0); } }
            __builtin_amdgcn_sched_barrier(0);
            int to_ = tid; asm volatile("" : "+v"(to_));
            if (to_ < 256) { const int d = to_; float s = 0.f;
#pragma unroll
                for (int i = 0; i < 8; ++i) { const u32x4 kk = *(const LAS u32x4*)(lds + L_KW + d * 128 + i * 16);
                    s += (bflo(kk.x) + bfhi(kk.x)) + (bflo(kk.y) + bfhi(kk.y)) + (bflo(kk.z) + bfhi(kk.z)) + (bflo(kk.w) + bfhi(kk.w)); }
                const int p = (d & ~12) | ((d & 4) << 1) | ((d & 8) >> 1);
                nperm[p] = decay * nperm[p] + s; }
        }
        __syncthreads();
        SEGT(3);
        { int te_ = tid; asm volatile("" : "+v"(te_)); const int t = te_ >> 3, part = te_ & 7;
          const float den = S_iw[t] * S_qn[t] + ((S_psum[t] + S_psum[64 + t]) + (S_psum[128 + t] + S_psum[192 + t]));
          const float hd = 1.0f / fmaxf(fabsf(den), S_clamp[t]);
          const LAS f32x4* sp = (const LAS f32x4*)(stage + t * SROW + 32 * part);
          f32x4 v[8]; float s1 = 0.f;
#pragma unroll
          for (int i = 0; i < 8; ++i) { v[i] = sp[i] * hd; s1 += (v[i][0] + v[i][1]) + (v[i][2] + v[i][3]); }
          s1 += __shfl_xor(s1, 1); s1 += __shfl_xor(s1, 2); s1 += __shfl_xor(s1, 4);
          const float mu = s1 * (1.f / 256.f); float s2 = 0.f;
#pragma unroll
          for (int i = 0; i < 8; ++i) { v[i] = v[i] - mu; s2 += (v[i][0] * v[i][0] + v[i][1] * v[i][1]) + (v[i][2] * v[i][2] + v[i][3] * v[i][3]); }
          s2 += __shfl_xor(s2, 1); s2 += __shfl_xor(s2, 2); s2 += __shfl_xor(s2, 4);
          const float rs = 1.0f / sqrtf(s2 * (1.f / 256.f) + EPS);
          const size_t ub = row0 * 1024 + h * 256; const int lo2 = t * 1024 + 32 * part;
#ifdef MLS_GATE_LATE
          { const u32x4* gp = (const u32x4*)(GM + ub + lo2);
#pragma unroll
            for (int i = 0; i < 4; ++i) gz[i] = gp[i]; }
#endif
          u32x4* op = (u32x4*)(HM + ub + lo2); const LAS f32x4* wp = (const LAS f32x4*)(lds + L_MW) + 8 * part;
#pragma unroll
          for (int i = 0; i < 4; ++i) { const u32x4 z = gz[i]; const f32x4 w0 = wp[2 * i], w1 = wp[2 * i + 1]; const f32x4 x0 = v[2 * i] * rs * w0, x1 = v[2 * i + 1] * rs * w1;
              u32x4 w; w.x = pk2(x0[0] * bflo(z.x), x0[1] * bfhi(z.x)); w.y = pk2(x0[2] * bflo(z.y), x0[3] * bfhi(z.y));
              w.z = pk2(x1[0] * bflo(z.z), x1[1] * bfhi(z.z)); w.w = pk2(x1[2] * bflo(z.w), x1[3] * bfhi(z.w)); op[i] = w; } }
        asm volatile("" :: "v"(tch0), "v"(tch1));
        SEGT(4);
    }
    __syncthreads();
#ifdef STAMP_SEG
    *(volatile LAS unsigned long long*)(lds + LDS_BYTES - 32) = seg_acc;
#endif
#undef SEGT
#undef MK
#undef MV
#undef GM
#undef HM
#undef LI
#undef LF
#undef MLS_LOAD_ROUND
#undef MLS_FILL_ROUND
#undef MLS_LANE_IDS
}
}

__device__ __forceinline__ void phase3(KArgs a, LAS unsigned char* lds, int WV) {
    const int tid = TID_OF(WV), lane = tid & 63;
    float s1 = a->in[11][lane] * a->in[12][lane], s2 = a->in[13][lane] * a->in[14][lane];
    s1 = wave_sum(s1); s2 = wave_sum(s2);
    const float lam = __uint_as_float(__builtin_amdgcn_readfirstlane(__float_as_uint(expf(s1) - expf(s2) + 0.2f)));
    unsigned* qhead = (unsigned*)(a->ws + WS_CTL) + CW_QUEUE;
    LAS unsigned* slot = (LAS unsigned*)(lds + LDS_BYTES - 64);
#ifdef STAMP_UNIT
    unsigned long long unit_span = 0ull;
#endif
    constexpr unsigned N_M1 = BATCH * MH, N_A1 = BATCH * AH * (SEQ / 128);
    constexpr unsigned N_M = N_M1 * REP_ML, N_AD = N_A1 * (REP_AT - 1), N_A = N_AD + N_A1;
    for (;;) {
        if (tid == 0) *slot = __hip_atomic_fetch_add(qhead, 1u, __ATOMIC_RELAXED, __HIP_MEMORY_SCOPE_AGENT);
        __syncthreads();
        const unsigned it = *slot;
        __syncthreads();
        if (it >= N_M + N_A) break;
        if (it < N_M) { const unsigned u = it % N_M1;
#ifdef STAMP_UNIT
            const unsigned long long tu0 = __builtin_amdgcn_s_memrealtime();
#endif
            mls::mlstm_unit(a, lds, WV, (int)(u >> 2), (int)(u & 3));
#ifdef STAMP_UNIT
#ifdef STAMP_SEG
            if (it == STAMP_UNIT) unit_span = *(volatile LAS unsigned long long*)(lds + LDS_BYTES - 32);
#else
            if (it == STAMP_UNIT) unit_span = __builtin_amdgcn_s_memrealtime() - tu0;
#endif
#endif
        }
        else { const unsigned i0 = it - N_M; const bool dummy = i0 < N_AD; const unsigned i = i0 % N_A1; const int qb = 15 - (int)(i >> 7), bh = (int)(i & 127); att::attn_unit(a, lds, WV, bh >> 3, bh & 7, qb, lam, dummy); }
    }
#ifdef STAMP_UNIT
    if (unit_span) { const unsigned long long t_end = __builtin_amdgcn_s_memrealtime(); while (__builtin_amdgcn_s_memrealtime() - t_end < unit_span) __builtin_amdgcn_s_sleep(8); }
#endif
}
template <bool COOP>
__global__ void __launch_bounds__(NTHREADS, 2) fwd(Args args) {
    extern __shared__ __attribute__((aligned(16))) unsigned char lds_raw[];
    LAS unsigned char* lds = (LAS unsigned char*)lds_raw;
    const int G = gridDim.x, bx = blockIdx.x;
    const int WV = __builtin_amdgcn_readfirstlane((int)threadIdx.x >> 6);
    const int vcu = (G % 8 == 0) ? (bx % 8) * (G / 8) + bx / 8 : bx;
    const int lo = args.ph_lo, hi = args.ph_hi;
    volatile LAS unsigned* MISC = (volatile LAS unsigned*)(lds + LDS_BYTES - 128);
    if (WV == 0) { const int l_ = lane_id(); if (l_ < 32) MISC[l_] = 0u; }
    __syncthreads();
    XcdBarrier bar; bar.bar = nullptr; bar.x = 0; bar.st = nullptr;
    if constexpr (COOP) bar = xcd_barrier_post((unsigned*)(kargs()->ws + WS_CTL) + CW_BAR, MISC + 8, WV == 0 && lane_id() == 0);
#define IN(k) (lo <= (k) && (k) < hi)
#ifdef STAMP_PHASE
    unsigned long long st_t0 = 0ull, st_t1 = 0ull;
#define STAMP_BEGIN(k) do { if ((k) == STAMP_PHASE) st_t0 = __builtin_amdgcn_s_memrealtime(); } while (0)
#define STAMP_END(k) do { if ((k) == STAMP_PHASE) st_t1 = __builtin_amdgcn_s_memrealtime(); } while (0)
#else
#define STAMP_BEGIN(k) do { } while (0)
#define STAMP_END(k) do { } while (0)
#endif
#define SEAM(k) do { if constexpr (COOP) { if (IN(k) && IN((k) + 1)) { if ((k) == 0) cg::this_grid().sync(); else xcd_barrier(bar, WV == 0 && lane_id() == 0); } } } while (0)
    STAMP_BEGIN(0);
    if (IN(0)) for (int rep = 0; rep < REP_P0; ++rep) { phase0(kargs(), lds, vcu, G, WV); __syncthreads(); }
    SEAM(0);
    STAMP_END(0);
    STAMP_BEGIN(1);
    if (IN(1)) for (int rep = 0; rep < REP_P1; ++rep) { phase1(kargs(), lds, vcu, G, WV); __syncthreads(); }
    SEAM(1);
    STAMP_END(1);
    STAMP_BEGIN(2);
    if (IN(2)) {
#pragma unroll 1
        for (int rep = 0; rep < REP_P2; ++rep) {
        const KArgs ka = kargs(); unsigned char* ws_ = ka->ws; float* out_ = ka->out;
        pg8::Gemm g{(const bf16*)(ws_ + WS_HB), (const bf16*)(ws_ + WS_HB), (const bf16*)(ws_ + WS_WIN), MTOK, NPROJ, 1024, 1024, 16};
        pg8::StaticOrder S; S.init(MTOK, NPROJ, G, bx);
        EpiProj E{(bf16*)out_, (bf16*)out_ + (size_t)MTOK * 1024, (bf16*)(ws_ + WS_MV), (bf16*)(ws_ + WS_GM), (bf16*)(ws_ + WS_AQ), (bf16*)(ws_ + WS_AK), (bf16*)(ws_ + WS_AV), (bf16*)(ws_ + WS_AZ)};
        pg8::gemm_phase<EpiProj, pg8::StaticOrder, true, true>(lds, g, S, E, WV);
        }
    }
    SEAM(2);
    STAMP_END(2);
    STAMP_BEGIN(3);
    if (IN(3)) phase3(kargs(), lds, WV);
    SEAM(3);
    STAMP_END(3);
    STAMP_BEGIN(4);
    if (IN(4)) {
#pragma unroll 1
        for (int rep = 0; rep < REP_P4; ++rep) {
        const KArgs ka = kargs(); unsigned char* ws_ = ka->ws; float* out_ = ka->out; const float* x_ = ka->in[0];
        pg8::Gemm g{(const bf16*)(ws_ + WS_HB), (const bf16*)(ws_ + WS_AQ), (const bf16*)(ws_ + WS_WOUT), MTOK, D, DMIX, 1024, 16};
        pg8::StaticOrder S; S.init(MTOK, D, G, bx);
        EpiOut E{x_, (const float*)(ws_ + WS_MOD), out_, (float*)(ws_ + WS_RSS)};
        pg8::gemm_phase<EpiOut, pg8::StaticOrder, true, true>(lds, g, S, E, WV);
        }
    }
    SEAM(4);
    STAMP_END(4);
    STAMP_BEGIN(5);
    if (IN(5)) phase5(kargs(), vcu, G, WV);
#if REP_P5 > 1
    if (IN(5)) { __syncthreads(); phase5_touch(kargs(), vcu, G, WV); }
#endif
    STAMP_END(5);
#ifdef STAMP_PHASE
    if (blockIdx.x == 0 && WV == 0 && lane_id() == 0) { const unsigned long long t_end = __builtin_amdgcn_s_memrealtime(); while (__builtin_amdgcn_s_memrealtime() - t_end < (st_t1 - st_t0)) __builtin_amdgcn_s_sleep(8); }
#endif
#undef IN
#undef SEAM
}

#ifndef MK_MULTI
#define MK_MULTI 0
#endif
extern "C" void kernel_launch(void* const* d_in, const int* in_sizes, int n_in, void* d_out, int out_size, void* d_ws, size_t ws_size, hipStream_t stream) {
    static int grid = 0;
    if (grid == 0) {
        if (n_in != 19 || out_size != MTOK * D || ws_size < WS_END) { fprintf(stderr, "kernel_launch: unexpected shapes (n_in %d, out %d, ws %zu)\n", n_in, out_size, ws_size); grid = -1; return; }
        int dev = 0, cus = 0, per_cu = 0;
        (void)hipGetDevice(&dev); (void)hipDeviceGetAttribute(&cus, hipDeviceAttributeMultiprocessorCount, dev);
        (void)hipFuncSetAttribute((const void*)fwd<!MK_MULTI>, hipFuncAttributeMaxDynamicSharedMemorySize, LDS_BYTES);
        (void)hipOccupancyMaxActiveBlocksPerMultiprocessor(&per_cu, (const void*)fwd<!MK_MULTI>, NTHREADS, LDS_BYTES);
        if (per_cu < 1) { fprintf(stderr, "kernel_launch: occupancy query says %d blocks per CU\n", per_cu); per_cu = 1; }
        (void)hipGetLastError();
        grid = cus * (per_cu > 1 ? 1 : per_cu);
    }
    if (grid < 0) return;
    (void)hipMemsetAsync((char*)d_ws + WS_CTL, 0, 1 * MiB, stream);
    Args a{};
    for (int i = 0; i < 19; ++i) a.in[i] = (const float*)d_in[i];
    a.out = (float*)d_out; a.ws = (unsigned char*)d_ws;
#if MK_MULTI
    for (int ph = 0; ph < 6; ++ph) { a.ph_lo = ph; a.ph_hi = ph + 1; hipLaunchKernelGGL(fwd<false>, dim3(grid), dim3(NTHREADS), LDS_BYTES, stream, a); }
#else
    a.ph_lo = 0; a.ph_hi = 6;
    void* kargs[] = {&a};
    hipError_t e = hipLaunchCooperativeKernel((const void*)fwd<true>, dim3(grid), dim3(NTHREADS), kargs, LDS_BYTES, stream);
    if (e != hipSuccess) fprintf(stderr, "cooperative launch failed: %s (grid %d)\n", hipGetErrorString(e), grid);
#endif
}
```

```cpp
#include <hip/hip_runtime.h>
#include <hip/hip_cooperative_groups.h>
#include <cstdio>
#include <cstdint>
#include <cmath>
namespace cg = cooperative_groups;
namespace pg8 {
#define PG8_LAS __attribute__((address_space(3)))
typedef unsigned short bf16_t;
typedef short bf16x8 __attribute__((ext_vector_type(8)));
typedef float f32x4 __attribute__((ext_vector_type(4)));
typedef unsigned u32x4 __attribute__((ext_vector_type(4)));
constexpr int BM = 256, BK = 64, HALF = 128, HTB = HALF * BK * 2  , STAGE_BYTES = 8 * HTB, NXCD = 8, WGM = 8;

__host__ __device__ __forceinline__ int lds_byte(int r, int c) { const int st = (r >> 4) * 2 + (c >> 5), rr = r & 15, cc = c & 31, ob = rr * 64 + cc * 2; return st * 1024 + (ob ^ (((ob >> 9) & 1) << 5)); }
__host__ __device__ __forceinline__ void stage_rc(int b, int& R, int& C) { const int st = b / 1024, sb = b % 1024, swz = sb ^ (((sb >> 9) & 1) << 5); R = (st >> 1) * 16 + swz / 64; C = (st & 1) * 32 + (swz % 64) / 2; }
__host__ __device__ __forceinline__ int perm32(int rho) { const int n = rho >> 4, i = rho & 15; return 8 * (i >> 2) + 4 * n + (i & 3); }

struct Unit { int pm, pn; };
struct Gemm { const bf16_t* A; const bf16_t* A2; const bf16_t* Bt; int M, N, K, lda, nt1; };

struct StaticOrder {
    int nM, nN, nwg, G, c;
    __host__ __device__ void init(int M, int N, int G_, int c_) { nM = M / BM; nN = N / BM; nwg = nM * nN; G = G_; c = c_; }
    __host__ __device__ bool next(int i, Unit& u) const {
        const long L = (long)i * G + c; if (L >= nwg) return false;
        int wgid = (int)L; { const int q = nwg / NXCD, r = nwg % NXCD, xcd = wgid % NXCD, off = wgid / NXCD; wgid = (xcd < r ? xcd * (q + 1) : r * (q + 1) + (xcd - r) * q) + off; }
        const int nig = WGM * nN, gid = wgid / nig, fm = gid * WGM, gsz = (nM - fm) < WGM ? (nM - fm) : WGM;
        u.pm = fm + ((wgid % nig) % gsz); u.pn = (wgid % nig) / gsz; return true;
    }
    __device__ __forceinline__ void a_ready(const Unit&) const {}
    __device__ __forceinline__ void done(const Unit&) const {}
};

__device__ __forceinline__ unsigned cvt_pk_bf16(float lo, float hi) { unsigned r; asm volatile("v_cvt_pk_bf16_f32 %0, %1, %2" : "=v"(r) : "v"(lo), "v"(hi)); return r; }
template <class Epi, class Sched, bool ALIGN_EPI = false, bool SP2 = false>
__device__ __forceinline__ void gemm_phase(PG8_LAS unsigned char* lds, const Gemm g, const Sched& S, const Epi& E, const int wid) {
    const int lane = (int)__builtin_amdgcn_mbcnt_hi(~0u, __builtin_amdgcn_mbcnt_lo(~0u, 0u)), tid = wid * 64 + lane, wr = wid >> 2, wc = wid & 3, fr = lane & 15, fq = lane >> 4;
    const int K = g.K, nt = K / BK;
    unsigned voffA[2], voffB[2];
#pragma unroll
    for (int i = 0; i < 2; ++i) { int R, C; stage_rc(tid * 16 + i * 8192, R, C); const int Rb = Epi::PERM ? ((R & ~31) + perm32(R & 31)) : R;
        voffA[i] = (unsigned)(R * g.lda + C) * 2u; voffB[i] = (unsigned)(Rb * K + C) * 2u; }
    const size_t kstep = (size_t)(BK * 2);
    const size_t hstep = (size_t)HALF * K * 2;
    const size_t tstep = 2 * hstep;
    const size_t hstepA = (size_t)HALF * g.lda * 2, tstepA = 2 * hstepA; const int nt1 = g.nt1;
#define PG8_AP(b1, b2, t) ((t) < nt1 ? (b1) + (size_t)(t) * kstep : (b2) + (size_t)((t) - nt1) * kstep)
    const unsigned ldsw = (unsigned)wid * 1024u;
    const int aoff = lds_byte(wr * 64 + fr, fq * 8), boff = lds_byte(wc * 32 + fr, fq * 8);
#define PG8_SA(b, h) (((b) * 2 + (h)) * HTB)
#define PG8_SB(b, h) ((4 + (b) * 2 + (h)) * HTB)
#define PG8_STAGE(bufoff, gbase, voff) do { _Pragma("unroll") for (int _i = 0; _i < 2; ++_i) \
        __builtin_amdgcn_global_load_lds((const unsigned*)((const char*)(gbase) + (voff)[_i]), (PG8_LAS unsigned*)(lds + (bufoff) + ldsw + _i * 8192), 16, 0, 0); } while (0)
#define PG8_LDA(dst, b, h) do { _Pragma("unroll") for (int m = 0; m < 4; ++m) _Pragma("unroll") for (int k = 0; k < 2; ++k) dst[m][k] = *(const PG8_LAS bf16x8*)(lds + PG8_SA(b, h) + aoff + m * 2048 + k * 1024); } while (0)
#define PG8_LDB(dst, b, h) do { _Pragma("unroll") for (int n = 0; n < 2; ++n) _Pragma("unroll") for (int k = 0; k < 2; ++k) dst[n][k] = *(const PG8_LAS bf16x8*)(lds + PG8_SB(b, h) + boff + n * 2048 + k * 1024); } while (0)
#define PG8_MMA(ai, bj, At, Bt) do { __builtin_amdgcn_s_setprio(1); _Pragma("unroll") for (int m = 0; m < 4; ++m) _Pragma("unroll") for (int n = 0; n < 2; ++n) _Pragma("unroll") for (int k = 0; k < 2; ++k) \
        acc[ai][bj][m][n] = __builtin_amdgcn_mfma_f32_16x16x32_bf16(Bt[n][k], At[m][k], acc[ai][bj][m][n], 0, 0, 0); __builtin_amdgcn_s_setprio(0); } while (0)
#define PG8_WAIT_V(n) asm volatile("s_waitcnt vmcnt(" #n ")" ::: "memory")
#define PG8_WAIT_L(n) asm volatile("s_waitcnt lgkmcnt(" #n ")" ::: "memory")
#define PG8_BAR __builtin_amdgcn_s_barrier()
#define PG8_SCHED __builtin_amdgcn_sched_barrier(0)
    Unit cur, nxt; int ui = 0;
    if (!S.next(0, cur)) return;
    f32x4 acc[2][2][4][2];
#pragma unroll
    for (int a = 0; a < 2; ++a)
#pragma unroll
        for (int b = 0; b < 2; ++b)
#pragma unroll
            for (int m = 0; m < 4; ++m)
#pragma unroll
                for (int n = 0; n < 2; ++n) acc[a][b][m][n] = (f32x4){0.f, 0.f, 0.f, 0.f};
    bf16x8 At[4][2], B0[2][2], B1[2][2];
    const char* cA = (const char*)g.A + (size_t)cur.pm * tstepA; const char* cA2 = (const char*)g.A2 + (size_t)cur.pm * tstepA; const char* cB = (const char*)g.Bt + (size_t)cur.pn * tstep;
    S.a_ready(cur);
    if constexpr (SP2) {
        PG8_STAGE(PG8_SB(0, 0), cB, voffB); PG8_STAGE(PG8_SB(0, 1), cB + hstep, voffB); PG8_STAGE(PG8_SA(0, 0), cA, voffA); PG8_STAGE(PG8_SA(0, 1), cA + hstepA, voffA);
        if (wr == 1) PG8_BAR;
        PG8_WAIT_V(2); PG8_BAR;
        PG8_STAGE(PG8_SB(1, 0), cB + kstep, voffB); PG8_STAGE(PG8_SA(1, 0), cA + kstep, voffA); PG8_STAGE(PG8_SB(1, 1), cB + hstep + kstep, voffB);
        PG8_WAIT_V(6); PG8_BAR;
    } else {
        PG8_STAGE(PG8_SB(0, 0), cB, voffB); PG8_STAGE(PG8_SA(0, 0), cA, voffA); PG8_STAGE(PG8_SB(0, 1), cB + hstep, voffB); PG8_STAGE(PG8_SA(0, 1), cA + hstepA, voffA);
        if (wr == 1) PG8_BAR;
        PG8_WAIT_V(4); PG8_BAR;
        PG8_STAGE(PG8_SB(1, 0), cB + kstep, voffB); PG8_STAGE(PG8_SA(1, 0), cA + kstep, voffA); PG8_STAGE(PG8_SB(1, 1), cB + hstep + kstep, voffB);
        PG8_WAIT_V(6); PG8_BAR;
    }
    for (;;) {
        const bool has_next = S.next(ui + 1, nxt);
        const char* nA = has_next ? (const char*)g.A + (size_t)nxt.pm * tstepA : cA; const char* nA2 = has_next ? (const char*)g.A2 + (size_t)nxt.pm * tstepA : cA2; const char* nB = has_next ? (const char*)g.Bt + (size_t)nxt.pn * tstep : cB;
        for (int t = 0; t < nt; t += 2) {
            const bool last = (t == nt - 2);
            const char* a1 = PG8_AP(cA, cA2, t + 1);
            const char* a2 = last ? nA : PG8_AP(cA, cA2, t + 2); const char* b2 = last ? nB : cB + (size_t)(t + 2) * kstep;
            const char* a3 = last ? nA + kstep : PG8_AP(cA, cA2, t + 3); const char* b3 = b2 + kstep;
            if (last && has_next) S.a_ready(nxt);
            if constexpr (SP2) {
            PG8_LDB(B0, 0, 0); PG8_LDB(B1, 0, 1); PG8_SCHED; PG8_LDA(At, 0, 0); PG8_STAGE(PG8_SA(1, 1), a1 + hstepA, voffA);
            PG8_WAIT_V(8); PG8_WAIT_L(0); PG8_BAR; PG8_MMA(0, 0, At, B0); PG8_MMA(0, 1, At, B1); PG8_BAR; PG8_SCHED;
            PG8_LDA(At, 0, 1); PG8_STAGE(PG8_SB(0, 0), b2, voffB); PG8_STAGE(PG8_SB(0, 1), b2 + hstep, voffB); PG8_STAGE(PG8_SA(0, 0), a2, voffA);
            PG8_WAIT_V(8); PG8_WAIT_L(0); PG8_BAR; PG8_MMA(1, 0, At, B0); PG8_MMA(1, 1, At, B1); PG8_BAR; PG8_SCHED;
            PG8_LDB(B0, 1, 0); PG8_LDB(B1, 1, 1); PG8_SCHED; PG8_LDA(At, 1, 0); PG8_STAGE(PG8_SA(0, 1), a2 + hstepA, voffA);
            PG8_WAIT_V(8); PG8_WAIT_L(0); PG8_BAR; PG8_MMA(0, 0, At, B0); PG8_MMA(0, 1, At, B1); PG8_BAR; PG8_SCHED;
            PG8_LDA(At, 1, 1); PG8_STAGE(PG8_SB(1, 0), b3, voffB); PG8_STAGE(PG8_SB(1, 1), b3 + hstep, voffB); PG8_STAGE(PG8_SA(1, 0), a3, voffA);
            PG8_WAIT_V(8); PG8_WAIT_L(0); PG8_BAR; PG8_MMA(1, 0, At, B0); PG8_MMA(1, 1, At, B1); PG8_BAR; PG8_SCHED;
            } else {
            PG8_LDB(B0, 0, 0); PG8_SCHED; PG8_LDA(At, 0, 0); PG8_STAGE(PG8_SA(1, 1), a1 + hstepA, voffA);
            PG8_WAIT_L(8); PG8_BAR; PG8_WAIT_L(0); PG8_MMA(0, 0, At, B0); PG8_BAR; PG8_SCHED;
            PG8_LDB(B1, 0, 1); PG8_STAGE(PG8_SB(0, 0), b2, voffB);
            PG8_BAR; PG8_WAIT_L(0); PG8_MMA(0, 1, At, B1); PG8_BAR;
            PG8_LDA(At, 0, 1); PG8_STAGE(PG8_SA(0, 0), a2, voffA);
            PG8_BAR; PG8_WAIT_L(0); PG8_MMA(1, 0, At, B0); PG8_BAR; PG8_SCHED;
            PG8_STAGE(PG8_SB(0, 1), b2 + hstep, voffB);
            PG8_WAIT_V(6); PG8_BAR; PG8_MMA(1, 1, At, B1); PG8_BAR;
            PG8_LDB(B0, 1, 0); PG8_SCHED; PG8_LDA(At, 1, 0); PG8_STAGE(PG8_SA(0, 1), a2 + hstepA, voffA);
            PG8_WAIT_L(8); PG8_BAR; PG8_WAIT_L(0); PG8_MMA(0, 0, At, B0); PG8_BAR; PG8_SCHED;
            PG8_LDB(B1, 1, 1); PG8_STAGE(PG8_SB(1, 0), b3, voffB);
            PG8_BAR; PG8_WAIT_L(0); PG8_MMA(0, 1, At, B1); PG8_BAR;
            PG8_LDA(At, 1, 1); PG8_STAGE(PG8_SA(1, 0), a3, voffA);
            PG8_BAR; PG8_WAIT_L(0); PG8_MMA(1, 0, At, B0); PG8_BAR; PG8_SCHED;
            PG8_STAGE(PG8_SB(1, 1), b3 + hstep, voffB);
            PG8_WAIT_V(6); PG8_BAR; PG8_MMA(1, 1, At, B1); PG8_BAR;
            }
        }
        if constexpr (ALIGN_EPI) { if (wr == 0) PG8_BAR; }
        if constexpr (!Epi::AFTER_DRAIN) { E(acc, cur, wr, wc, fr, fq); S.done(cur); }
        if (!has_next) break;
#pragma unroll
        for (int a = 0; a < 2; ++a)
#pragma unroll
            for (int b = 0; b < 2; ++b)
#pragma unroll
                for (int m = 0; m < 4; ++m)
#pragma unroll
                    for (int n = 0; n < 2; ++n) acc[a][b][m][n] = (f32x4){0.f, 0.f, 0.f, 0.f};
        cur = nxt; cA = nA; cA2 = nA2; cB = nB; ++ui;
        if constexpr (ALIGN_EPI) { if (wr == 1) PG8_BAR; }
    }
    PG8_WAIT_V(0);
    if constexpr (!ALIGN_EPI) { if (wr == 0) PG8_BAR; }
    PG8_BAR;
    if constexpr (Epi::AFTER_DRAIN) { E.fused(acc, cur, wr, wc, fr, fq, lds, wid, lane); S.done(cur); }
#undef PG8_AP
#undef PG8_SA
#undef PG8_SB
#undef PG8_STAGE
#undef PG8_LDA
#undef PG8_LDB
#undef PG8_MMA
#undef PG8_WAIT_V
#undef PG8_WAIT_L
#undef PG8_BAR
#undef PG8_SCHED
}
}
#ifndef REP_P0
#define REP_P0 1
#endif
#ifndef REP_P5
#define REP_P5 1
#endif
#ifndef REP_P1
#define REP_P1 1
#endif
#ifndef REP_P2
#define REP_P2 1
#endif
#ifndef REP_ML
#define REP_ML 1
#endif
#ifndef REP_AT
#define REP_AT 1
#endif
#ifndef REP_P4
#define REP_P4 1
#endif
constexpr int NWAVES = 8, NTHREADS = 512;
constexpr int D = 1024, BATCH = 16, SEQ = 2048, MTOK = BATCH * SEQ, DIN = 9224, NPROJ = 9216, DMIX = 2048;
constexpr int MH = 4, MHD = 256, AH = 8, AVD = 128, AQK = 64, MCH = 64;
constexpr int C_MQ = 0, C_MK = 1024, C_MV = 2048, C_MO = 3072, C_MZ = 4096, C_MI = 5120, C_MF = 5124, C_AQ = 5128, C_AK = 6152, C_AV = 7176, C_AZ = 8200;
constexpr float EPS = 1e-6f, LOG2E = 1.4426950408889634f;
constexpr float QSCALE = 0.125f * LOG2E;
constexpr size_t MiB = 1u << 20;
constexpr size_t WS_CTL = 0;
constexpr size_t WS_MOD = 1 * MiB;
constexpr size_t WS_LI = 2 * MiB;
constexpr size_t WS_LF = 2 * MiB + 512 * 1024;
constexpr size_t WS_RSS = 4 * MiB;
constexpr size_t WS_WIN = 8 * MiB;
constexpr size_t WS_WOUT = 26 * MiB;
constexpr size_t WS_HB = 32 * MiB;
constexpr size_t WS_MV = 96 * MiB;
constexpr size_t WS_GM = 160 * MiB;
constexpr size_t WS_AQ = 224 * MiB;
constexpr size_t WS_AK = 288 * MiB;
constexpr size_t WS_AV = 352 * MiB;
constexpr size_t WS_AZ = 416 * MiB;
constexpr size_t WS_END = 480 * MiB;
constexpr size_t WS_HALO = 480 * MiB;
constexpr size_t WS_DUMMY = 496 * MiB;
constexpr int CW_QUEUE = 64;
constexpr int CW_PREP = 128;
constexpr int LDS_BYTES = 155648;

#define LAS __attribute__((address_space(3)))
typedef unsigned short bf16;
typedef float f32x4 __attribute__((ext_vector_type(4)));
typedef float f32x16 __attribute__((ext_vector_type(16)));
typedef float f32x2 __attribute__((ext_vector_type(2)));
typedef short bf16x8 __attribute__((ext_vector_type(8)));
typedef short s16x4 __attribute__((ext_vector_type(4)));
typedef unsigned u32x4 __attribute__((ext_vector_type(4)));
typedef unsigned u32x2 __attribute__((ext_vector_type(2)));
typedef __bf16 bf16x2_t __attribute__((ext_vector_type(2)));

__device__ __forceinline__ unsigned pk2(float lo, float hi) { f32x2 v = {lo, hi}; bf16x2_t b = __builtin_convertvector(v, bf16x2_t); return __builtin_bit_cast(unsigned, b); }
__device__ __forceinline__ float bflo(unsigned u) { return __uint_as_float(u << 16); }
__device__ __forceinline__ float bfhi(unsigned u) { return __uint_as_float(u & 0xffff0000u); }
__device__ __forceinline__ float siluf(float x) { return x * __builtin_amdgcn_rcpf(1.f + __expf(-x)); }
__device__ __forceinline__ float sigmf(float x) { return __builtin_amdgcn_rcpf(1.f + __expf(-x)); }
__device__ __forceinline__ int lane_id() { int l; asm volatile("v_mbcnt_lo_u32_b32 %0, -1, 0\n\tv_mbcnt_hi_u32_b32 %0, -1, %0" : "=v"(l)); return l; }
#define TID_OF(wv) ((wv) * 64 + lane_id())
template <int M> __device__ __forceinline__ float xadd(float v) {
    if constexpr (M == 32) { auto rr = __builtin_amdgcn_permlane32_swap(__float_as_uint(v), __float_as_uint(v), false, false); return __uint_as_float(rr[0]) + __uint_as_float(rr[1]); }
    else return v + __uint_as_float((unsigned)__builtin_amdgcn_ds_swizzle((int)__float_as_uint(v), (M << 10) | 0x1f));
}
__device__ __forceinline__ float wave_sum(float v) { v = xadd<1>(v); v = xadd<2>(v); v = xadd<4>(v); v = xadd<8>(v); v = xadd<16>(v); v = xadd<32>(v); return v; }

struct Args { const float* in[19]; float* out; unsigned char* ws; int ph_lo, ph_hi; };
typedef const __attribute__((address_space(4))) Args* KArgs;
__device__ __forceinline__ KArgs kargs() { KArgs p = (KArgs)__builtin_amdgcn_kernarg_segment_ptr(); asm volatile("" : "+s"(p)); return p; }

__device__ __forceinline__ int win_src_col(int n) {
    if (n < 3072) return n;
    if (n < 5120) { const int g = (n - 3072) >> 8, r = (n - 3072) & 255; return (r < 128) ? C_MO + 128 * g + r : C_MZ + 128 * g + (r - 128); }
    return n + 8;
}
__device__ __forceinline__ void p0_transpose_item(const float* W, int ldw, int K, bf16* WT, int k0, int n0, int sc0, LAS float* scr, int lane) {
#pragma unroll
    for (int i = 0; i < 32; ++i) { const int kk = 2 * i + (lane >> 5); scr[kk * 33 + (lane & 31)] = W[(size_t)(k0 + kk) * ldw + sc0 + (lane & 31)]; }
    asm volatile("s_waitcnt lgkmcnt(0)" ::: "memory");
    const int c = lane & 7;
#pragma unroll
    for (int j = 0; j < 4; ++j) { const int n = (lane >> 3) + 8 * j; const LAS float* s = scr + (8 * c) * 33 + n;
        u32x4 o; o.x = pk2(s[0 * 33], s[1 * 33]); o.y = pk2(s[2 * 33], s[3 * 33]); o.z = pk2(s[4 * 33], s[5 * 33]); o.w = pk2(s[6 * 33], s[7 * 33]);
        *(u32x4*)(WT + (size_t)(n0 + n) * K + k0 + 8 * c) = o; }
    asm volatile("s_waitcnt lgkmcnt(0)" ::: "memory");
}
__device__ __forceinline__ void phase0(KArgs a, LAS unsigned char* lds, int vcu, int G, int WV) {
    const int tid = TID_OF(WV), lane = tid & 63, wave = WV;
    const float* c = a->in[1]; const float* w_ada = a->in[3]; const float* b_ada = a->in[4];
    float* mod = (float*)(a->ws + WS_MOD);
    if (blockIdx.x == 0 && tid == 0) ((unsigned*)(a->ws + WS_CTL))[CW_QUEUE] = 0u;
    for (int cgp = vcu; cgp < 256; cgp += G) {
        const int b = tid >> 5, part = tid & 31, j0 = 12 * cgp;
        float acc[12];
#pragma unroll
        for (int j = 0; j < 12; ++j) acc[j] = 0.f;
#pragma unroll 8
        for (int ii = 0; ii < 32; ++ii) { const int i = part + 32 * ii;
            const float s = c[b * 1024 + i]; const float sv = s / (1.f + expf(-s));
            const f32x4* wr = (const f32x4*)(w_ada + (size_t)i * 3072 + j0);
            const f32x4 w0 = wr[0], w1 = wr[1], w2 = wr[2];
            acc[0] += sv * w0[0]; acc[1] += sv * w0[1]; acc[2] += sv * w0[2]; acc[3] += sv * w0[3];
            acc[4] += sv * w1[0]; acc[5] += sv * w1[1]; acc[6] += sv * w1[2]; acc[7] += sv * w1[3];
            acc[8] += sv * w2[0]; acc[9] += sv * w2[1]; acc[10] += sv * w2[2]; acc[11] += sv * w2[3]; }
#pragma unroll
        for (int j = 0; j < 12; ++j) { float v = acc[j];
            v = xadd<1>(v); v = xadd<2>(v); v = xadd<4>(v); v = xadd<8>(v); v = xadd<16>(v);
            if (part == 0) mod[b * 3072 + j0 + j] = v + b_ada[j0 + j]; }
    }
}

__device__ __forceinline__ void weight_copies(KArgs a, LAS float* scr, int vcu, int G, int wave, int lane) {
    const int gw = vcu * NWAVES + wave, NGW = G * NWAVES;
    constexpr int I_IN = (1024 / 64) * (NPROJ / 32), I_OUT = (2048 / 64) * (1024 / 32);
    bf16* WinT = (bf16*)(a->ws + WS_WIN); bf16* WoutT = (bf16*)(a->ws + WS_WOUT);
    for (int it = gw; it < I_IN + I_OUT; it += NGW) {
        if (it < I_IN) { const int nb = it % (NPROJ / 32), kb = it / (NPROJ / 32); p0_transpose_item(a->in[5], DIN, 1024, WinT, 64 * kb, 32 * nb, win_src_col(32 * nb), scr, lane); }
        else { const int r = it - I_IN, nb = r % 32, kb = r / 32; p0_transpose_item(a->in[17], 1024, 2048, WoutT, 64 * kb, 32 * nb, 32 * nb, scr, lane); }
    }
}

__device__ __forceinline__ void phase1(KArgs a, LAS unsigned char* lds, int vcu, int G, int WV) {
    const int tid = TID_OF(WV), lane = tid & 63, wave = WV;
    const float* x = a->in[0]; const float* norm_w = a->in[2]; const float* w_in = a->in[5]; const float* b_i = a->in[6]; const float* b_f = a->in[7];
    const float* mod = (const float*)(a->ws + WS_MOD);
    bf16* HB = (bf16*)(a->ws + WS_HB); float* LI = (float*)(a->ws + WS_LI); float* LF = (float*)(a->ws + WS_LF);
    LAS float* wg = (LAS float*)lds;
#pragma unroll
    for (int i = tid; i < 1024 * 8; i += NTHREADS) { const int k = i >> 3, q = i & 7;
        wg[(((((k >> 8) * 4 + (k & 3)) * 2 + (q >> 2)) * 64 + ((k & 255) >> 2)) * 4) + (q & 3)] = w_in[(size_t)k * DIN + C_MI + q]; }
    weight_copies(a, (LAS float*)(lds + 32768 + wave * 8448), vcu, G, wave, lane);
    __syncthreads();
    const int gw = vcu * NWAVES + wave, NGW = G * NWAVES;
    for (int grp = gw; grp < MTOK / 16; grp += NGW) {
        const int row0 = grp * 16, b = row0 / SEQ;
        f32x4 am[4], sh[4];
#pragma unroll
        for (int j = 0; j < 4; ++j) { const int col = 4 * lane + 256 * j;
            const f32x4 nw = *(const f32x4*)(norm_w + col), sc = *(const f32x4*)(mod + b * 3072 + 1024 + col);
            am[j] = nw * (sc + 1.0f); sh[j] = *(const f32x4*)(mod + b * 3072 + col); }
        f32x4 vn[4];
        { const f32x4* xr = (const f32x4*)(x + (size_t)row0 * D) + lane;
#pragma unroll
          for (int j = 0; j < 4; ++j) vn[j] = xr[64 * j]; }
        for (int r = 0; r < 16; ++r) { const int row = row0 + r;
            LAS float* wgr = wg; asm volatile("" : "+v"(wgr));
            f32x4 v[4]; float s = 0.f;
#pragma unroll
            for (int j = 0; j < 4; ++j) { v[j] = vn[j]; s += (v[j][0] * v[j][0] + v[j][1] * v[j][1]) + (v[j][2] * v[j][2] + v[j][3] * v[j][3]); }
            if (r < 15) { const f32x4* xr = (const f32x4*)(x + (size_t)(row + 1) * D) + lane;
#pragma unroll
                for (int j = 0; j < 4; ++j) vn[j] = xr[64 * j]; }
            const float rstd = 1.0f / sqrtf(wave_sum(s) * (1.f / D) + EPS);
            float g8[8];
#pragma unroll
            for (int q = 0; q < 8; ++q) g8[q] = 0.f;
            u32x2* o8 = (u32x2*)(HB + (size_t)row * D) + lane;
#pragma unroll
            for (int j = 0; j < 4; ++j) { const f32x4 hv = v[j] * rstd * am[j] + sh[j];
                u32x2 w; w.x = pk2(hv[0], hv[1]); w.y = pk2(hv[2], hv[3]); o8[64 * j] = w;
#pragma unroll
                for (int e = 0; e < 4; ++e) {
                    const f32x4 w0 = *(const LAS f32x4*)(wgr + ((((j * 4 + e) * 2 + 0) * 64 + lane) * 4)), w1 = *(const LAS f32x4*)(wgr + ((((j * 4 + e) * 2 + 1) * 64 + lane) * 4));
                    g8[0] += hv[e] * w0[0]; g8[1] += hv[e] * w0[1]; g8[2] += hv[e] * w0[2]; g8[3] += hv[e] * w0[3];
                    g8[4] += hv[e] * w1[0]; g8[5] += hv[e] * w1[1]; g8[6] += hv[e] * w1[2]; g8[7] += hv[e] * w1[3]; } }
#pragma unroll
            for (int q = 0; q < 8; ++q) g8[q] = wave_sum(g8[q]);
#pragma unroll
            for (int q = 0; q < 4; ++q) {
                if (lane == q) LI[(size_t)row * 4 + q] = g8[q] + b_i[q];
                if (lane == 4 + q) { const float xf = g8[4 + q] + b_f[q]; LF[(size_t)row * 4 + q] = fminf(xf, 0.f) - log1pf(expf(-fabsf(xf))); } }
        }
    }
}

struct EpiProj {
    static constexpr bool PERM = true, AFTER_DRAIN = false;
    bf16 *MQ, *MK, *MV, *GM, *AQ, *AK, *AV, *AZ, *HALO;
    __device__ __forceinline__ void operator()(const pg8::f32x4 (&acc)[2][2][4][2], const pg8::Unit& u, int wr, int wc, int fr, int fq) const {
        const int pn = u.pn; const int row0 = u.pm * 256 + wr * 64 + fr;
        if (pn >= 12 && pn < 20) {
            const int col = 128 * (pn - 12) + wc * 32 + 8 * fq;
#pragma unroll
            for (int ai = 0; ai < 2; ++ai)
#pragma unroll
                for (int m = 0; m < 4; ++m) { bf16* p = GM + (size_t)(row0 + ai * 128 + m * 16) * 1024 + col;
                    float g[8];
#pragma unroll
                    for (int n = 0; n < 2; ++n)
#pragma unroll
                        for (int e = 0; e < 4; ++e) { const float o = acc[ai][0][m][n][e], z = acc[ai][1][m][n][e]; g[4 * n + e] = z * __builtin_amdgcn_rcpf((1.f + __expf(-o)) * (1.f + __expf(-z))); }
                    u32x4 w; w.x = pk2(g[0], g[1]); w.y = pk2(g[2], g[3]); w.z = pk2(g[4], g[5]); w.w = pk2(g[6], g[7]);
                    *(u32x4*)p = w; }
            return;
        }
        bf16* base; float sc = 1.f; int act = 0; int ct;
        if (pn < 4) { base = MQ; ct = pn; } else if (pn < 8) { base = MK; ct = pn - 4; } else if (pn < 12) { base = MV; ct = pn - 8; }
        else if (pn < 24) { base = AQ; ct = pn - 20; sc = QSCALE; } else if (pn < 28) { base = AK; ct = pn - 24; } else if (pn < 32) { base = AV; ct = pn - 28; }
        else { base = AZ; ct = pn - 32; act = 1; }
        const int col0 = ct * 256 + wc * 32 + 8 * fq;
#pragma unroll
        for (int ai = 0; ai < 2; ++ai)
#pragma unroll
            for (int m = 0; m < 4; ++m) { bf16* rowp = base + (size_t)(row0 + ai * 128 + m * 16) * 1024 + col0;
#pragma unroll
                for (int bj = 0; bj < 2; ++bj) { pg8::f32x4 v0 = acc[ai][bj][m][0], v1 = acc[ai][bj][m][1];
                    if (act) { v0 = (pg8::f32x4){siluf(v0[0]), siluf(v0[1]), siluf(v0[2]), siluf(v0[3])}; v1 = (pg8::f32x4){siluf(v1[0]), siluf(v1[1]), siluf(v1[2]), siluf(v1[3])}; }
                    v0 = v0 * sc; v1 = v1 * sc;
                    u32x4 w; w.x = pk2(v0[0], v0[1]); w.y = pk2(v0[2], v0[3]); w.z = pk2(v1[0], v1[1]); w.w = pk2(v1[2], v1[3]);
                    *(u32x4*)(rowp + bj * 128) = w;
                    if (pn < 8) { const int row = row0 + ai * 128 + m * 16;
                        if ((row & 63) >= 61) *(u32x4*)(HALO + ((size_t)((pn >> 2) * 512 + (row >> 6)) * 3 + ((row & 63) - 61)) * 1024 + col0 + bj * 128) = w; } } }
    }
};
struct EpiOut {
    static constexpr bool PERM = false, AFTER_DRAIN = false;
    const float* x; const float* mod; float* out; float* rss;
    __device__ __forceinline__ void operator()(const pg8::f32x4 (&acc)[2][2][4][2], const pg8::Unit& u, int wr, int wc, int fr, int fq) const {
        const int col0 = u.pn * 256 + wc * 32 + 4 * fq; const int b = (u.pm * 256) / SEQ;
        pg8::f32x4 gv[2][2];
#pragma unroll
        for (int bj = 0; bj < 2; ++bj)
#pragma unroll
            for (int n = 0; n < 2; ++n) gv[bj][n] = *(const pg8::f32x4*)(mod + b * 3072 + 2048 + col0 + bj * 128 + n * 16);
#pragma unroll
        for (int ai = 0; ai < 2; ++ai)
#pragma unroll
            for (int m = 0; m < 4; ++m) { const int row = u.pm * 256 + ai * 128 + wr * 64 + m * 16 + fr; const size_t off = (size_t)row * D + col0; float ss = 0.f;
#pragma unroll
                for (int bj = 0; bj < 2; ++bj)
#pragma unroll
                    for (int n = 0; n < 2; ++n) { const pg8::f32x4 xv = *(const pg8::f32x4*)(x + off + bj * 128 + n * 16);
                        const pg8::f32x4 o = xv + gv[bj][n] * acc[ai][bj][m][n];
                        ss += (o[0] * o[0] + o[1] * o[1]) + (o[2] * o[2] + o[3] * o[3]);
                        *(pg8::f32x4*)(out + off + bj * 128 + n * 16) = o; }
                ss = xadd<16>(ss); ss = xadd<32>(ss);
                if (fq == 0) rss[(size_t)row * 16 + u.pn * 4 + wc] = ss; }
    }
};

__device__ __forceinline__ void phase5(KArgs a, int vcu, int G, int WV) {
    const int tid = TID_OF(WV), lane = tid & 63, wave = WV;
    const float* fnw = a->in[18]; const float* rss = (const float*)(a->ws + WS_RSS); float* out = a->out;
    f32x4 fw[4];
#pragma unroll
    for (int j = 0; j < 4; ++j) fw[j] = *(const f32x4*)(fnw + 4 * lane + 256 * j);
    const int gw = vcu * NWAVES + wave, NGW = G * NWAVES;
    for (int grp = gw; grp < MTOK / 16; grp += NGW)
        for (int r = 0; r < 16; ++r) { const int row = grp * 16 + r;
            const f32x4* pr = (const f32x4*)(rss + (size_t)row * 16);
            const f32x4 p0 = pr[0], p1 = pr[1], p2 = pr[2], p3 = pr[3];
            const float tot = (((p0[0] + p0[1]) + (p0[2] + p0[3])) + ((p1[0] + p1[1]) + (p1[2] + p1[3]))) + (((p2[0] + p2[1]) + (p2[2] + p2[3])) + ((p3[0] + p3[1]) + (p3[2] + p3[3])));
            const float rstd = 1.0f / sqrtf(tot * (1.f / D) + EPS);
            f32x4* o = (f32x4*)(out + (size_t)row * D) + lane;
#pragma unroll
            for (int j = 0; j < 4; ++j) o[64 * j] = o[64 * j] * rstd * fw[j]; }
}

__device__ __forceinline__ void phase5_touch(KArgs a, int vcu, int G, int WV) {
    const int tid = TID_OF(WV), lane = tid & 63, wave = WV;
    const float* rss = (const float*)(a->ws + WS_RSS); float* out = a->out;
    const int gw = vcu * NWAVES + wave, NGW = G * NWAVES;
    for (int grp = gw; grp < MTOK / 16; grp += NGW)
        for (int r = 0; r < 16; ++r) { const int row = grp * 16 + r;
            const f32x4* pr = (const f32x4*)(rss + (size_t)row * 16);
            const f32x4 p0 = pr[0], p1 = pr[1], p2 = pr[2], p3 = pr[3];
            const float tot = (p0[0] + p1[0]) + (p2[0] + p3[0]);
            const float one = (tot == -1.2345f) ? 2.f : 1.f;
            f32x4* o = (f32x4*)(out + (size_t)row * D) + lane;
#pragma unroll
            for (int j = 0; j < 4; ++j) o[64 * j] = o[64 * j] * one; }
}
constexpr int CW_BAR = 4096;
#define XB_TMO      128
#define XB_XCNT(j)  (256  + 64 * (j))
#define XB_XSUB(j)  (1280 + 64 * (j))
#define XB_XGEN(j)  (2304 + 64 * (j))
#define XB_TOP      3328
#define XB_TOPGEN   3392
#define XCD_BAR_WORDS 3456
#define XB_SPIN_CAP (1u << 18)

__device__ __forceinline__ unsigned xb_ld(unsigned* p)              { return __hip_atomic_load(p, __ATOMIC_RELAXED, __HIP_MEMORY_SCOPE_AGENT); }
__device__ __forceinline__ unsigned xb_add(unsigned* p, unsigned v) { return __hip_atomic_fetch_add(p, v, __ATOMIC_RELAXED, __HIP_MEMORY_SCOPE_AGENT); }
__device__ __forceinline__ unsigned xb_xcc_id() { return (unsigned)__builtin_amdgcn_s_getreg((3 << 11) | 20) & 0xFu; }
#define XB_SPIN(cond, bar) do { unsigned _sp = 0; while (cond) { __builtin_amdgcn_s_sleep(1); \
    if ((++_sp & 255u) == 0u) { if (xb_ld(&(bar)[XB_TMO])) break; if (_sp > XB_SPIN_CAP) { atomicAdd(&(bar)[XB_TMO], 1u); break; } } } } while (0)

struct XcdBarrier {
    unsigned* bar; unsigned x;
    volatile LAS unsigned* st;
};

__device__ __forceinline__ XcdBarrier xcd_barrier_post(unsigned* bar, volatile LAS unsigned* st, bool t0) {
    XcdBarrier b; b.bar = bar; b.x = xb_xcc_id(); b.st = st;
    if (t0) (void)xb_add(&bar[XB_XCNT(b.x)], 1u);
    return b;
}
__device__ __forceinline__ void xcd_barrier_complete(unsigned* bar, unsigned x, unsigned& nloc, unsigned& nx) {
    const unsigned G = gridDim.x * gridDim.y * gridDim.z;
    unsigned sum, cnt, mine, sp = 0u;
    for (;;) {
        sum = 0u; cnt = 0u; mine = 0u;
#pragma unroll
        for (unsigned j = 0; j < 16; ++j) { const unsigned c = xb_ld(&bar[XB_XCNT(j)]); sum += c; cnt += (c > 0u) ? 1u : 0u; mine = (j == x) ? c : mine; }
        if (sum == G) break;
        __builtin_amdgcn_s_sleep(1);
        if ((++sp & 255u) == 0u) { if (xb_ld(&bar[XB_TMO])) break; if (sp > XB_SPIN_CAP) { atomicAdd(&bar[XB_TMO], 1u); break; } }
    }
    nloc = mine > 0u ? mine : 1u; nx = cnt > 0u ? cnt : 1u;
}

__device__ __forceinline__ void xcd_barrier(const XcdBarrier& b, bool t0) {
    asm volatile("s_waitcnt vmcnt(0)" ::: "memory");
    __syncthreads();
    if (t0) {
        unsigned* bar = b.bar;
        __builtin_amdgcn_s_waitcnt(0);
        unsigned nloc = b.st[0], nx = b.st[1];
        if (nloc == 0u) { xcd_barrier_complete(bar, b.x, nloc, nx); b.st[0] = nloc; b.st[1] = nx; }
        const unsigned old = xb_add(&bar[XB_XSUB(b.x)], 1u);
        const unsigned gen = old / nloc;
        if (old + 1u == (gen + 1u) * nloc) {
            __builtin_amdgcn_fence(__ATOMIC_RELEASE, "agent");
            asm volatile("s_waitcnt vmcnt(0)" ::: "memory");
            const unsigned og = xb_add(&bar[XB_TOP], 1u);
            const unsigned tg = og / nx;
            if (og + 1u == (tg + 1u) * nx) xb_add(&bar[XB_TOPGEN], 1u);
            else XB_SPIN(xb_ld(&bar[XB_TOPGEN]) == tg, bar);
            __builtin_amdgcn_fence(__ATOMIC_ACQUIRE, "agent");
            xb_add(&bar[XB_XGEN(b.x)], 1u);
            asm volatile("s_waitcnt vmcnt(0)" ::: "memory");
        } else {
            XB_SPIN(xb_ld(&bar[XB_XGEN(b.x)]) == gen, bar);
            __builtin_amdgcn_fence(__ATOMIC_ACQUIRE, "agent");
            asm volatile("s_waitcnt vmcnt(0)" ::: "memory");
        }
    }
    __syncthreads();
}

__device__ __forceinline__ int crow(int r, int hi) { return (r & 3) + 8 * (r >> 2) + 4 * hi; }
typedef short v4i16_t __attribute__((ext_vector_type(4)));
__device__ __forceinline__ s16x4 ldtr(const LAS unsigned char* p) { return __builtin_bit_cast(s16x4, __builtin_amdgcn_ds_read_tr16_b64_v4i16((LAS v4i16_t*)p)); }
__device__ __forceinline__ bf16x8 ldfrag(const LAS unsigned char* p) { return *(const LAS bf16x8*)p; }
__device__ __forceinline__ float halfswap_max(float m) { auto rr = __builtin_amdgcn_permlane32_swap(__float_as_uint(m), __float_as_uint(m), false, false); return fmaxf(__uint_as_float(rr[0]), __uint_as_float(rr[1])); }
__device__ __forceinline__ float halfswap_sum(float m) { auto rr = __builtin_amdgcn_permlane32_swap(__float_as_uint(m), __float_as_uint(m), false, false); return __uint_as_float(rr[0]) + __uint_as_float(rr[1]); }
__device__ __forceinline__ bf16x8 pack8(const f32x16& p, int base) {
    u32x4 w; w.x = pk2(p[base + 0], p[base + 1]); w.y = pk2(p[base + 2], p[base + 3]); w.z = pk2(p[base + 4], p[base + 5]); w.w = pk2(p[base + 6], p[base + 7]);
    return __builtin_bit_cast(bf16x8, w);
}
__device__ __forceinline__ int t5_bucket(int n) {
    if (n < 16) return n;
    int bkt = 16;
    bkt += (n >= 19); bkt += (n >= 21); bkt += (n >= 24); bkt += (n >= 27); bkt += (n >= 31); bkt += (n >= 35); bkt += (n >= 40); bkt += (n >= 46);
    bkt += (n >= 52); bkt += (n >= 59); bkt += (n >= 67); bkt += (n >= 77); bkt += (n >= 87); bkt += (n >= 99); bkt += (n >= 113);
    return bkt;
}

namespace att {
constexpr int L_RING = 0;
constexpr int L_TB = 98304;
constexpr int L_WSF = L_TB + 512;
constexpr int L_STAGE = 0;
constexpr int SROW = 132;
constexpr float THR = 8.0f;

__device__ __forceinline__ void attn_unit(KArgs a, LAS unsigned char* lds, int WV, int b, int h, int qb, bool dummy = false) {
    int tid_ = TID_OF(WV); asm volatile("" : "+v"(tid_));
    const int tid = tid_, lane = tid & 63, r32 = lane & 31, hi = lane >> 5, wave = WV;
    const int rb = wave & 3, mp = wave >> 2;
    bf16* AQ = (bf16*)(a->ws + WS_AQ); const bf16* AK = (const bf16*)(a->ws + WS_AK); const bf16* AV = (const bf16*)(a->ws + WS_AV); const bf16* AZ = (const bf16*)(a->ws + WS_AZ);
    const float* relb = a->in[16]; const float* anw = a->in[15];
    const size_t rowbase = (size_t)b * SEQ; const int q0 = qb * 128;
    const int qmin = q0 + 32 * rb, qrow = qmin + r32;
    LAS float* tb = (LAS float*)(lds + L_TB); LAS float* wsf = (LAS float*)(lds + L_WSF) + wave * 64; LAS float* stage = (LAS float*)(lds + L_STAGE);
    bf16x8 qf[4];
#pragma unroll
    for (int ks = 0; ks < 4; ++ks) qf[ks] = *(const bf16x8*)(AQ + (rowbase + qrow) * 1024 + h * 128 + mp * 64 + ks * 16 + hi * 8);
    if (tid < 128) tb[tid] = (tid < 113) ? (relb[t5_bucket(tid) * AH + h] - relb[31 * AH + h]) * LOG2E : 0.f;
    const int lc = tid & 15, lkv = tid >> 4;
    const bf16* kg = AK + (rowbase + lkv) * 1024 + h * 128 + lc * 8;
    const bf16* vg = AV + (rowbase + lkv) * 1024 + h * 128 + lc * 8;
    const int kofs0 = lc * 1024 + ((lkv ^ lc) * 16), kofs1 = lc * 1024 + (((lkv + 32) ^ lc) * 16);
    const int vofs0 = 16384 + (lc >> 2) * 4096 + (lkv >> 4) * 1024 + (lkv & 15) * 64 + (lc & 3) * 16, vofs1 = vofs0 + 2048;
    const int NT = 2 * qb + 2;
    u32x4 kA0, kA1, vA0, vA1, kB0, kB1, vB0, vB1;
#define ATT_LOAD(K0, K1, V0, V1, t) do { const size_t go_ = (size_t)(t) * 64 * 1024; K0 = *(const u32x4*)(kg + go_); K1 = *(const u32x4*)(kg + go_ + 32 * 1024); V0 = *(const u32x4*)(vg + go_); V1 = *(const u32x4*)(vg + go_ + 32 * 1024); } while (0)
#define ATT_STORE(K0, K1, V0, V1, bo) do { LAS unsigned char* nb_ = lds + L_RING + (bo); *(LAS u32x4*)(nb_ + kofs0) = K0; *(LAS u32x4*)(nb_ + kofs1) = K1; *(LAS u32x4*)(nb_ + vofs0) = V0; *(LAS u32x4*)(nb_ + vofs1) = V1; } while (0)
    ATT_LOAD(kA0, kA1, vA0, vA1, 0); ATT_LOAD(kB0, kB1, vB0, vB1, 1);
    ATT_STORE(kA0, kA1, vA0, vA1, 0);
    __syncthreads();
    f32x16 o[4];
#pragma unroll
    for (int e = 0; e < 4; ++e)
#pragma unroll
        for (int r = 0; r < 16; ++r) o[e][r] = 0.f;
    float mref = 0.f, lsum = 0.f;
    f32x16 negm;
#pragma unroll
    for (int r = 0; r < 16; ++r) negm[r] = 0.f;
    const int vlane = ((lane >> 4) & 1) * 32 + (lane & 3) * 8 + (4 * hi + ((lane & 15) >> 2)) * 64;
    int bcur = 0, bnext = 32768;
    for (int jj = 0; jj < NT; jj += 2) {
#pragma unroll
      for (int par = 0; par < 2; ++par) { const int j = jj + par;
        if (j + 2 < NT) { if (par == 0) ATT_LOAD(kA0, kA1, vA0, vA1, j + 2); else ATT_LOAD(kB0, kB1, vB0, vB1, j + 2); }
        const int kv0 = 64 * j;
        if (kv0 <= qmin + 31) {
            const LAS unsigned char* kb = lds + L_RING + bcur; const LAS unsigned char* vb = kb + 16384 + vlane;
            f32x16 s0, s1;
            { bf16x8 kf[8];
#pragma unroll
              for (int ks = 0; ks < 4; ++ks) { const int cgi = mp * 8 + 2 * ks + hi;
                  kf[2 * ks] = ldfrag(kb + cgi * 1024 + ((r32 ^ cgi) * 16)); kf[2 * ks + 1] = ldfrag(kb + cgi * 1024 + (((r32 + 32) ^ cgi) * 16)); }
              __builtin_amdgcn_sched_barrier(0);
#pragma unroll
              for (int ks = 0; ks < 4; ++ks) {
                  s0 = __builtin_amdgcn_mfma_f32_32x32x16_bf16(kf[2 * ks], qf[ks], ks == 0 ? negm : s0, 0, 0, 0);
                  s1 = __builtin_amdgcn_mfma_f32_32x32x16_bf16(kf[2 * ks + 1], qf[ks], ks == 0 ? negm : s1, 0, 0, 0); } }
            s16x4 vAl[4], vAh[4], vBl[4], vBh[4];
#pragma unroll
            for (int ks = 0; ks < 4; ++ks) { vAl[ks] = ldtr(vb + ks * 1024); vAh[ks] = ldtr(vb + ks * 1024 + 512); }
            if (qmin - (kv0 + 63) < 113) {
#pragma unroll
                for (int r = 0; r < 16; ++r) { const int d0 = qrow - (kv0 + crow(r, hi)); const int i0 = min(max(d0, 0), 127), i1 = min(max(d0 - 32, 0), 127);
                    s0[r] += tb[i0]; s1[r] += tb[i1]; }
            }
            if (kv0 + 63 > qmin) {
#pragma unroll
                for (int r = 0; r < 16; ++r) { const int kv = kv0 + crow(r, hi); if (kv > qrow) s0[r] = -INFINITY; if (kv + 32 > qrow) s1[r] = -INFINITY; }
            }
            float rm;
            { float m0_ = fmaxf(fmaxf(s0[0], s0[1]), s0[2]), m1_ = fmaxf(fmaxf(s0[3], s0[4]), s0[5]), m2_ = fmaxf(fmaxf(s1[0], s1[1]), s1[2]), m3_ = fmaxf(fmaxf(s1[3], s1[4]), s1[5]);
              m0_ = fmaxf(fmaxf(m0_, s0[6]), s0[7]); m1_ = fmaxf(fmaxf(m1_, s0[8]), s0[9]); m2_ = fmaxf(fmaxf(m2_, s1[6]), s1[7]); m3_ = fmaxf(fmaxf(m3_, s1[8]), s1[9]);
              m0_ = fmaxf(fmaxf(m0_, s0[10]), s0[11]); m1_ = fmaxf(fmaxf(m1_, s0[12]), s0[13]); m2_ = fmaxf(fmaxf(m2_, s1[10]), s1[11]); m3_ = fmaxf(fmaxf(m3_, s1[12]), s1[13]);
              m0_ = fmaxf(fmaxf(m0_, s0[14]), s0[15]); m2_ = fmaxf(fmaxf(m2_, s1[14]), s1[15]);
              rm = fmaxf(fmaxf(m0_, m1_), fmaxf(m2_, m3_)); }
            rm = halfswap_max(rm);
            if (j == 0 || __any(rm > THR)) {
                const float dl = (j == 0) ? rm : fmaxf(rm, 0.f);
                mref += dl;
#pragma unroll
                for (int r = 0; r < 16; ++r) { s0[r] -= dl; s1[r] -= dl; negm[r] = -mref; }
                if (j != 0) { const float f = __builtin_amdgcn_exp2f(-dl); lsum *= f;
                    if (hi == 0) wsf[r32] = f;
#pragma unroll
                    for (int r = 0; r < 16; ++r) { const float fr_ = wsf[crow(r, hi)];
#pragma unroll
                        for (int e = 0; e < 4; ++e) o[e][r] *= fr_; } }
            }
#pragma unroll
            for (int r = 0; r < 16; ++r) { s0[r] = __builtin_amdgcn_exp2f(s0[r]); s1[r] = __builtin_amdgcn_exp2f(s1[r]); }
            lsum += (((s0[0] + s0[1]) + (s0[2] + s0[3])) + ((s0[4] + s0[5]) + (s0[6] + s0[7]))) + (((s0[8] + s0[9]) + (s0[10] + s0[11])) + ((s0[12] + s0[13]) + (s0[14] + s0[15])))
                  + (((s1[0] + s1[1]) + (s1[2] + s1[3])) + ((s1[4] + s1[5]) + (s1[6] + s1[7]))) + (((s1[8] + s1[9]) + (s1[10] + s1[11])) + ((s1[12] + s1[13]) + (s1[14] + s1[15])));
            const bf16x8 pa0 = pack8(s0, 0), pa1 = pack8(s0, 8), pa2 = pack8(s1, 0), pa3 = pack8(s1, 8);
#define ATT_VFX(L, H, k) (bf16x8){L[k][0], L[k][1], L[k][2], L[k][3], H[k][0], H[k][1], H[k][2], H[k][3]}
#define ATT_PV(e, L, H) do { o[e] = __builtin_amdgcn_mfma_f32_32x32x16_bf16(pa0, ATT_VFX(L, H, 0), o[e], 0, 0, 0); o[e] = __builtin_amdgcn_mfma_f32_32x32x16_bf16(pa1, ATT_VFX(L, H, 1), o[e], 0, 0, 0); \
                o[e] = __builtin_amdgcn_mfma_f32_32x32x16_bf16(pa2, ATT_VFX(L, H, 2), o[e], 0, 0, 0); o[e] = __builtin_amdgcn_mfma_f32_32x32x16_bf16(pa3, ATT_VFX(L, H, 3), o[e], 0, 0, 0); } while (0)
#define ATT_VRD(L, H, e) do { _Pragma("unroll") for (int ks = 0; ks < 4; ++ks) { L[ks] = ldtr(vb + (e) * 4096 + ks * 1024); H[ks] = ldtr(vb + (e) * 4096 + ks * 1024 + 512); } } while (0)
            ATT_VRD(vBl, vBh, 1); __builtin_amdgcn_sched_barrier(0); ATT_PV(0, vAl, vAh);
            ATT_VRD(vAl, vAh, 2); __builtin_amdgcn_sched_barrier(0); ATT_PV(1, vBl, vBh);
            ATT_VRD(vBl, vBh, 3); __builtin_amdgcn_sched_barrier(0); ATT_PV(2, vAl, vAh);
            __builtin_amdgcn_sched_barrier(0); ATT_PV(3, vBl, vBh);
#undef ATT_VFX
#undef ATT_PV
#undef ATT_VRD
        }
        if (j + 1 < NT) { if (par == 0) ATT_STORE(kB0, kB1, vB0, vB1, bnext); else ATT_STORE(kA0, kA1, vA0, vA1, bnext); }
        bcur = bnext; bnext = (bnext == 65536) ? 0 : bnext + 32768;
        __syncthreads();
      }
    }
#undef ATT_LOAD
#undef ATT_STORE
    u32x4 zpre[4];
    { int te_ = tid; asm volatile("" : "+v"(te_)); const int row = te_ >> 2, part = te_ & 3;
      const u32x4* zp = (const u32x4*)(AZ + (rowbase + q0 + row) * 1024 + h * 128 + 32 * part);
#pragma unroll
      for (int i = 0; i < 4; ++i) zpre[i] = zp[i]; }
    const float ltot = halfswap_sum(lsum);
    const float lam_ = *(volatile LAS float*)(lds + LDS_BYTES - 48);
    const float sc = (mp == 0 ? 1.0f : -lam_) / ltot;
    if (hi == 0) wsf[r32] = sc;
    float scr[16];
#pragma unroll
    for (int r = 0; r < 16; ++r) scr[r] = wsf[crow(r, hi)];
    if (mp == 0) {
#pragma unroll
        for (int e = 0; e < 4; ++e)
#pragma unroll
            for (int r = 0; r < 16; ++r) stage[(32 * rb + crow(r, hi)) * SROW + 32 * e + r32] = o[e][r] * scr[r];
    }
    __syncthreads();
    if (mp == 1) {
#pragma unroll
        for (int e = 0; e < 4; ++e)
#pragma unroll
            for (int r = 0; r < 16; ++r) stage[(32 * rb + crow(r, hi)) * SROW + 32 * e + r32] += o[e][r] * scr[r];
    }
    __syncthreads();
    { const int row = tid >> 2, part = tid & 3;
      const LAS f32x4* sp = (const LAS f32x4*)(stage + row * SROW + 32 * part);
      f32x4 v[8]; float ss = 0.f;
#pragma unroll
      for (int i = 0; i < 8; ++i) { v[i] = sp[i]; ss += (v[i][0] * v[i][0] + v[i][1] * v[i][1]) + (v[i][2] * v[i][2] + v[i][3] * v[i][3]); }
      ss = xadd<1>(ss); ss = xadd<2>(ss);
      const float rs = 0.8f / sqrtf(ss * (1.f / 128.f) + EPS);
      const size_t go = (rowbase + q0 + row) * 1024 + h * 128 + 32 * part;
      u32x4* op = dummy ? (u32x4*)((bf16*)(a->ws + WS_DUMMY) + (size_t)row * 1024 + h * 128 + 32 * part) : (u32x4*)(AQ + go); const f32x4* wp = (const f32x4*)(anw + 32 * part);
#pragma unroll
      for (int i = 0; i < 4; ++i) { const u32x4 z = zpre[i]; const f32x4 w0 = wp[2 * i], w1 = wp[2 * i + 1]; const f32x4 x0 = v[2 * i] * rs * w0, x1 = v[2 * i + 1] * rs * w1;
          u32x4 w; w.x = pk2(x0[0] * bflo(z.x), x0[1] * bfhi(z.x)); w.y = pk2(x0[2] * bflo(z.y), x0[3] * bfhi(z.y));
          w.z = pk2(x1[0] * bflo(z.z), x1[1] * bfhi(z.z)); w.w = pk2(x1[2] * bflo(z.w), x1[3] * bfhi(z.w)); op[i] = w; } }
    __syncthreads();
}
}

namespace prep {
constexpr unsigned N_ITEMS = MTOK / 64;
__device__ __forceinline__ void conv_item(KArgs a, int WV, int g) {
    int tid_ = TID_OF(WV); asm volatile("" : "+v"(tid_)); const int tid = tid_;
    bf16* MQ = (bf16*)a->out; bf16* MK = MQ + (size_t)MTOK * 1024; const bf16* HALO = (const bf16*)(a->ws + WS_HALO);
    const int c0 = 2 * tid;
    f32x2 wq[4], wk[4];
#pragma unroll
    for (int j = 0; j < 4; ++j) { wq[j] = *(const f32x2*)(a->in[8] + j * 1024 + c0); wk[j] = *(const f32x2*)(a->in[9] + j * 1024 + c0); }
    unsigned q3 = 0u, q2 = 0u, q1 = 0u, k3 = 0u, k2 = 0u, k1 = 0u;
    if ((g & 31) != 0) { const bf16* hq = HALO + (size_t)(g - 1) * 3 * 1024 + c0; const bf16* hk = hq + (size_t)512 * 3 * 1024;
        q3 = *(const unsigned*)hq; q2 = *(const unsigned*)(hq + 1024); q1 = *(const unsigned*)(hq + 2048);
        k3 = *(const unsigned*)hk; k2 = *(const unsigned*)(hk + 1024); k1 = *(const unsigned*)(hk + 2048); }
    bf16* qp = MQ + (size_t)g * 64 * 1024 + c0; bf16* kp = MK + (size_t)g * 64 * 1024 + c0;
#define PREP_PASS(ptr, w, h3, h2, h1, SCALE) do { unsigned r_[64]; \
        _Pragma("unroll") for (int t = 0; t < 64; ++t) r_[t] = *(const unsigned*)((ptr) + t * 1024); \
        unsigned p3 = h3, p2 = h2, p1 = h1; \
        _Pragma("unroll") for (int t = 0; t < 64; ++t) { const unsigned u = r_[t]; \
            const float a0 = w[0][0] * bflo(p3) + w[1][0] * bflo(p2) + w[2][0] * bflo(p1) + w[3][0] * bflo(u); \
            const float a1 = w[0][1] * bfhi(p3) + w[1][1] * bfhi(p2) + w[2][1] * bfhi(p1) + w[3][1] * bfhi(u); \
            *(unsigned*)((ptr) + t * 1024) = pk2(siluf(a0) * (SCALE), siluf(a1) * (SCALE)); \
            p3 = p2; p2 = p1; p1 = u; } } while (0)
    PREP_PASS(qp, wq, q3, q2, q1, 0.0625f);
    PREP_PASS(kp, wk, k3, k2, k1, 1.0f);
#undef PREP_PASS
    asm volatile("s_waitcnt vmcnt(0)" ::: "memory");
    __syncthreads();
    if (tid == 0) { __builtin_amdgcn_fence(__ATOMIC_RELEASE, "agent"); asm volatile("s_waitcnt vmcnt(0)" ::: "memory");
        __hip_atomic_fetch_add((unsigned*)(a->ws + WS_CTL) + CW_PREP, 1u, __ATOMIC_RELAXED, __HIP_MEMORY_SCOPE_AGENT); }
}
__device__ __forceinline__ void wait_all(KArgs a, int WV) {
    if (WV == 0 && lane_id() == 0) { unsigned* cnt = (unsigned*)(a->ws + WS_CTL) + CW_PREP; unsigned spins = 0u;
        while (__hip_atomic_load(cnt, __ATOMIC_RELAXED, __HIP_MEMORY_SCOPE_AGENT) < N_ITEMS) { __builtin_amdgcn_s_sleep(16); if (++spins > (1u << 22)) break; }
        __builtin_amdgcn_fence(__ATOMIC_ACQUIRE, "agent"); asm volatile("s_waitcnt vmcnt(0)" ::: "memory"); }
    __syncthreads();
}
}

namespace mls {
#ifdef MLS_KEEP_SB
#define MLS_SB __builtin_amdgcn_sched_barrier(0)
#else
#define MLS_SB do { } while (0)
#endif
constexpr int L_Q = 0;
constexpr int L_K = 32768;
constexpr int L_STAGE = 0;
constexpr int L_KW = 66560;
constexpr int L_V = L_KW + 32768;
constexpr int L_P = L_V + 32768;
constexpr int L_SC = L_P + 8192;
constexpr int L_N = L_SC + 18 * 256;
constexpr int L_CW = L_N + 1024;
constexpr int L_MW = L_CW + 8192;
constexpr int L_END = L_MW + 1024;
static_assert(L_END <= LDS_BYTES, "mLSTM LDS map");
constexpr int SROW = 260;

__device__ __forceinline__ void mlstm_unit(KArgs a, LAS unsigned char* lds, int WV, int b, int h) {
    int tid_ = TID_OF(WV); asm volatile("" : "+v"(tid_));
    const int tid = tid_, lane = tid & 63, r32 = lane & 31, hi = lane >> 5, wave = WV;
    prep::wait_all(a, WV);
    const bf16* MQ = (const bf16*)a->out; unsigned char* wsb = a->ws;
#define MK (MQ + (size_t)MTOK * 1024)
#define MV ((const bf16*)(wsb + WS_MV))
#define GM ((const bf16*)(wsb + WS_GM))
#define HM ((bf16*)(wsb + WS_HB))
#define LI ((const float*)(wsb + WS_LI))
#define LF ((const float*)(wsb + WS_LF))
    LAS float* S_psum = (LAS float*)(lds + L_SC) + 768; LAS float* S_qn = S_psum + 256;
    LAS float* nperm = (LAS float*)(lds + L_N); LAS float* stage = (LAS float*)(lds + L_STAGE);
    f32x16 X[8];
#pragma unroll
    for (int i = 0; i < 8; ++i)
#pragma unroll
        for (int r = 0; r < 16; ++r) X[i][r] = 0.f;
    if (tid < 256) nperm[tid] = 0.f;
    if (tid < 256) ((LAS float*)(lds + L_MW))[tid] = a->in[10][h * 256 + tid];
    float m_prev = 0.f;
    const int tg = WV >> 1;
#define MLS_LANE_IDS int tf_ = tid; asm volatile("" : "+v"(tf_));   \
    const int dp = tf_ & 127, d0 = 2 * dp; \
    const int ppos = (d0 & ~12) | ((d0 & 4) << 1) | ((d0 & 8) >> 1);     \
    const int qch = ppos >> 3, qbo = (ppos & 7) * 2;
#define MLS_LOAD_SET(Rq, Rk, Rv, cc, hs) do { const int t0_ = 32 * (hs) + 8 * tg; int tl_ = tid; asm volatile("" : "+v"(tl_)); const int d0 = 2 * (tl_ & 127);     \
        const size_t ub_ = ((size_t)b * SEQ + 64 * (cc) + t0_) * 1024 + h * 256; \
        const bf16* qb_ = MQ + ub_; const bf16* kb_ = MK + ub_; const bf16* vb_ = MV + ub_; \
        _Pragma("unroll") for (int i = 0; i < 8; ++i) { Rq[i] = *(const unsigned*)(qb_ + (i * 1024 + d0)); Rk[i] = *(const unsigned*)(kb_ + (i * 1024 + d0)); Rv[i] = *(const unsigned*)(vb_ + (i * 1024 + d0)); } } while (0)
#define MLS_FILL_SET(Rq, Rk, Rv, hs) do { const int t0_ = 32 * (hs) + 8 * tg; MLS_LANE_IDS \
        float kw0_[8], kw1_[8]; \
        _Pragma("unroll") for (int t = 0; t < 8; ++t) { const int row = t0_ + t; \
            const int ro_ = row * 512 + ((qch ^ (row & 15)) * 16) + qbo; \
            *(LAS unsigned*)(lds + L_Q + ro_) = Rq[t]; *(LAS unsigned*)(lds + L_K + ro_) = Rk[t]; \
            const float wsr = S_ws[row]; kw0_[t] = bflo(Rk[t]) * wsr; kw1_[t] = bfhi(Rk[t]) * wsr; } \
        const int cs_ = t0_ >> 3; \
        { const int d = d0; const int ro_ = d * 128 + ((cs_ ^ ((d >> 1) & 7)) * 16); \
          u32x4 w; w.x = pk2(kw0_[0], kw0_[1]); w.y = pk2(kw0_[2], kw0_[3]); w.z = pk2(kw0_[4], kw0_[5]); w.w = pk2(kw0_[6], kw0_[7]); *(LAS u32x4*)(lds + L_KW + ro_) = w; \
          u32x4 wv; wv.x = (Rv[0] & 0xffffu) | (Rv[1] << 16); wv.y = (Rv[2] & 0xffffu) | (Rv[3] << 16); wv.z = (Rv[4] & 0xffffu) | (Rv[5] << 16); wv.w = (Rv[6] & 0xffffu) | (Rv[7] << 16); *(LAS u32x4*)(lds + L_V + ro_) = wv; } \
        { const int d = d0 + 1; const int ro_ = d * 128 + ((cs_ ^ ((d >> 1) & 7)) * 16); \
          u32x4 w; w.x = pk2(kw1_[0], kw1_[1]); w.y = pk2(kw1_[2], kw1_[3]); w.z = pk2(kw1_[4], kw1_[5]); w.w = pk2(kw1_[6], kw1_[7]); *(LAS u32x4*)(lds + L_KW + ro_) = w; \
          u32x4 wv; wv.x = (Rv[0] >> 16) | (Rv[1] & 0xffff0000u); wv.y = (Rv[2] >> 16) | (Rv[3] & 0xffff0000u); wv.z = (Rv[4] >> 16) | (Rv[5] & 0xffff0000u); wv.w = (Rv[6] >> 16) | (Rv[7] & 0xffff0000u); *(LAS u32x4*)(lds + L_V + ro_) = wv; } \
    } while (0)
    unsigned SAq[8], SAk[8], SAv[8];
    MLS_LOAD_SET(SAq, SAk, SAv, 0, 0);
    float pf_lf = 0.f, pf_li = 0.f;
    if (wave == 0) { const size_t ub_ = (size_t)b * SEQ * 4 + h; pf_lf = (LF + ub_)[lane * 4]; pf_li = (LI + ub_)[lane * 4]; }
#ifdef STAMP_SEG
    unsigned long long seg_acc = 0ull, seg_t = __builtin_amdgcn_s_memrealtime();
#define SEGT(k) do { const unsigned long long n_ = __builtin_amdgcn_s_memrealtime(); if ((k) == STAMP_SEG) seg_acc += n_ - seg_t; seg_t = n_; } while (0)
#else
#define SEGT(k) do { } while (0)
#endif
    for (int c = 0; c < SEQ / MCH; ++c) {
        const size_t row0 = (size_t)b * SEQ + 64 * c;
        LAS float* S_alpha = (LAS float*)(lds + L_SC) + (c & 1) * 384; LAS float* S_beta = S_alpha + 64; LAS float* S_iw = S_alpha + 128; LAS float* S_clamp = S_alpha + 192; LAS float* S_ws = S_alpha + 256; LAS float* S_misc = S_alpha + 320;
        unsigned SBq[8], SBk[8], SBv[8];
        MLS_LOAD_SET(SBq, SBk, SBv, c, 1);
        if (wave == 0) {
            const float lf = pf_lf, li = pf_li;
            if (c + 1 < SEQ / MCH) { const size_t ub_ = (row0 + 64) * 4 + h; pf_lf = (LF + ub_)[lane * 4]; pf_li = (LI + ub_)[lane * 4]; }
#define MLS_DPP(old_, src_, ctrl_, rmask_) __uint_as_float((unsigned)__builtin_amdgcn_update_dpp((int)__float_as_uint(old_), (int)__float_as_uint(src_), ctrl_, rmask_, 0xf, false))
            float bt = lf;
            bt += MLS_DPP(0.f, bt, 0x111, 0xf); bt += MLS_DPP(0.f, bt, 0x112, 0xf); bt += MLS_DPP(0.f, bt, 0x114, 0xf); bt += MLS_DPP(0.f, bt, 0x118, 0xf);
            bt += MLS_DPP(0.f, bt, 0x142, 0xa); bt += MLS_DPP(0.f, bt, 0x143, 0xc);
            const float beta = li - bt; float cm = beta; const float ninf = -INFINITY;
            cm = fmaxf(cm, MLS_DPP(ninf, cm, 0x111, 0xf)); cm = fmaxf(cm, MLS_DPP(ninf, cm, 0x112, 0xf)); cm = fmaxf(cm, MLS_DPP(ninf, cm, 0x114, 0xf)); cm = fmaxf(cm, MLS_DPP(ninf, cm, 0x118, 0xf));
            cm = fmaxf(cm, MLS_DPP(ninf, cm, 0x142, 0xa)); cm = fmaxf(cm, MLS_DPP(ninf, cm, 0x143, 0xc));
#undef MLS_DPP
            const float mx = fmaxf(cm, m_prev);
            S_alpha[lane] = -mx; S_beta[lane] = beta; S_iw[lane] = __expf(m_prev - mx); S_clamp[lane] = __expf(-(bt + mx));
            const float cmL = __uint_as_float(__builtin_amdgcn_readlane(__float_as_uint(cm), 63)), bL = __uint_as_float(__builtin_amdgcn_readlane(__float_as_uint(bt), 63)); const float mxL = fmaxf(m_prev, cmL);
            S_ws[lane] = __expf(beta - mxL);
            if (lane == 0) S_misc[0] = __expf(m_prev - mxL);
            m_prev = bL + mxL;
        }
        __syncthreads();
        SEGT(0);
        MLS_FILL_SET(SAq, SAk, SAv, 0);
        __builtin_amdgcn_sched_barrier(0);
        MLS_FILL_SET(SBq, SBk, SBv, 1);
        __builtin_amdgcn_sched_barrier(0);
        __syncthreads();
        SEGT(1);
        f32x16 num[2];
        {
            int lo_ = lane; asm volatile("" : "+v"(lo_));
            const int l15 = lo_ & 15, kq = lo_ >> 4, r32a = lo_ & 31, hia = lo_ >> 5;
            const int si = wave >> 1, ti0 = 2 * (wave & 1);
            f32x4 sa[2] = {(f32x4){0.f, 0.f, 0.f, 0.f}, (f32x4){0.f, 0.f, 0.f, 0.f}};
            { const int y = kq ^ l15; const int rowoff = l15 * 512;
              int b4[4];
#pragma unroll
              for (int j = 0; j < 4; ++j) b4[j] = rowoff + (((4 * j) ^ y) * 16);
              const LAS unsigned char* kbase = lds + L_K + si * 8192; const LAS unsigned char* qbase = lds + L_Q + ti0 * 8192;
#pragma unroll
              for (int kk = 0; kk < 8; ++kk) { const int o_ = b4[kk & 3] + (kk >> 2) * 256;
                  const bf16x8 ka = ldfrag(kbase + o_);
                  const bf16x8 q0_ = ldfrag(qbase + o_), q1_ = ldfrag(qbase + 8192 + o_);
                  sa[0] = __builtin_amdgcn_mfma_f32_16x16x32_bf16(ka, q0_, sa[0], 0, 0, 0);
                  sa[1] = __builtin_amdgcn_mfma_f32_16x16x32_bf16(ka, q1_, sa[1], 0, 0, 0); } }
#pragma unroll
            for (int u = 0; u < 2; ++u) { const int ti = ti0 + u, t = 16 * ti + l15, s_ = 16 * si + 4 * kq;
                const float al = S_alpha[t]; const f32x4 bt4 = *(const LAS f32x4*)(S_beta + s_); float pv_[4]; float psum = 0.f;
#pragma unroll
                for (int r = 0; r < 4; ++r) { pv_[r] = (s_ + r <= t) ? sa[u][r] * __expf(al + bt4[r]) : 0.f; psum += pv_[r]; }
                psum = xadd<16>(psum); psum = xadd<32>(psum);
                if (kq == 0) S_psum[si * 64 + t] = psum;
                u32x2 w; w.x = pk2(pv_[0], pv_[1]); w.y = pk2(pv_[2], pv_[3]);
                const int cp = 2 * si + (kq >> 1);
                *(LAS u32x2*)(lds + L_P + t * 128 + ((cp ^ ((t >> 1) & 7)) * 16) + 8 * (kq & 1)) = w; }
#pragma unroll
            for (int r = 0; r < 16; ++r) { num[0][r] = 0.f; num[1][r] = 0.f; }
            { const int yq = hia ^ (r32a & 15); const int rowoff = r32a * 512;
              int b8[8];
#pragma unroll
              for (int g = 0; g < 8; ++g) b8[g] = rowoff + (((2 * g) ^ yq) * 16);
              const LAS unsigned char* qbase = lds + L_Q;
#pragma unroll
              for (int dt = 0; dt < 8; ++dt) { MLS_SB;
#pragma unroll
                  for (int sp = 0; sp < 2; ++sp) { const bf16x8 xb = pack8(X[dt], 8 * sp); const int G_ = 2 * dt + sp; const int o_ = b8[G_ & 7] + (G_ >> 3) * 256;
                      const bf16x8 qa0 = ldfrag(qbase + o_), qa1 = ldfrag(qbase + 16384 + o_);
                      num[0] = __builtin_amdgcn_mfma_f32_32x32x16_bf16(qa0, xb, num[0], 0, 0, 0);
                      num[1] = __builtin_amdgcn_mfma_f32_32x32x16_bf16(qa1, xb, num[1], 0, 0, 0); } } }
            __builtin_amdgcn_sched_barrier(0);
            { int to_ = tid; asm volatile("" : "+v"(to_));
              const int t = to_ >> 3, part = to_ & 7; float accn = 0.f;
#pragma unroll
              for (int i = 0; i < 4; ++i) { const int ch = 4 * part + i; const u32x4 qq = *(const LAS u32x4*)(lds + L_Q + t * 512 + ((ch ^ (t & 15)) * 16));
                  const f32x4 n0 = *(const LAS f32x4*)(nperm + 8 * ch), n1 = *(const LAS f32x4*)(nperm + 8 * ch + 4);
                  accn += bflo(qq.x) * n0[0] + bfhi(qq.x) * n0[1] + bflo(qq.y) * n0[2] + bfhi(qq.y) * n0[3] + bflo(qq.z) * n1[0] + bfhi(qq.z) * n1[1] + bflo(qq.w) * n1[2] + bfhi(qq.w) * n1[3]; }
              accn = xadd<1>(accn); accn = xadd<2>(accn); accn = xadd<4>(accn);
              if (part == 0) S_qn[t] = accn; }
        }
        __syncthreads();
        SEGT(2);
        u32x4 gz[4];
        {
            int lo_ = lane; asm volatile("" : "+v"(lo_));
            const int r32a = lo_ & 31, hia = lo_ >> 5;
            const int e = 32 * wave + r32a;
            const int yk = hia ^ ((r32a >> 1) & 7); const int rowoff = r32a * 128;
            int b4[4];
#pragma unroll
            for (int ks = 0; ks < 4; ++ks) b4[ks] = rowoff + (((2 * ks) ^ yk) * 16);
            bf16x8 vf[4];
#pragma unroll
            for (int ks = 0; ks < 4; ++ks) vf[ks] = ldfrag(lds + L_V + wave * 4096 + b4[ks]);
#pragma unroll
            for (int tt = 0; tt < 2; ++tt) {
#pragma unroll
                for (int g = 0; g < 4; ++g) { const f32x4 iw4 = *(const LAS f32x4*)(S_iw + 32 * tt + 8 * g + 4 * hia);
#pragma unroll
                    for (int q = 0; q < 4; ++q) num[tt][4 * g + q] *= iw4[q]; }
#pragma unroll
                for (int ks = 0; ks < 4; ++ks) { const bf16x8 pa = ldfrag(lds + L_P + tt * 4096 + b4[ks]);
                    num[tt] = __builtin_amdgcn_mfma_f32_32x32x16_bf16(pa, vf[ks], num[tt], 0, 0, 0); }
#pragma unroll
                for (int r = 0; r < 16; ++r) stage[(32 * tt + crow(r, hia)) * SROW + e] = num[tt][r];
            }
            if (c + 1 < SEQ / MCH) MLS_LOAD_SET(SAq, SAk, SAv, c + 1, 0);
#ifndef MLS_GATE_LATE
            { int to2_ = tid; asm volatile("" : "+v"(to2_)); const int t = to2_ >> 3, part = to2_ & 7;
              const u32x4* gp = (const u32x4*)(GM + row0 * 1024 + h * 256 + (t * 1024 + 32 * part));
#pragma unroll
              for (int i = 0; i < 4; ++i) gz[i] = gp[i]; }
#endif
            const float decay = S_misc[0];
#pragma unroll
            for (int dt = 0; dt < 8; ++dt) { MLS_SB;
#pragma unroll
                for (int r = 0; r < 16; ++r) X[dt][r] *= decay;
#pragma unroll
                for (int ks = 0; ks < 4; ++ks) { const bf16x8 ka = ldfrag(lds + L_KW + dt * 4096 + b4[ks]);
                    X[dt] = __builtin_amdgcn_mfma_f32_32x32x16_bf16(ka, vf[ks], X[dt], 0, 0, 0); } }
            __builtin_amdgcn_sched_barrier(0);
            int to_ = tid; asm volatile("" : "+v"(to_));
            if (to_ < 256) { const int d = to_; float s = 0.f;
#pragma unroll
                for (int i = 0; i < 8; ++i) { const u32x4 kk = *(const LAS u32x4*)(lds + L_KW + d * 128 + i * 16);
                    s += (bflo(kk.x) + bfhi(kk.x)) + (bflo(kk.y) + bfhi(kk.y)) + (bflo(kk.z) + bfhi(kk.z)) + (bflo(kk.w) + bfhi(kk.w)); }
                const int p = (d & ~12) | ((d & 4) << 1) | ((d & 8) >> 1);
                nperm[p] = decay * nperm[p] + s; }
        }
        __syncthreads();
        SEGT(3);
        { int te_ = tid; asm volatile("" : "+v"(te_)); const int t = te_ >> 3, part = te_ & 7;
          const float den = S_iw[t] * S_qn[t] + ((S_psum[t] + S_psum[64 + t]) + (S_psum[128 + t] + S_psum[192 + t]));
          const float hd = 1.0f / fmaxf(fabsf(den), S_clamp[t]);
          const LAS f32x4* sp = (const LAS f32x4*)(stage + t * SROW + 32 * part);
          f32x4 v[8]; float s1 = 0.f;
#pragma unroll
          for (int i = 0; i < 8; ++i) { v[i] = sp[i] * hd; s1 += (v[i][0] + v[i][1]) + (v[i][2] + v[i][3]); }
          s1 = xadd<1>(s1); s1 = xadd<2>(s1); s1 = xadd<4>(s1);
          const float mu = s1 * (1.f / 256.f); float s2 = 0.f;
#pragma unroll
          for (int i = 0; i < 8; ++i) { v[i] = v[i] - mu; s2 += (v[i][0] * v[i][0] + v[i][1] * v[i][1]) + (v[i][2] * v[i][2] + v[i][3] * v[i][3]); }
          s2 = xadd<1>(s2); s2 = xadd<2>(s2); s2 = xadd<4>(s2);
          const float rs = 1.0f / sqrtf(s2 * (1.f / 256.f) + EPS);
          const size_t ub = row0 * 1024 + h * 256; const int lo2 = t * 1024 + 32 * part;
#ifdef MLS_GATE_LATE
          { const u32x4* gp = (const u32x4*)(GM + ub + lo2);
#pragma unroll
            for (int i = 0; i < 4; ++i) gz[i] = gp[i]; }
#endif
          u32x4* op = (u32x4*)(HM + ub + lo2); const LAS f32x4* wp = (const LAS f32x4*)(lds + L_MW) + 8 * part;
#pragma unroll
          for (int i = 0; i < 4; ++i) { const u32x4 z = gz[i]; const f32x4 w0 = wp[2 * i], w1 = wp[2 * i + 1]; const f32x4 x0 = v[2 * i] * rs * w0, x1 = v[2 * i + 1] * rs * w1;
              u32x4 w; w.x = pk2(x0[0] * bflo(z.x), x0[1] * bfhi(z.x)); w.y = pk2(x0[2] * bflo(z.y), x0[3] * bfhi(z.y));
              w.z = pk2(x1[0] * bflo(z.z), x1[1] * bfhi(z.z)); w.w = pk2(x1[2] * bflo(z.w), x1[3] * bfhi(z.w)); op[i] = w; } }
        SEGT(4);
    }
    __syncthreads();
#ifdef STAMP_SEG
    *(volatile LAS unsigned long long*)(lds + LDS_BYTES - 32) = seg_acc;
#endif
#undef SEGT
#undef MK
#undef MV
#undef GM
#undef HM
#undef LI
#undef LF
#undef MLS_LOAD_SET
#undef MLS_FILL_SET
#undef MLS_LANE_IDS
}
}

__device__ __forceinline__ void phase3(KArgs a, LAS unsigned char* lds, int WV) {
    const int tid = TID_OF(WV), lane = tid & 63;
    float s1 = a->in[11][lane] * a->in[12][lane], s2 = a->in[13][lane] * a->in[14][lane];
    s1 = wave_sum(s1); s2 = wave_sum(s2);
    if (tid == 0) *(volatile LAS float*)(lds + LDS_BYTES - 48) = expf(s1) - expf(s2) + 0.2f;
    LAS unsigned* slot = (LAS unsigned*)(lds + LDS_BYTES - 64);
#if defined(STAMP_UNIT) || defined(STAMP_ITEM)
    unsigned long long unit_span = 0ull;
#endif
    constexpr unsigned N_M1 = BATCH * MH, N_A1 = BATCH * AH * (SEQ / 128);
    constexpr unsigned N_M = N_M1 * REP_ML, N_AD = N_A1 * (REP_AT - 1), N_A = N_AD + N_A1;
    constexpr unsigned N_P = prep::N_ITEMS;
    const bool t0q = (WV == 0 && lane_id() == 0);
    unsigned nx = 0u;
    if (t0q) nx = __hip_atomic_fetch_add((unsigned*)(a->ws + WS_CTL) + CW_QUEUE, 1u, __ATOMIC_RELAXED, __HIP_MEMORY_SCOPE_AGENT);
    for (;;) {
        if (t0q) *slot = nx;
        __syncthreads();
        unsigned it = *slot;
        __syncthreads();
        if (it >= N_P + N_M + N_A) break;
        if (t0q) nx = __hip_atomic_fetch_add((unsigned*)(a->ws + WS_CTL) + CW_QUEUE, 1u, __ATOMIC_RELAXED, __HIP_MEMORY_SCOPE_AGENT);
#ifdef STAMP_ITEM
        const unsigned it_abs = it; const unsigned long long ti0 = __builtin_amdgcn_s_memrealtime();
#define STAMP_ITEM_END() do { if (it_abs == STAMP_ITEM) unit_span = __builtin_amdgcn_s_memrealtime() - ti0; } while (0)
#else
#define STAMP_ITEM_END() do { } while (0)
#endif
        if (it < N_P) { prep::conv_item(a, WV, (int)it); STAMP_ITEM_END(); continue; }
        it -= N_P;
        if (it < N_M) { const unsigned u = it % N_M1;
#ifdef STAMP_UNIT
            const unsigned long long tu0 = __builtin_amdgcn_s_memrealtime();
#endif
            mls::mlstm_unit(a, lds, WV, (int)(u >> 2), (int)(u & 3));
#ifdef STAMP_UNIT
#ifdef STAMP_SEG
            if (it == STAMP_UNIT) unit_span = *(volatile LAS unsigned long long*)(lds + LDS_BYTES - 32);
#else
            if (it == STAMP_UNIT) unit_span = __builtin_amdgcn_s_memrealtime() - tu0;
#endif
#endif
        }
        else { const unsigned i0 = it - N_M; const bool dummy = i0 < N_AD; const unsigned i = i0 % N_A1; const int qb = 15 - (int)(i >> 7), bh = (int)(i & 127); att::attn_unit(a, lds, WV, bh >> 3, bh & 7, qb, dummy); }
        STAMP_ITEM_END();
    }
#if defined(STAMP_UNIT) || defined(STAMP_ITEM)
    if (unit_span) { const unsigned long long t_end = __builtin_amdgcn_s_memrealtime(); while (__builtin_amdgcn_s_memrealtime() - t_end < unit_span) __builtin_amdgcn_s_sleep(8); }
#endif
}
template <bool COOP>
__global__ void __launch_bounds__(NTHREADS, 2) fwd(Args args) {
    extern __shared__ __attribute__((aligned(16))) unsigned char lds_raw[];
    LAS unsigned char* lds = (LAS unsigned char*)lds_raw;
    const int G = gridDim.x, bx = blockIdx.x;
    const int WV = __builtin_amdgcn_readfirstlane((int)threadIdx.x >> 6);
    const int vcu = (G % 8 == 0) ? (bx % 8) * (G / 8) + bx / 8 : bx;
    const int lo = args.ph_lo, hi = args.ph_hi;
    volatile LAS unsigned* MISC = (volatile LAS unsigned*)(lds + LDS_BYTES - 128);
    if (WV == 0) { const int l_ = lane_id(); if (l_ < 32) MISC[l_] = 0u; }
    __syncthreads();
    XcdBarrier bar; bar.bar = nullptr; bar.x = 0; bar.st = nullptr;
    if constexpr (COOP) bar = xcd_barrier_post((unsigned*)(kargs()->ws + WS_CTL) + CW_BAR, MISC + 8, WV == 0 && lane_id() == 0);
#define IN(k) (lo <= (k) && (k) < hi)
#ifdef STAMP_PHASE
    unsigned long long st_t0 = 0ull, st_t1 = 0ull;
#define STAMP_BEGIN(k) do { if ((k) == STAMP_PHASE) st_t0 = __builtin_amdgcn_s_memrealtime(); } while (0)
#define STAMP_END(k) do { if ((k) == STAMP_PHASE) st_t1 = __builtin_amdgcn_s_memrealtime(); } while (0)
#else
#define STAMP_BEGIN(k) do { } while (0)
#define STAMP_END(k) do { } while (0)
#endif
#ifdef MK_CG_SEAM0
#define SEAM(k) do { if constexpr (COOP) { if (IN(k) && IN((k) + 1)) { if ((k) == 0) cg::this_grid().sync(); else xcd_barrier(bar, WV == 0 && lane_id() == 0); } } } while (0)
#else
#define SEAM(k) do { if constexpr (COOP) { if (IN(k) && IN((k) + 1)) xcd_barrier(bar, WV == 0 && lane_id() == 0); } } while (0)
#endif
    STAMP_BEGIN(0);
    if (IN(0)) for (int rep = 0; rep < REP_P0; ++rep) { phase0(kargs(), lds, vcu, G, WV); __syncthreads(); }
    SEAM(0);
    STAMP_END(0);
    STAMP_BEGIN(1);
    if (IN(1)) for (int rep = 0; rep < REP_P1; ++rep) { phase1(kargs(), lds, vcu, G, WV); __syncthreads(); }
    SEAM(1);
    STAMP_END(1);
    STAMP_BEGIN(2);
    if (IN(2)) {
#pragma unroll 1
        for (int rep = 0; rep < REP_P2; ++rep) {
        const KArgs ka = kargs(); unsigned char* ws_ = ka->ws; float* out_ = ka->out;
        pg8::Gemm g{(const bf16*)(ws_ + WS_HB), (const bf16*)(ws_ + WS_HB), (const bf16*)(ws_ + WS_WIN), MTOK, NPROJ, 1024, 1024, 16};
        pg8::StaticOrder S; S.init(MTOK, NPROJ, G, bx);
        EpiProj E{(bf16*)out_, (bf16*)out_ + (size_t)MTOK * 1024, (bf16*)(ws_ + WS_MV), (bf16*)(ws_ + WS_GM), (bf16*)(ws_ + WS_AQ), (bf16*)(ws_ + WS_AK), (bf16*)(ws_ + WS_AV), (bf16*)(ws_ + WS_AZ), (bf16*)(ws_ + WS_HALO)};
        pg8::gemm_phase<EpiProj, pg8::StaticOrder, true, true>(lds, g, S, E, WV);
        }
    }
    SEAM(2);
    STAMP_END(2);
    STAMP_BEGIN(3);
    if (IN(3)) phase3(kargs(), lds, WV);
    SEAM(3);
    STAMP_END(3);
    STAMP_BEGIN(4);
    if (IN(4)) {
#pragma unroll 1
        for (int rep = 0; rep < REP_P4; ++rep) {
        const KArgs ka = kargs(); unsigned char* ws_ = ka->ws; float* out_ = ka->out; const float* x_ = ka->in[0];
        pg8::Gemm g{(const bf16*)(ws_ + WS_HB), (const bf16*)(ws_ + WS_AQ), (const bf16*)(ws_ + WS_WOUT), MTOK, D, DMIX, 1024, 16};
        pg8::StaticOrder S; S.init(MTOK, D, G, bx);
        EpiOut E{x_, (const float*)(ws_ + WS_MOD), out_, (float*)(ws_ + WS_RSS)};
        pg8::gemm_phase<EpiOut, pg8::StaticOrder, true, true>(lds, g, S, E, WV);
        }
    }
    SEAM(4);
    STAMP_END(4);
    STAMP_BEGIN(5);
    if (IN(5)) phase5(kargs(), vcu, G, WV);
#if REP_P5 > 1
    if (IN(5)) { __syncthreads(); phase5_touch(kargs(), vcu, G, WV); }
#endif
    STAMP_END(5);
#ifdef STAMP_PHASE
    if (blockIdx.x == 0 && WV == 0 && lane_id() == 0) { const unsigned long long t_end = __builtin_amdgcn_s_memrealtime(); while (__builtin_amdgcn_s_memrealtime() - t_end < (st_t1 - st_t0)) __builtin_amdgcn_s_sleep(8); }
#endif
#undef IN
#undef SEAM
}

#ifndef MK_MULTI
#define MK_MULTI 0
#endif
extern "C" void kernel_launch(void* const* d_in, const int* in_sizes, int n_in, void* d_out, int out_size, void* d_ws, size_t ws_size, hipStream_t stream) {
    static int grid = 0;
    if (grid == 0) {
        if (n_in != 19 || out_size != MTOK * D || ws_size < WS_END) { fprintf(stderr, "kernel_launch: unexpected shapes (n_in %d, out %d, ws %zu)\n", n_in, out_size, ws_size); grid = -1; return; }
        int dev = 0, cus = 0, per_cu = 0;
        (void)hipGetDevice(&dev); (void)hipDeviceGetAttribute(&cus, hipDeviceAttributeMultiprocessorCount, dev);
        (void)hipFuncSetAttribute((const void*)fwd<!MK_MULTI>, hipFuncAttributeMaxDynamicSharedMemorySize, LDS_BYTES);
        (void)hipOccupancyMaxActiveBlocksPerMultiprocessor(&per_cu, (const void*)fwd<!MK_MULTI>, NTHREADS, LDS_BYTES);
        if (per_cu < 1) { fprintf(stderr, "kernel_launch: occupancy query says %d blocks per CU\n", per_cu); per_cu = 1; }
        (void)hipGetLastError();
        grid = cus * (per_cu > 1 ? 1 : per_cu);
    }
    if (grid < 0) return;
    (void)hipMemsetAsync((char*)d_ws + WS_CTL, 0, 1 * MiB, stream);
    Args a{};
    for (int i = 0; i < 19; ++i) a.in[i] = (const float*)d_in[i];
    a.out = (float*)d_out; a.ws = (unsigned char*)d_ws;
#if MK_MULTI
    for (int ph = 0; ph < 6; ++ph) { a.ph_lo = ph; a.ph_hi = ph + 1; hipLaunchKernelGGL(fwd<false>, dim3(grid), dim3(NTHREADS), LDS_BYTES, stream, a); }
#else
    a.ph_lo = 0; a.ph_hi = 6;
    void* kargs[] = {&a};
    hipError_t e = hipLaunchCooperativeKernel((const void*)fwd<true>, dim3(grid), dim3(NTHREADS), kargs, LDS_BYTES, stream);
    if (e != hipSuccess) fprintf(stderr, "cooperative launch failed: %s (grid %d)\n", hipGetErrorString(e), grid);
#endif
}
```

```cpp
#include <hip/hip_runtime.h>
#include <hip/hip_cooperative_groups.h>
#include <cstdio>
#include <cstdint>
#include <cmath>
namespace cg = cooperative_groups;
namespace pg8 {
#define PG8_LAS __attribute__((address_space(3)))
typedef unsigned short bf16_t;
typedef short bf16x8 __attribute__((ext_vector_type(8)));
typedef float f32x4 __attribute__((ext_vector_type(4)));
typedef unsigned u32x4 __attribute__((ext_vector_type(4)));
constexpr int BM = 256, BK = 64, HALF = 128, HTB = HALF * BK * 2  , STAGE_BYTES = 8 * HTB, NXCD = 8, WGM = 8;

__host__ __device__ __forceinline__ int lds_byte(int r, int c) { const int st = (r >> 4) * 2 + (c >> 5), rr = r & 15, cc = c & 31, ob = rr * 64 + cc * 2; return st * 1024 + (ob ^ (((ob >> 9) & 1) << 5)); }
__host__ __device__ __forceinline__ void stage_rc(int b, int& R, int& C) { const int st = b / 1024, sb = b % 1024, swz = sb ^ (((sb >> 9) & 1) << 5); R = (st >> 1) * 16 + swz / 64; C = (st & 1) * 32 + (swz % 64) / 2; }
__host__ __device__ __forceinline__ int perm32(int rho) { const int n = rho >> 4, i = rho & 15; return 8 * (i >> 2) + 4 * n + (i & 3); }

struct Unit { int pm, pn; };
struct Gemm { const bf16_t* A; const bf16_t* A2; const bf16_t* Bt; int M, N, K, lda, nt1; };

struct StaticOrder {
    int nM, nN, nwg, G, c;
    __host__ __device__ void init(int M, int N, int G_, int c_) { nM = M / BM; nN = N / BM; nwg = nM * nN; G = G_; c = c_; }
    __host__ __device__ bool next(int i, Unit& u) const {
        const long L = (long)i * G + c; if (L >= nwg) return false;
        int wgid = (int)L; { const int q = nwg / NXCD, r = nwg % NXCD, xcd = wgid % NXCD, off = wgid / NXCD; wgid = (xcd < r ? xcd * (q + 1) : r * (q + 1) + (xcd - r) * q) + off; }
        const int nig = WGM * nN, gid = wgid / nig, fm = gid * WGM, gsz = (nM - fm) < WGM ? (nM - fm) : WGM;
        u.pm = fm + ((wgid % nig) % gsz); u.pn = (wgid % nig) / gsz; return true;
    }
    __device__ __forceinline__ void a_ready(const Unit&) const {}
    __device__ __forceinline__ void done(const Unit&) const {}
};

__device__ __forceinline__ unsigned cvt_pk_bf16(float lo, float hi) { unsigned r; asm volatile("v_cvt_pk_bf16_f32 %0, %1, %2" : "=v"(r) : "v"(lo), "v"(hi)); return r; }
template <class Epi, class Sched, bool ALIGN_EPI = false, bool SP2 = false>
__device__ __forceinline__ void gemm_phase(PG8_LAS unsigned char* lds, const Gemm g, const Sched& S, const Epi& E, const int wid) {
    const int lane = (int)__builtin_amdgcn_mbcnt_hi(~0u, __builtin_amdgcn_mbcnt_lo(~0u, 0u)), tid = wid * 64 + lane, wr = wid >> 2, wc = wid & 3, fr = lane & 15, fq = lane >> 4;
    const int K = g.K, nt = K / BK;
    unsigned voffA[2], voffB[2];
#pragma unroll
    for (int i = 0; i < 2; ++i) { int R, C; stage_rc(tid * 16 + i * 8192, R, C); const int Rb = Epi::PERM ? ((R & ~31) + perm32(R & 31)) : R;
        voffA[i] = (unsigned)(R * g.lda + C) * 2u; voffB[i] = (unsigned)(Rb * K + C) * 2u; }
    const size_t kstep = (size_t)(BK * 2);
    const size_t hstep = (size_t)HALF * K * 2;
    const size_t tstep = 2 * hstep;
    const size_t hstepA = (size_t)HALF * g.lda * 2, tstepA = 2 * hstepA; const int nt1 = g.nt1;
#define PG8_AP(b1, b2, t) ((t) < nt1 ? (b1) + (size_t)(t) * kstep : (b2) + (size_t)((t) - nt1) * kstep)
    const unsigned ldsw = (unsigned)wid * 1024u;
    const int aoff = lds_byte(wr * 64 + fr, fq * 8), boff = lds_byte(wc * 32 + fr, fq * 8);
#define PG8_SA(b, h) (((b) * 2 + (h)) * HTB)
#define PG8_SB(b, h) ((4 + (b) * 2 + (h)) * HTB)
#define PG8_STAGE(bufoff, gbase, voff) do { _Pragma("unroll") for (int _i = 0; _i < 2; ++_i) \
        __builtin_amdgcn_global_load_lds((const unsigned*)((const char*)(gbase) + (voff)[_i]), (PG8_LAS unsigned*)(lds + (bufoff) + ldsw + _i * 8192), 16, 0, 0); } while (0)
#define PG8_LDA(dst, b, h) do { _Pragma("unroll") for (int m = 0; m < 4; ++m) _Pragma("unroll") for (int k = 0; k < 2; ++k) dst[m][k] = *(const PG8_LAS bf16x8*)(lds + PG8_SA(b, h) + aoff + m * 2048 + k * 1024); } while (0)
#define PG8_LDB(dst, b, h) do { _Pragma("unroll") for (int n = 0; n < 2; ++n) _Pragma("unroll") for (int k = 0; k < 2; ++k) dst[n][k] = *(const PG8_LAS bf16x8*)(lds + PG8_SB(b, h) + boff + n * 2048 + k * 1024); } while (0)
#define PG8_MMA(ai, bj, At, Bt) do { __builtin_amdgcn_s_setprio(1); _Pragma("unroll") for (int m = 0; m < 4; ++m) _Pragma("unroll") for (int n = 0; n < 2; ++n) _Pragma("unroll") for (int k = 0; k < 2; ++k) \
        acc[ai][bj][m][n] = __builtin_amdgcn_mfma_f32_16x16x32_bf16(Bt[n][k], At[m][k], acc[ai][bj][m][n], 0, 0, 0); __builtin_amdgcn_s_setprio(0); } while (0)
#define PG8_WAIT_V(n) asm volatile("s_waitcnt vmcnt(" #n ")" ::: "memory")
#define PG8_WAIT_L(n) asm volatile("s_waitcnt lgkmcnt(" #n ")" ::: "memory")
#define PG8_BAR __builtin_amdgcn_s_barrier()
#define PG8_SCHED __builtin_amdgcn_sched_barrier(0)
    Unit cur, nxt; int ui = 0;
    if (!S.next(0, cur)) return;
    f32x4 acc[2][2][4][2];
#pragma unroll
    for (int a = 0; a < 2; ++a)
#pragma unroll
        for (int b = 0; b < 2; ++b)
#pragma unroll
            for (int m = 0; m < 4; ++m)
#pragma unroll
                for (int n = 0; n < 2; ++n) acc[a][b][m][n] = (f32x4){0.f, 0.f, 0.f, 0.f};
    bf16x8 At[4][2], B0[2][2], B1[2][2];
    const char* cA = (const char*)g.A + (size_t)cur.pm * tstepA; const char* cA2 = (const char*)g.A2 + (size_t)cur.pm * tstepA; const char* cB = (const char*)g.Bt + (size_t)cur.pn * tstep;
    S.a_ready(cur);
    if constexpr (SP2) {
        PG8_STAGE(PG8_SB(0, 0), cB, voffB); PG8_STAGE(PG8_SB(0, 1), cB + hstep, voffB); PG8_STAGE(PG8_SA(0, 0), cA, voffA); PG8_STAGE(PG8_SA(0, 1), cA + hstepA, voffA);
        if (wr == 1) PG8_BAR;
        PG8_WAIT_V(2); PG8_BAR;
        PG8_STAGE(PG8_SB(1, 0), cB + kstep, voffB); PG8_STAGE(PG8_SA(1, 0), cA + kstep, voffA); PG8_STAGE(PG8_SB(1, 1), cB + hstep + kstep, voffB);
        PG8_WAIT_V(6); PG8_BAR;
    } else {
        PG8_STAGE(PG8_SB(0, 0), cB, voffB); PG8_STAGE(PG8_SA(0, 0), cA, voffA); PG8_STAGE(PG8_SB(0, 1), cB + hstep, voffB); PG8_STAGE(PG8_SA(0, 1), cA + hstepA, voffA);
        if (wr == 1) PG8_BAR;
        PG8_WAIT_V(4); PG8_BAR;
        PG8_STAGE(PG8_SB(1, 0), cB + kstep, voffB); PG8_STAGE(PG8_SA(1, 0), cA + kstep, voffA); PG8_STAGE(PG8_SB(1, 1), cB + hstep + kstep, voffB);
        PG8_WAIT_V(6); PG8_BAR;
    }
    for (;;) {
        const bool has_next = S.next(ui + 1, nxt);
        const char* nA = has_next ? (const char*)g.A + (size_t)nxt.pm * tstepA : cA; const char* nA2 = has_next ? (const char*)g.A2 + (size_t)nxt.pm * tstepA : cA2; const char* nB = has_next ? (const char*)g.Bt + (size_t)nxt.pn * tstep : cB;
        for (int t = 0; t < nt; t += 2) {
            const bool last = (t == nt - 2);
            const char* a1 = PG8_AP(cA, cA2, t + 1);
            const char* a2 = last ? nA : PG8_AP(cA, cA2, t + 2); const char* b2 = last ? nB : cB + (size_t)(t + 2) * kstep;
            const char* a3 = last ? nA + kstep : PG8_AP(cA, cA2, t + 3); const char* b3 = b2 + kstep;
            if (last && has_next) S.a_ready(nxt);
            if constexpr (SP2) {
            PG8_LDB(B0, 0, 0); PG8_LDB(B1, 0, 1); PG8_SCHED; PG8_LDA(At, 0, 0); PG8_STAGE(PG8_SA(1, 1), a1 + hstepA, voffA);
            PG8_WAIT_V(8); PG8_WAIT_L(0); PG8_BAR; PG8_MMA(0, 0, At, B0); PG8_MMA(0, 1, At, B1); PG8_BAR; PG8_SCHED;
            PG8_LDA(At, 0, 1); PG8_STAGE(PG8_SB(0, 0), b2, voffB); PG8_STAGE(PG8_SB(0, 1), b2 + hstep, voffB); PG8_STAGE(PG8_SA(0, 0), a2, voffA);
            PG8_WAIT_V(8); PG8_WAIT_L(0); PG8_BAR; PG8_MMA(1, 0, At, B0); PG8_MMA(1, 1, At, B1); PG8_BAR; PG8_SCHED;
            PG8_LDB(B0, 1, 0); PG8_LDB(B1, 1, 1); PG8_SCHED; PG8_LDA(At, 1, 0); PG8_STAGE(PG8_SA(0, 1), a2 + hstepA, voffA);
            PG8_WAIT_V(8); PG8_WAIT_L(0); PG8_BAR; PG8_MMA(0, 0, At, B0); PG8_MMA(0, 1, At, B1); PG8_BAR; PG8_SCHED;
            PG8_LDA(At, 1, 1); PG8_STAGE(PG8_SB(1, 0), b3, voffB); PG8_STAGE(PG8_SB(1, 1), b3 + hstep, voffB); PG8_STAGE(PG8_SA(1, 0), a3, voffA);
            PG8_WAIT_V(8); PG8_WAIT_L(0); PG8_BAR; PG8_MMA(1, 0, At, B0); PG8_MMA(1, 1, At, B1); PG8_BAR; PG8_SCHED;
            } else {
            PG8_LDB(B0, 0, 0); PG8_SCHED; PG8_LDA(At, 0, 0); PG8_STAGE(PG8_SA(1, 1), a1 + hstepA, voffA);
            PG8_WAIT_L(8); PG8_BAR; PG8_WAIT_L(0); PG8_MMA(0, 0, At, B0); PG8_BAR; PG8_SCHED;
            PG8_LDB(B1, 0, 1); PG8_STAGE(PG8_SB(0, 0), b2, voffB);
            PG8_BAR; PG8_WAIT_L(0); PG8_MMA(0, 1, At, B1); PG8_BAR;
            PG8_LDA(At, 0, 1); PG8_STAGE(PG8_SA(0, 0), a2, voffA);
            PG8_BAR; PG8_WAIT_L(0); PG8_MMA(1, 0, At, B0); PG8_BAR; PG8_SCHED;
            PG8_STAGE(PG8_SB(0, 1), b2 + hstep, voffB);
            PG8_WAIT_V(6); PG8_BAR; PG8_MMA(1, 1, At, B1); PG8_BAR;
            PG8_LDB(B0, 1, 0); PG8_SCHED; PG8_LDA(At, 1, 0); PG8_STAGE(PG8_SA(0, 1), a2 + hstepA, voffA);
            PG8_WAIT_L(8); PG8_BAR; PG8_WAIT_L(0); PG8_MMA(0, 0, At, B0); PG8_BAR; PG8_SCHED;
            PG8_LDB(B1, 1, 1); PG8_STAGE(PG8_SB(1, 0), b3, voffB);
            PG8_BAR; PG8_WAIT_L(0); PG8_MMA(0, 1, At, B1); PG8_BAR;
            PG8_LDA(At, 1, 1); PG8_STAGE(PG8_SA(1, 0), a3, voffA);
            PG8_BAR; PG8_WAIT_L(0); PG8_MMA(1, 0, At, B0); PG8_BAR; PG8_SCHED;
            PG8_STAGE(PG8_SB(1, 1), b3 + hstep, voffB);
            PG8_WAIT_V(6); PG8_BAR; PG8_MMA(1, 1, At, B1); PG8_BAR;
            }
        }
        if constexpr (ALIGN_EPI) { if (wr == 0) PG8_BAR; }
        if constexpr (!Epi::AFTER_DRAIN) { E(acc, cur, wr, wc, fr, fq); S.done(cur); }
        if (!has_next) break;
#pragma unroll
        for (int a = 0; a < 2; ++a)
#pragma unroll
            for (int b = 0; b < 2; ++b)
#pragma unroll
                for (int m = 0; m < 4; ++m)
#pragma unroll
                    for (int n = 0; n < 2; ++n) acc[a][b][m][n] = (f32x4){0.f, 0.f, 0.f, 0.f};
        cur = nxt; cA = nA; cA2 = nA2; cB = nB; ++ui;
        if constexpr (ALIGN_EPI) { if (wr == 1) PG8_BAR; }
    }
    PG8_WAIT_V(0);
    if constexpr (!ALIGN_EPI) { if (wr == 0) PG8_BAR; }
    PG8_BAR;
    if constexpr (Epi::AFTER_DRAIN) { E.fused(acc, cur, wr, wc, fr, fq, lds, wid, lane); S.done(cur); }
#undef PG8_AP
#undef PG8_SA
#undef PG8_SB
#undef PG8_STAGE
#undef PG8_LDA
#undef PG8_LDB
#undef PG8_MMA
#undef PG8_WAIT_V
#undef PG8_WAIT_L
#undef PG8_BAR
#undef PG8_SCHED
}
}
#ifndef REP_P0
#define REP_P0 1
#endif
#ifndef REP_P5
#define REP_P5 1
#endif
#ifndef REP_P1
#define REP_P1 1
#endif
#ifndef REP_P2
#define REP_P2 1
#endif
#ifndef REP_ML
#define REP_ML 1
#endif
#ifndef REP_AT
#define REP_AT 1
#endif
#ifndef REP_P4
#define REP_P4 1
#endif
constexpr int NWAVES = 8, NTHREADS = 512;
constexpr int D = 1024, BATCH = 16, SEQ = 2048, MTOK = BATCH * SEQ, DIN = 9224, NPROJ = 9216, DMIX = 2048;
constexpr int MH = 4, MHD = 256, AH = 8, AVD = 128, AQK = 64, MCH = 64;
constexpr int C_MQ = 0, C_MK = 1024, C_MV = 2048, C_MO = 3072, C_MZ = 4096, C_MI = 5120, C_MF = 5124, C_AQ = 5128, C_AK = 6152, C_AV = 7176, C_AZ = 8200;
constexpr float EPS = 1e-6f, LOG2E = 1.4426950408889634f;
constexpr float QSCALE = 0.125f * LOG2E;
constexpr size_t MiB = 1u << 20;
constexpr size_t WS_CTL = 0;
constexpr size_t WS_MOD = 1 * MiB;
constexpr size_t WS_LI = 2 * MiB;
constexpr size_t WS_LF = 2 * MiB + 512 * 1024;
constexpr size_t WS_RSS = 4 * MiB;
constexpr size_t WS_WIN = 8 * MiB;
constexpr size_t WS_WOUT = 26 * MiB;
constexpr size_t WS_HB = 32 * MiB;
constexpr size_t WS_MV = 96 * MiB;
constexpr size_t WS_GM = 160 * MiB;
constexpr size_t WS_AQ = 224 * MiB;
constexpr size_t WS_AK = 288 * MiB;
constexpr size_t WS_AV = 352 * MiB;
constexpr size_t WS_AZ = 416 * MiB;
constexpr size_t WS_END = 480 * MiB;
constexpr size_t WS_HALO = 480 * MiB;
constexpr size_t WS_DUMMY = 496 * MiB;
constexpr int CW_QUEUE = 64;
constexpr int CW_PREP = 128;
constexpr int LDS_BYTES = 155648;

#define LAS __attribute__((address_space(3)))
typedef unsigned short bf16;
typedef float f32x4 __attribute__((ext_vector_type(4)));
typedef float f32x16 __attribute__((ext_vector_type(16)));
typedef float f32x2 __attribute__((ext_vector_type(2)));
typedef short bf16x8 __attribute__((ext_vector_type(8)));
typedef short s16x4 __attribute__((ext_vector_type(4)));
typedef unsigned u32x4 __attribute__((ext_vector_type(4)));
typedef unsigned u32x2 __attribute__((ext_vector_type(2)));
typedef __bf16 bf16x2_t __attribute__((ext_vector_type(2)));

__device__ __forceinline__ unsigned pk2(float lo, float hi) { f32x2 v = {lo, hi}; bf16x2_t b = __builtin_convertvector(v, bf16x2_t); return __builtin_bit_cast(unsigned, b); }
__device__ __forceinline__ float bflo(unsigned u) { return __uint_as_float(u << 16); }
__device__ __forceinline__ float bfhi(unsigned u) { return __uint_as_float(u & 0xffff0000u); }
__device__ __forceinline__ float siluf(float x) { return x * __builtin_amdgcn_rcpf(1.f + __expf(-x)); }
__device__ __forceinline__ float sigmf(float x) { return __builtin_amdgcn_rcpf(1.f + __expf(-x)); }
__device__ __forceinline__ int lane_id() { int l; asm volatile("v_mbcnt_lo_u32_b32 %0, -1, 0\n\tv_mbcnt_hi_u32_b32 %0, -1, %0" : "=v"(l)); return l; }
#define TID_OF(wv) ((wv) * 64 + lane_id())
template <int M> __device__ __forceinline__ float xadd(float v) {
    if constexpr (M == 32) { auto rr = __builtin_amdgcn_permlane32_swap(__float_as_uint(v), __float_as_uint(v), false, false); return __uint_as_float(rr[0]) + __uint_as_float(rr[1]); }
    else return v + __uint_as_float((unsigned)__builtin_amdgcn_ds_swizzle((int)__float_as_uint(v), (M << 10) | 0x1f));
}
template <int M> __device__ __forceinline__ float xswz(float v) {
    return __uint_as_float((unsigned)__builtin_amdgcn_ds_swizzle((int)__float_as_uint(v), (M << 10) | 0x1f));
}
__device__ __forceinline__ float wave_sum(float v) { v = xadd<1>(v); v = xadd<2>(v); v = xadd<4>(v); v = xadd<8>(v); v = xadd<16>(v); v = xadd<32>(v); return v; }

struct Args { const float* in[19]; float* out; unsigned char* ws; int ph_lo, ph_hi; };
typedef const __attribute__((address_space(4))) Args* KArgs;
__device__ __forceinline__ KArgs kargs() { KArgs p = (KArgs)__builtin_amdgcn_kernarg_segment_ptr(); asm volatile("" : "+s"(p)); return p; }

__device__ __forceinline__ int win_src_col(int n) {
    if (n < 3072) return n;
    if (n < 5120) { const int g = (n - 3072) >> 8, r = (n - 3072) & 255; return (r < 128) ? C_MO + 128 * g + r : C_MZ + 128 * g + (r - 128); }
    return n + 8;
}
__device__ __forceinline__ void p0_transpose_item(const float* W, int ldw, int K, bf16* WT, int k0, int n0, int sc0, LAS float* scr, int lane) {
#pragma unroll
    for (int i = 0; i < 32; ++i) { const int kk = 2 * i + (lane >> 5); scr[kk * 33 + (lane & 31)] = W[(size_t)(k0 + kk) * ldw + sc0 + (lane & 31)]; }
    asm volatile("s_waitcnt lgkmcnt(0)" ::: "memory");
    const int c = lane & 7;
#pragma unroll
    for (int j = 0; j < 4; ++j) { const int n = (lane >> 3) + 8 * j; const LAS float* s = scr + (8 * c) * 33 + n;
        u32x4 o; o.x = pk2(s[0 * 33], s[1 * 33]); o.y = pk2(s[2 * 33], s[3 * 33]); o.z = pk2(s[4 * 33], s[5 * 33]); o.w = pk2(s[6 * 33], s[7 * 33]);
        *(u32x4*)(WT + (size_t)(n0 + n) * K + k0 + 8 * c) = o; }
    asm volatile("s_waitcnt lgkmcnt(0)" ::: "memory");
}
__device__ __forceinline__ void phase0(KArgs a, LAS unsigned char* lds, int vcu, int G, int WV) {
    const int tid = TID_OF(WV), lane = tid & 63, wave = WV;
    const float* c = a->in[1]; const float* w_ada = a->in[3]; const float* b_ada = a->in[4];
    float* mod = (float*)(a->ws + WS_MOD);
    if (blockIdx.x == 0 && tid == 0) ((unsigned*)(a->ws + WS_CTL))[CW_QUEUE] = 0u;
    for (int cgp = vcu; cgp < 256; cgp += G) {
        const int b = tid >> 5, part = tid & 31, j0 = 12 * cgp;
        float acc[12];
#pragma unroll
        for (int j = 0; j < 12; ++j) acc[j] = 0.f;
#pragma unroll 8
        for (int ii = 0; ii < 32; ++ii) { const int i = part + 32 * ii;
            const float s = c[b * 1024 + i]; const float sv = s / (1.f + expf(-s));
            const f32x4* wr = (const f32x4*)(w_ada + (size_t)i * 3072 + j0);
            const f32x4 w0 = wr[0], w1 = wr[1], w2 = wr[2];
            acc[0] += sv * w0[0]; acc[1] += sv * w0[1]; acc[2] += sv * w0[2]; acc[3] += sv * w0[3];
            acc[4] += sv * w1[0]; acc[5] += sv * w1[1]; acc[6] += sv * w1[2]; acc[7] += sv * w1[3];
            acc[8] += sv * w2[0]; acc[9] += sv * w2[1]; acc[10] += sv * w2[2]; acc[11] += sv * w2[3]; }
#pragma unroll
        for (int j = 0; j < 12; ++j) { float v = acc[j];
            v = xadd<1>(v); v = xadd<2>(v); v = xadd<4>(v); v = xadd<8>(v); v = xadd<16>(v);
            if (part == 0) mod[b * 3072 + j0 + j] = v + b_ada[j0 + j]; }
    }
}

__device__ __forceinline__ void weight_copies(KArgs a, LAS float* scr, int vcu, int G, int wave, int lane) {
    const int gw = vcu * NWAVES + wave, NGW = G * NWAVES;
    constexpr int I_IN = (1024 / 64) * (NPROJ / 32), I_OUT = (2048 / 64) * (1024 / 32);
    bf16* WinT = (bf16*)(a->ws + WS_WIN); bf16* WoutT = (bf16*)(a->ws + WS_WOUT);
    for (int it = gw; it < I_IN + I_OUT; it += NGW) {
        if (it < I_IN) { const int nb = it % (NPROJ / 32), kb = it / (NPROJ / 32); p0_transpose_item(a->in[5], DIN, 1024, WinT, 64 * kb, 32 * nb, win_src_col(32 * nb), scr, lane); }
        else { const int r = it - I_IN, nb = r % 32, kb = r / 32; p0_transpose_item(a->in[17], 1024, 2048, WoutT, 64 * kb, 32 * nb, 32 * nb, scr, lane); }
    }
}

__device__ __forceinline__ void phase1(KArgs a, LAS unsigned char* lds, int vcu, int G, int WV) {
    const int tid = TID_OF(WV), lane = tid & 63, wave = WV;
    const float* x = a->in[0]; const float* norm_w = a->in[2]; const float* w_in = a->in[5]; const float* b_i = a->in[6]; const float* b_f = a->in[7];
    const float* mod = (const float*)(a->ws + WS_MOD);
    bf16* HB = (bf16*)(a->ws + WS_HB); float* LI = (float*)(a->ws + WS_LI); float* LF = (float*)(a->ws + WS_LF);
    LAS float* wg = (LAS float*)lds;
#pragma unroll
    for (int i = tid; i < 1024 * 8; i += NTHREADS) { const int k = i >> 3, q = i & 7;
        wg[(((((k >> 8) * 4 + (k & 3)) * 2 + (q >> 2)) * 64 + ((k & 255) >> 2)) * 4) + (q & 3)] = w_in[(size_t)k * DIN + C_MI + q]; }
    weight_copies(a, (LAS float*)(lds + 32768 + wave * 8448), vcu, G, wave, lane);
    __syncthreads();
    const int gw = vcu * NWAVES + wave, NGW = G * NWAVES;
    for (int grp = gw; grp < MTOK / 16; grp += NGW) {
        const int row0 = grp * 16, b = row0 / SEQ;
        f32x4 am[4], sh[4];
#pragma unroll
        for (int j = 0; j < 4; ++j) { const int col = 4 * lane + 256 * j;
            const f32x4 nw = *(const f32x4*)(norm_w + col), sc = *(const f32x4*)(mod + b * 3072 + 1024 + col);
            am[j] = nw * (sc + 1.0f); sh[j] = *(const f32x4*)(mod + b * 3072 + col); }
        f32x4 vn[4];
        { const f32x4* xr = (const f32x4*)(x + (size_t)row0 * D) + lane;
#pragma unroll
          for (int j = 0; j < 4; ++j) vn[j] = xr[64 * j]; }
        for (int r = 0; r < 16; ++r) { const int row = row0 + r;
            LAS float* wgr = wg; asm volatile("" : "+v"(wgr));
            f32x4 v[4]; float s = 0.f;
#pragma unroll
            for (int j = 0; j < 4; ++j) { v[j] = vn[j]; s += (v[j][0] * v[j][0] + v[j][1] * v[j][1]) + (v[j][2] * v[j][2] + v[j][3] * v[j][3]); }
            if (r < 15) { const f32x4* xr = (const f32x4*)(x + (size_t)(row + 1) * D) + lane;
#pragma unroll
                for (int j = 0; j < 4; ++j) vn[j] = xr[64 * j]; }
            const float rstd = 1.0f / sqrtf(wave_sum(s) * (1.f / D) + EPS);
            float g8[8];
#pragma unroll
            for (int q = 0; q < 8; ++q) g8[q] = 0.f;
            u32x2* o8 = (u32x2*)(HB + (size_t)row * D) + lane;
#pragma unroll
            for (int j = 0; j < 4; ++j) { const f32x4 hv = v[j] * rstd * am[j] + sh[j];
                u32x2 w; w.x = pk2(hv[0], hv[1]); w.y = pk2(hv[2], hv[3]); o8[64 * j] = w;
#pragma unroll
                for (int e = 0; e < 4; ++e) {
                    const f32x4 w0 = *(const LAS f32x4*)(wgr + ((((j * 4 + e) * 2 + 0) * 64 + lane) * 4)), w1 = *(const LAS f32x4*)(wgr + ((((j * 4 + e) * 2 + 1) * 64 + lane) * 4));
                    g8[0] += hv[e] * w0[0]; g8[1] += hv[e] * w0[1]; g8[2] += hv[e] * w0[2]; g8[3] += hv[e] * w0[3];
                    g8[4] += hv[e] * w1[0]; g8[5] += hv[e] * w1[1]; g8[6] += hv[e] * w1[2]; g8[7] += hv[e] * w1[3]; } }
            { const bool b0 = lane & 1, b1 = lane & 2, b2 = lane & 4;
              float h4[4], h2[2], m1;
#pragma unroll
              for (int q = 0; q < 4; ++q) { const float keep = b0 ? g8[4 + q] : g8[q], send = b0 ? g8[q] : g8[4 + q]; h4[q] = keep + xswz<1>(send); }
#pragma unroll
              for (int q = 0; q < 2; ++q) { const float keep = b1 ? h4[2 + q] : h4[q], send = b1 ? h4[q] : h4[2 + q]; h2[q] = keep + xswz<2>(send); }
              { const float keep = b2 ? h2[1] : h2[0], send = b2 ? h2[0] : h2[1]; m1 = keep + xswz<4>(send); }
              m1 = xadd<8>(m1); m1 = xadd<16>(m1); m1 = xadd<32>(m1);
              const int gq = ((lane & 1) << 2) | (lane & 2) | ((lane >> 2) & 1); const bool isf = gq >= 4; const int gi = gq & 3;
              const float xf = m1 + (isf ? b_f[gi] : b_i[gi]);
              const float outv = isf ? (fminf(xf, 0.f) - log1pf(expf(-fabsf(xf)))) : xf;
              if (lane < 8) (isf ? LF : LI)[(size_t)row * 4 + gi] = outv; }
        }
    }
}

struct EpiProj {
    static constexpr bool PERM = true, AFTER_DRAIN = false;
    bf16 *MQ, *MK, *MV, *GM, *AQ, *AK, *AV, *AZ, *HALO;
    __device__ __forceinline__ void operator()(const pg8::f32x4 (&acc)[2][2][4][2], const pg8::Unit& u, int wr, int wc, int fr, int fq) const {
        const int pn = u.pn; const int row0 = u.pm * 256 + wr * 64 + fr;
        if (pn >= 12 && pn < 20) {
            const int col = 128 * (pn - 12) + wc * 32 + 8 * fq;
#pragma unroll
            for (int ai = 0; ai < 2; ++ai)
#pragma unroll
                for (int m = 0; m < 4; ++m) { bf16* p = GM + (size_t)(row0 + ai * 128 + m * 16) * 1024 + col;
                    float g[8];
#pragma unroll
                    for (int n = 0; n < 2; ++n)
#pragma unroll
                        for (int e = 0; e < 4; ++e) { const float o = acc[ai][0][m][n][e], z = acc[ai][1][m][n][e]; g[4 * n + e] = z * __builtin_amdgcn_rcpf((1.f + __expf(-o)) * (1.f + __expf(-z))); }
                    u32x4 w; w.x = pk2(g[0], g[1]); w.y = pk2(g[2], g[3]); w.z = pk2(g[4], g[5]); w.w = pk2(g[6], g[7]);
                    *(u32x4*)p = w; }
            return;
        }
        bf16* base; float sc = 1.f; int act = 0; int ct;
        if (pn < 4) { base = MQ; ct = pn; } else if (pn < 8) { base = MK; ct = pn - 4; } else if (pn < 12) { base = MV; ct = pn - 8; }
        else if (pn < 24) { base = AQ; ct = pn - 20; sc = QSCALE; } else if (pn < 28) { base = AK; ct = pn - 24; } else if (pn < 32) { base = AV; ct = pn - 28; }
        else { base = AZ; ct = pn - 32; act = 1; }
        const int col0 = ct * 256 + wc * 32 + 8 * fq;
#pragma unroll
        for (int ai = 0; ai < 2; ++ai)
#pragma unroll
            for (int m = 0; m < 4; ++m) { bf16* rowp = base + (size_t)(row0 + ai * 128 + m * 16) * 1024 + col0;
#pragma unroll
                for (int bj = 0; bj < 2; ++bj) { pg8::f32x4 v0 = acc[ai][bj][m][0], v1 = acc[ai][bj][m][1];
                    if (act) { v0 = (pg8::f32x4){siluf(v0[0]), siluf(v0[1]), siluf(v0[2]), siluf(v0[3])}; v1 = (pg8::f32x4){siluf(v1[0]), siluf(v1[1]), siluf(v1[2]), siluf(v1[3])}; }
                    v0 = v0 * sc; v1 = v1 * sc;
                    u32x4 w; w.x = pk2(v0[0], v0[1]); w.y = pk2(v0[2], v0[3]); w.z = pk2(v1[0], v1[1]); w.w = pk2(v1[2], v1[3]);
                    *(u32x4*)(rowp + bj * 128) = w;
                    if (pn < 8) { const int row = row0 + ai * 128 + m * 16;
                        if ((row & 63) >= 61) *(u32x4*)(HALO + ((size_t)((pn >> 2) * 512 + (row >> 6)) * 3 + ((row & 63) - 61)) * 1024 + col0 + bj * 128) = w; } } }
    }
};
struct EpiOut {
    static constexpr bool PERM = false, AFTER_DRAIN = false;
    const float* x; const float* mod; float* out; float* rss;
    __device__ __forceinline__ void operator()(const pg8::f32x4 (&acc)[2][2][4][2], const pg8::Unit& u, int wr, int wc, int fr, int fq) const {
        const int col0 = u.pn * 256 + wc * 32 + 4 * fq; const int b = (u.pm * 256) / SEQ;
        pg8::f32x4 gv[2][2];
#pragma unroll
        for (int bj = 0; bj < 2; ++bj)
#pragma unroll
            for (int n = 0; n < 2; ++n) gv[bj][n] = *(const pg8::f32x4*)(mod + b * 3072 + 2048 + col0 + bj * 128 + n * 16);
#pragma unroll
        for (int ai = 0; ai < 2; ++ai)
#pragma unroll
            for (int m = 0; m < 4; ++m) { const int row = u.pm * 256 + ai * 128 + wr * 64 + m * 16 + fr; const size_t off = (size_t)row * D + col0; float ss = 0.f;
#pragma unroll
                for (int bj = 0; bj < 2; ++bj)
#pragma unroll
                    for (int n = 0; n < 2; ++n) { const pg8::f32x4 xv = *(const pg8::f32x4*)(x + off + bj * 128 + n * 16);
                        const pg8::f32x4 o = xv + gv[bj][n] * acc[ai][bj][m][n];
                        ss += (o[0] * o[0] + o[1] * o[1]) + (o[2] * o[2] + o[3] * o[3]);
                        *(pg8::f32x4*)(out + off + bj * 128 + n * 16) = o; }
                ss = xadd<16>(ss); ss = xadd<32>(ss);
                if (fq == 0) rss[(size_t)row * 16 + u.pn * 4 + wc] = ss; }
    }
};

__device__ __forceinline__ void phase5(KArgs a, int vcu, int G, int WV) {
    const int tid = TID_OF(WV), lane = tid & 63, wave = WV;
    const float* fnw = a->in[18]; const float* rss = (const float*)(a->ws + WS_RSS); float* out = a->out;
    f32x4 fw[4];
#pragma unroll
    for (int j = 0; j < 4; ++j) fw[j] = *(const f32x4*)(fnw + 4 * lane + 256 * j);
    const int gw = vcu * NWAVES + wave, NGW = G * NWAVES;
    for (int grp = gw; grp < MTOK / 16; grp += NGW)
        for (int r = 0; r < 16; ++r) { const int row = grp * 16 + r;
            const f32x4* pr = (const f32x4*)(rss + (size_t)row * 16);
            const f32x4 p0 = pr[0], p1 = pr[1], p2 = pr[2], p3 = pr[3];
            const float tot = (((p0[0] + p0[1]) + (p0[2] + p0[3])) + ((p1[0] + p1[1]) + (p1[2] + p1[3]))) + (((p2[0] + p2[1]) + (p2[2] + p2[3])) + ((p3[0] + p3[1]) + (p3[2] + p3[3])));
            const float rstd = 1.0f / sqrtf(tot * (1.f / D) + EPS);
            f32x4* o = (f32x4*)(out + (size_t)row * D) + lane;
#pragma unroll
            for (int j = 0; j < 4; ++j) o[64 * j] = o[64 * j] * rstd * fw[j]; }
}

__device__ __forceinline__ void phase5_touch(KArgs a, int vcu, int G, int WV) {
    const int tid = TID_OF(WV), lane = tid & 63, wave = WV;
    const float* rss = (const float*)(a->ws + WS_RSS); float* out = a->out;
    const int gw = vcu * NWAVES + wave, NGW = G * NWAVES;
    for (int grp = gw; grp < MTOK / 16; grp += NGW)
        for (int r = 0; r < 16; ++r) { const int row = grp * 16 + r;
            const f32x4* pr = (const f32x4*)(rss + (size_t)row * 16);
            const f32x4 p0 = pr[0], p1 = pr[1], p2 = pr[2], p3 = pr[3];
            const float tot = (p0[0] + p1[0]) + (p2[0] + p3[0]);
            const float one = (tot == -1.2345f) ? 2.f : 1.f;
            f32x4* o = (f32x4*)(out + (size_t)row * D) + lane;
#pragma unroll
            for (int j = 0; j < 4; ++j) o[64 * j] = o[64 * j] * one; }
}
constexpr int CW_BAR = 4096;
#define XB_TMO      128
#define XB_XCNT(j)  (256  + 64 * (j))
#define XB_XSUB(j)  (1280 + 64 * (j))
#define XB_XGEN(j)  (2304 + 64 * (j))
#define XB_TOP      3328
#define XB_TOPGEN   3392
#define XCD_BAR_WORDS 3456
#define XB_SPIN_CAP (1u << 18)

__device__ __forceinline__ unsigned xb_ld(unsigned* p)              { return __hip_atomic_load(p, __ATOMIC_RELAXED, __HIP_MEMORY_SCOPE_AGENT); }
__device__ __forceinline__ unsigned xb_add(unsigned* p, unsigned v) { return __hip_atomic_fetch_add(p, v, __ATOMIC_RELAXED, __HIP_MEMORY_SCOPE_AGENT); }
__device__ __forceinline__ unsigned xb_xcc_id() { return (unsigned)__builtin_amdgcn_s_getreg((3 << 11) | 20) & 0xFu; }
#define XB_SPIN(cond, bar) do { unsigned _sp = 0; while (cond) { __builtin_amdgcn_s_sleep(1); \
    if ((++_sp & 255u) == 0u) { if (xb_ld(&(bar)[XB_TMO])) break; if (_sp > XB_SPIN_CAP) { atomicAdd(&(bar)[XB_TMO], 1u); break; } } } } while (0)

struct XcdBarrier {
    unsigned* bar; unsigned x;
    volatile LAS unsigned* st;
};

__device__ __forceinline__ XcdBarrier xcd_barrier_post(unsigned* bar, volatile LAS unsigned* st, bool t0) {
    XcdBarrier b; b.bar = bar; b.x = xb_xcc_id(); b.st = st;
    if (t0) (void)xb_add(&bar[XB_XCNT(b.x)], 1u);
    return b;
}
__device__ __forceinline__ void xcd_barrier_complete(unsigned* bar, unsigned x, unsigned& nloc, unsigned& nx) {
    const unsigned G = gridDim.x * gridDim.y * gridDim.z;
    unsigned sum, cnt, mine, sp = 0u;
    for (;;) {
        sum = 0u; cnt = 0u; mine = 0u;
#pragma unroll
        for (unsigned j = 0; j < 16; ++j) { const unsigned c = xb_ld(&bar[XB_XCNT(j)]); sum += c; cnt += (c > 0u) ? 1u : 0u; mine = (j == x) ? c : mine; }
        if (sum == G) break;
        __builtin_amdgcn_s_sleep(1);
        if ((++sp & 255u) == 0u) { if (xb_ld(&bar[XB_TMO])) break; if (sp > XB_SPIN_CAP) { atomicAdd(&bar[XB_TMO], 1u); break; } }
    }
    nloc = mine > 0u ? mine : 1u; nx = cnt > 0u ? cnt : 1u;
}

__device__ __forceinline__ void xcd_barrier(const XcdBarrier& b, bool t0) {
    asm volatile("s_waitcnt vmcnt(0)" ::: "memory");
    __syncthreads();
    if (t0) {
        unsigned* bar = b.bar;
        __builtin_amdgcn_s_waitcnt(0);
        unsigned nloc = b.st[0], nx = b.st[1];
        if (nloc == 0u) { xcd_barrier_complete(bar, b.x, nloc, nx); b.st[0] = nloc; b.st[1] = nx; }
        const unsigned old = xb_add(&bar[XB_XSUB(b.x)], 1u);
        const unsigned gen = old / nloc;
        if (old + 1u == (gen + 1u) * nloc) {
            __builtin_amdgcn_fence(__ATOMIC_RELEASE, "agent");
            asm volatile("s_waitcnt vmcnt(0)" ::: "memory");
            const unsigned og = xb_add(&bar[XB_TOP], 1u);
            const unsigned tg = og / nx;
            if (og + 1u == (tg + 1u) * nx) xb_add(&bar[XB_TOPGEN], 1u);
            else XB_SPIN(xb_ld(&bar[XB_TOPGEN]) == tg, bar);
            __builtin_amdgcn_fence(__ATOMIC_ACQUIRE, "agent");
            xb_add(&bar[XB_XGEN(b.x)], 1u);
            asm volatile("s_waitcnt vmcnt(0)" ::: "memory");
        } else {
            XB_SPIN(xb_ld(&bar[XB_XGEN(b.x)]) == gen, bar);
            __builtin_amdgcn_fence(__ATOMIC_ACQUIRE, "agent");
            asm volatile("s_waitcnt vmcnt(0)" ::: "memory");
        }
    }
    __syncthreads();
}

__device__ __forceinline__ int crow(int r, int hi) { return (r & 3) + 8 * (r >> 2) + 4 * hi; }
typedef short v4i16_t __attribute__((ext_vector_type(4)));
__device__ __forceinline__ s16x4 ldtr(const LAS unsigned char* p) { return __builtin_bit_cast(s16x4, __builtin_amdgcn_ds_read_tr16_b64_v4i16((LAS v4i16_t*)p)); }
__device__ __forceinline__ bf16x8 ldfrag(const LAS unsigned char* p) { return *(const LAS bf16x8*)p; }
__device__ __forceinline__ float halfswap_max(float m) { auto rr = __builtin_amdgcn_permlane32_swap(__float_as_uint(m), __float_as_uint(m), false, false); return fmaxf(__uint_as_float(rr[0]), __uint_as_float(rr[1])); }
__device__ __forceinline__ float halfswap_sum(float m) { auto rr = __builtin_amdgcn_permlane32_swap(__float_as_uint(m), __float_as_uint(m), false, false); return __uint_as_float(rr[0]) + __uint_as_float(rr[1]); }
__device__ __forceinline__ bf16x8 pack8(const f32x16& p, int base) {
    u32x4 w; w.x = pk2(p[base + 0], p[base + 1]); w.y = pk2(p[base + 2], p[base + 3]); w.z = pk2(p[base + 4], p[base + 5]); w.w = pk2(p[base + 6], p[base + 7]);
    return __builtin_bit_cast(bf16x8, w);
}
__device__ __forceinline__ int t5_bucket(int n) {
    if (n < 16) return n;
    int bkt = 16;
    bkt += (n >= 19); bkt += (n >= 21); bkt += (n >= 24); bkt += (n >= 27); bkt += (n >= 31); bkt += (n >= 35); bkt += (n >= 40); bkt += (n >= 46);
    bkt += (n >= 52); bkt += (n >= 59); bkt += (n >= 67); bkt += (n >= 77); bkt += (n >= 87); bkt += (n >= 99); bkt += (n >= 113);
    return bkt;
}

namespace att {
constexpr int L_RING = 0;
constexpr int L_TB = 98304;
constexpr int L_WSF = L_TB + 512;
constexpr int L_STAGE = 0;
constexpr int SROW = 132;
constexpr float THR = 8.0f;

__device__ __forceinline__ void attn_unit(KArgs a, LAS unsigned char* lds, int WV, int b, int h, int qb, bool dummy = false) {
    int tid_ = TID_OF(WV); asm volatile("" : "+v"(tid_));
    const int tid = tid_, lane = tid & 63, r32 = lane & 31, hi = lane >> 5, wave = WV;
    const int rb = wave & 3, mp = wave >> 2;
    bf16* AQ = (bf16*)(a->ws + WS_AQ); const bf16* AK = (const bf16*)(a->ws + WS_AK); const bf16* AV = (const bf16*)(a->ws + WS_AV); const bf16* AZ = (const bf16*)(a->ws + WS_AZ);
    const float* relb = a->in[16]; const float* anw = a->in[15];
    const size_t rowbase = (size_t)b * SEQ; const int q0 = qb * 128;
    const int qmin = q0 + 32 * rb, qrow = qmin + r32;
    LAS float* tb = (LAS float*)(lds + L_TB); LAS float* wsf = (LAS float*)(lds + L_WSF) + wave * 64; LAS float* stage = (LAS float*)(lds + L_STAGE);
    bf16x8 qf[4];
#pragma unroll
    for (int ks = 0; ks < 4; ++ks) qf[ks] = *(const bf16x8*)(AQ + (rowbase + qrow) * 1024 + h * 128 + mp * 64 + ks * 16 + hi * 8);
    if (tid < 128) tb[tid] = (tid < 113) ? (relb[t5_bucket(tid) * AH + h] - relb[31 * AH + h]) * LOG2E : 0.f;
    const int lc = tid & 15, lkv = tid >> 4;
    const bf16* kg = AK + (rowbase + lkv) * 1024 + h * 128 + lc * 8;
    const bf16* vg = AV + (rowbase + lkv) * 1024 + h * 128 + lc * 8;
    const int kofs0 = lc * 1024 + ((lkv ^ lc) * 16), kofs1 = lc * 1024 + (((lkv + 32) ^ lc) * 16);
    const int vofs0 = 16384 + (lc >> 2) * 4096 + (lkv >> 4) * 1024 + (lkv & 15) * 64 + (lc & 3) * 16, vofs1 = vofs0 + 2048;
    const int NT = 2 * qb + 2;
    u32x4 kA0, kA1, vA0, vA1, kB0, kB1, vB0, vB1;
#define ATT_LOAD(K0, K1, V0, V1, t) do { const size_t go_ = (size_t)(t) * 64 * 1024; K0 = *(const u32x4*)(kg + go_); K1 = *(const u32x4*)(kg + go_ + 32 * 1024); V0 = *(const u32x4*)(vg + go_); V1 = *(const u32x4*)(vg + go_ + 32 * 1024); } while (0)
#define ATT_STORE(K0, K1, V0, V1, bo) do { LAS unsigned char* nb_ = lds + L_RING + (bo); *(LAS u32x4*)(nb_ + kofs0) = K0; *(LAS u32x4*)(nb_ + kofs1) = K1; *(LAS u32x4*)(nb_ + vofs0) = V0; *(LAS u32x4*)(nb_ + vofs1) = V1; } while (0)
    ATT_LOAD(kA0, kA1, vA0, vA1, 0); ATT_LOAD(kB0, kB1, vB0, vB1, 1);
    ATT_STORE(kA0, kA1, vA0, vA1, 0);
    __syncthreads();
    f32x16 o[4];
#pragma unroll
    for (int e = 0; e < 4; ++e)
#pragma unroll
        for (int r = 0; r < 16; ++r) o[e][r] = 0.f;
    float mref = 0.f, lsum = 0.f;
    f32x16 negm;
#pragma unroll
    for (int r = 0; r < 16; ++r) negm[r] = 0.f;
    const int vlane = ((lane >> 4) & 1) * 32 + (lane & 3) * 8 + (4 * hi + ((lane & 15) >> 2)) * 64;
    int bcur = 0, bnext = 32768;
    for (int jj = 0; jj < NT; jj += 2) {
#pragma unroll
      for (int par = 0; par < 2; ++par) { const int j = jj + par;
        if (j + 2 < NT) { if (par == 0) ATT_LOAD(kA0, kA1, vA0, vA1, j + 2); else ATT_LOAD(kB0, kB1, vB0, vB1, j + 2); }
        const int kv0 = 64 * j;
        if (kv0 <= qmin + 31) {
            const LAS unsigned char* kb = lds + L_RING + bcur; const LAS unsigned char* vb = kb + 16384 + vlane;
            f32x16 s0, s1;
            { bf16x8 kf[8];
#pragma unroll
              for (int ks = 0; ks < 4; ++ks) { const int cgi = mp * 8 + 2 * ks + hi;
                  kf[2 * ks] = ldfrag(kb + cgi * 1024 + ((r32 ^ cgi) * 16)); kf[2 * ks + 1] = ldfrag(kb + cgi * 1024 + (((r32 + 32) ^ cgi) * 16)); }
              __builtin_amdgcn_sched_barrier(0);
#pragma unroll
              for (int ks = 0; ks < 4; ++ks) {
                  s0 = __builtin_amdgcn_mfma_f32_32x32x16_bf16(kf[2 * ks], qf[ks], ks == 0 ? negm : s0, 0, 0, 0);
                  s1 = __builtin_amdgcn_mfma_f32_32x32x16_bf16(kf[2 * ks + 1], qf[ks], ks == 0 ? negm : s1, 0, 0, 0); } }
            s16x4 vAl[4], vAh[4], vBl[4], vBh[4];
#pragma unroll
            for (int ks = 0; ks < 4; ++ks) { vAl[ks] = ldtr(vb + ks * 1024); vAh[ks] = ldtr(vb + ks * 1024 + 512); }
            if (qmin - (kv0 + 63) < 113) {
#pragma unroll
                for (int r = 0; r < 16; ++r) { const int d0 = qrow - (kv0 + crow(r, hi)); const int i0 = min(max(d0, 0), 127), i1 = min(max(d0 - 32, 0), 127);
                    s0[r] += tb[i0]; s1[r] += tb[i1]; }
            }
            if (kv0 + 63 > qmin) {
#pragma unroll
                for (int r = 0; r < 16; ++r) { const int kv = kv0 + crow(r, hi); if (kv > qrow) s0[r] = -INFINITY; if (kv + 32 > qrow) s1[r] = -INFINITY; }
            }
            float rm;
            { float m0_ = fmaxf(fmaxf(s0[0], s0[1]), s0[2]), m1_ = fmaxf(fmaxf(s0[3], s0[4]), s0[5]), m2_ = fmaxf(fmaxf(s1[0], s1[1]), s1[2]), m3_ = fmaxf(fmaxf(s1[3], s1[4]), s1[5]);
              m0_ = fmaxf(fmaxf(m0_, s0[6]), s0[7]); m1_ = fmaxf(fmaxf(m1_, s0[8]), s0[9]); m2_ = fmaxf(fmaxf(m2_, s1[6]), s1[7]); m3_ = fmaxf(fmaxf(m3_, s1[8]), s1[9]);
              m0_ = fmaxf(fmaxf(m0_, s0[10]), s0[11]); m1_ = fmaxf(fmaxf(m1_, s0[12]), s0[13]); m2_ = fmaxf(fmaxf(m2_, s1[10]), s1[11]); m3_ = fmaxf(fmaxf(m3_, s1[12]), s1[13]);
              m0_ = fmaxf(fmaxf(m0_, s0[14]), s0[15]); m2_ = fmaxf(fmaxf(m2_, s1[14]), s1[15]);
              rm = fmaxf(fmaxf(m0_, m1_), fmaxf(m2_, m3_)); }
            rm = halfswap_max(rm);
            if (j == 0 || __any(rm > THR)) {
                const float dl = (j == 0) ? rm : fmaxf(rm, 0.f);
                mref += dl;
#pragma unroll
                for (int r = 0; r < 16; ++r) { s0[r] -= dl; s1[r] -= dl; negm[r] = -mref; }
                if (j != 0) { const float f = __builtin_amdgcn_exp2f(-dl); lsum *= f;
                    if (hi == 0) wsf[r32] = f;
#pragma unroll
                    for (int r = 0; r < 16; ++r) { const float fr_ = wsf[crow(r, hi)];
#pragma unroll
                        for (int e = 0; e < 4; ++e) o[e][r] *= fr_; } }
            }
#pragma unroll
            for (int r = 0; r < 16; ++r) { s0[r] = __builtin_amdgcn_exp2f(s0[r]); s1[r] = __builtin_amdgcn_exp2f(s1[r]); }
            lsum += (((s0[0] + s0[1]) + (s0[2] + s0[3])) + ((s0[4] + s0[5]) + (s0[6] + s0[7]))) + (((s0[8] + s0[9]) + (s0[10] + s0[11])) + ((s0[12] + s0[13]) + (s0[14] + s0[15])))
                  + (((s1[0] + s1[1]) + (s1[2] + s1[3])) + ((s1[4] + s1[5]) + (s1[6] + s1[7]))) + (((s1[8] + s1[9]) + (s1[10] + s1[11])) + ((s1[12] + s1[13]) + (s1[14] + s1[15])));
            const bf16x8 pa0 = pack8(s0, 0), pa1 = pack8(s0, 8), pa2 = pack8(s1, 0), pa3 = pack8(s1, 8);
#define ATT_VFX(L, H, k) (bf16x8){L[k][0], L[k][1], L[k][2], L[k][3], H[k][0], H[k][1], H[k][2], H[k][3]}
#define ATT_PV(e, L, H) do { o[e] = __builtin_amdgcn_mfma_f32_32x32x16_bf16(pa0, ATT_VFX(L, H, 0), o[e], 0, 0, 0); o[e] = __builtin_amdgcn_mfma_f32_32x32x16_bf16(pa1, ATT_VFX(L, H, 1), o[e], 0, 0, 0); \
                o[e] = __builtin_amdgcn_mfma_f32_32x32x16_bf16(pa2, ATT_VFX(L, H, 2), o[e], 0, 0, 0); o[e] = __builtin_amdgcn_mfma_f32_32x32x16_bf16(pa3, ATT_VFX(L, H, 3), o[e], 0, 0, 0); } while (0)
#define ATT_VRD(L, H, e) do { _Pragma("unroll") for (int ks = 0; ks < 4; ++ks) { L[ks] = ldtr(vb + (e) * 4096 + ks * 1024); H[ks] = ldtr(vb + (e) * 4096 + ks * 1024 + 512); } } while (0)
            ATT_VRD(vBl, vBh, 1); __builtin_amdgcn_sched_barrier(0); ATT_PV(0, vAl, vAh);
            ATT_VRD(vAl, vAh, 2); __builtin_amdgcn_sched_barrier(0); ATT_PV(1, vBl, vBh);
            ATT_VRD(vBl, vBh, 3); __builtin_amdgcn_sched_barrier(0); ATT_PV(2, vAl, vAh);
            __builtin_amdgcn_sched_barrier(0); ATT_PV(3, vBl, vBh);
#undef ATT_VFX
#undef ATT_PV
#undef ATT_VRD
        }
        if (j + 1 < NT) { if (par == 0) ATT_STORE(kB0, kB1, vB0, vB1, bnext); else ATT_STORE(kA0, kA1, vA0, vA1, bnext); }
        bcur = bnext; bnext = (bnext == 65536) ? 0 : bnext + 32768;
        __syncthreads();
      }
    }
#undef ATT_LOAD
#undef ATT_STORE
    u32x4 zpre[4];
    { int te_ = tid; asm volatile("" : "+v"(te_)); const int row = te_ >> 2, part = te_ & 3;
      const u32x4* zp = (const u32x4*)(AZ + (rowbase + q0 + row) * 1024 + h * 128 + 32 * part);
#pragma unroll
      for (int i = 0; i < 4; ++i) zpre[i] = zp[i]; }
    const float ltot = halfswap_sum(lsum);
    const float lam_ = *(volatile LAS float*)(lds + LDS_BYTES - 48);
    const float sc = (mp == 0 ? 1.0f : -lam_) / ltot;
    if (hi == 0) wsf[r32] = sc;
    float scr[16];
#pragma unroll
    for (int r = 0; r < 16; ++r) scr[r] = wsf[crow(r, hi)];
    if (mp == 0) {
#pragma unroll
        for (int e = 0; e < 4; ++e)
#pragma unroll
            for (int r = 0; r < 16; ++r) stage[(32 * rb + crow(r, hi)) * SROW + 32 * e + r32] = o[e][r] * scr[r];
    }
    __syncthreads();
    if (mp == 1) {
#pragma unroll
        for (int e = 0; e < 4; ++e)
#pragma unroll
            for (int r = 0; r < 16; ++r) stage[(32 * rb + crow(r, hi)) * SROW + 32 * e + r32] += o[e][r] * scr[r];
    }
    __syncthreads();
    { const int row = tid >> 2, part = tid & 3;
      const LAS f32x4* sp = (const LAS f32x4*)(stage + row * SROW + 32 * part);
      f32x4 v[8]; float ss = 0.f;
#pragma unroll
      for (int i = 0; i < 8; ++i) { v[i] = sp[i]; ss += (v[i][0] * v[i][0] + v[i][1] * v[i][1]) + (v[i][2] * v[i][2] + v[i][3] * v[i][3]); }
      ss = xadd<1>(ss); ss = xadd<2>(ss);
      const float rs = 0.8f / sqrtf(ss * (1.f / 128.f) + EPS);
      const size_t go = (rowbase + q0 + row) * 1024 + h * 128 + 32 * part;
      u32x4* op = dummy ? (u32x4*)((bf16*)(a->ws + WS_DUMMY) + (size_t)row * 1024 + h * 128 + 32 * part) : (u32x4*)(AQ + go); const f32x4* wp = (const f32x4*)(anw + 32 * part);
#pragma unroll
      for (int i = 0; i < 4; ++i) { const u32x4 z = zpre[i]; const f32x4 w0 = wp[2 * i], w1 = wp[2 * i + 1]; const f32x4 x0 = v[2 * i] * rs * w0, x1 = v[2 * i + 1] * rs * w1;
          u32x4 w; w.x = pk2(x0[0] * bflo(z.x), x0[1] * bfhi(z.x)); w.y = pk2(x0[2] * bflo(z.y), x0[3] * bfhi(z.y));
          w.z = pk2(x1[0] * bflo(z.z), x1[1] * bfhi(z.z)); w.w = pk2(x1[2] * bflo(z.w), x1[3] * bfhi(z.w)); op[i] = w; } }
    __syncthreads();
}
}

namespace prep {
constexpr unsigned N_ITEMS = MTOK / 64;
__device__ __forceinline__ void conv_item(KArgs a, int WV, int g) {
    int tid_ = TID_OF(WV); asm volatile("" : "+v"(tid_)); const int tid = tid_;
    bf16* MQ = (bf16*)a->out; bf16* MK = MQ + (size_t)MTOK * 1024; const bf16* HALO = (const bf16*)(a->ws + WS_HALO);
    const int c0 = 2 * tid;
    f32x2 wq[4], wk[4];
#pragma unroll
    for (int j = 0; j < 4; ++j) { wq[j] = *(const f32x2*)(a->in[8] + j * 1024 + c0); wk[j] = *(const f32x2*)(a->in[9] + j * 1024 + c0); }
    unsigned q3 = 0u, q2 = 0u, q1 = 0u, k3 = 0u, k2 = 0u, k1 = 0u;
    if ((g & 31) != 0) { const bf16* hq = HALO + (size_t)(g - 1) * 3 * 1024 + c0; const bf16* hk = hq + (size_t)512 * 3 * 1024;
        q3 = *(const unsigned*)hq; q2 = *(const unsigned*)(hq + 1024); q1 = *(const unsigned*)(hq + 2048);
        k3 = *(const unsigned*)hk; k2 = *(const unsigned*)(hk + 1024); k1 = *(const unsigned*)(hk + 2048); }
    bf16* qp = MQ + (size_t)g * 64 * 1024 + c0; bf16* kp = MK + (size_t)g * 64 * 1024 + c0;
#define PREP_PASS(ptr, w, h3, h2, h1, SCALE) do { unsigned r_[64]; \
        _Pragma("unroll") for (int t = 0; t < 64; ++t) r_[t] = *(const unsigned*)((ptr) + t * 1024); \
        unsigned p3 = h3, p2 = h2, p1 = h1; \
        _Pragma("unroll") for (int t = 0; t < 64; ++t) { const unsigned u = r_[t]; \
            const float a0 = w[0][0] * bflo(p3) + w[1][0] * bflo(p2) + w[2][0] * bflo(p1) + w[3][0] * bflo(u); \
            const float a1 = w[0][1] * bfhi(p3) + w[1][1] * bfhi(p2) + w[2][1] * bfhi(p1) + w[3][1] * bfhi(u); \
            *(unsigned*)((ptr) + t * 1024) = pk2(siluf(a0) * (SCALE), siluf(a1) * (SCALE)); \
            p3 = p2; p2 = p1; p1 = u; } } while (0)
    PREP_PASS(qp, wq, q3, q2, q1, 0.0625f);
    PREP_PASS(kp, wk, k3, k2, k1, 1.0f);
#undef PREP_PASS
    asm volatile("s_waitcnt vmcnt(0)" ::: "memory");
    __syncthreads();
    if (tid == 0) { __builtin_amdgcn_fence(__ATOMIC_RELEASE, "agent"); asm volatile("s_waitcnt vmcnt(0)" ::: "memory");
        __hip_atomic_fetch_add((unsigned*)(a->ws + WS_CTL) + CW_PREP, 1u, __ATOMIC_RELAXED, __HIP_MEMORY_SCOPE_AGENT); }
}
__device__ __forceinline__ void wait_all(KArgs a, int WV) {
    if (WV == 0 && lane_id() == 0) { unsigned* cnt = (unsigned*)(a->ws + WS_CTL) + CW_PREP; unsigned spins = 0u;
        while (__hip_atomic_load(cnt, __ATOMIC_RELAXED, __HIP_MEMORY_SCOPE_AGENT) < N_ITEMS) { __builtin_amdgcn_s_sleep(16); if (++spins > (1u << 22)) break; }
        __builtin_amdgcn_fence(__ATOMIC_ACQUIRE, "agent"); asm volatile("s_waitcnt vmcnt(0)" ::: "memory"); }
    __syncthreads();
}
}

namespace mls {
#ifdef MLS_KEEP_SB
#define MLS_SB __builtin_amdgcn_sched_barrier(0)
#else
#define MLS_SB do { } while (0)
#endif
constexpr int L_Q = 0;
constexpr int L_K = 32768;
constexpr int L_STAGE = 0;
constexpr int L_KW = 66560;
constexpr int L_V = L_KW + 32768;
constexpr int L_P = L_V + 32768;
constexpr int L_SC = L_P + 8192;
constexpr int L_N = L_SC + 18 * 256;
constexpr int L_CW = L_N + 1024;
constexpr int L_MW = L_CW + 8192;
constexpr int L_END = L_MW + 1024;
static_assert(L_END <= LDS_BYTES, "mLSTM LDS map");
constexpr int SROW = 260;

__device__ __forceinline__ void mlstm_unit(KArgs a, LAS unsigned char* lds, int WV, int b, int h) {
    int tid_ = TID_OF(WV); asm volatile("" : "+v"(tid_));
    const int tid = tid_, lane = tid & 63, r32 = lane & 31, hi = lane >> 5, wave = WV;
    prep::wait_all(a, WV);
    const bf16* MQ = (const bf16*)a->out; unsigned char* wsb = a->ws;
#define MK (MQ + (size_t)MTOK * 1024)
#define MV ((const bf16*)(wsb + WS_MV))
#define GM ((const bf16*)(wsb + WS_GM))
#define HM ((bf16*)(wsb + WS_HB))
#define LI ((const float*)(wsb + WS_LI))
#define LF ((const float*)(wsb + WS_LF))
    LAS float* S_psum = (LAS float*)(lds + L_SC) + 768; LAS float* S_qn = S_psum + 256;
    LAS float* nperm = (LAS float*)(lds + L_N); LAS float* stage = (LAS float*)(lds + L_STAGE);
    f32x16 X[8];
#pragma unroll
    for (int i = 0; i < 8; ++i)
#pragma unroll
        for (int r = 0; r < 16; ++r) X[i][r] = 0.f;
    if (tid < 256) nperm[tid] = 0.f;
    if (tid < 256) ((LAS float*)(lds + L_MW))[tid] = a->in[10][h * 256 + tid];
    float m_prev = 0.f;
    const int tg = WV >> 1;
#define MLS_LANE_IDS int tf_ = tid; asm volatile("" : "+v"(tf_));   \
    const int dp = tf_ & 127, d0 = 2 * dp; \
    const int ppos = (d0 & ~12) | ((d0 & 4) << 1) | ((d0 & 8) >> 1);     \
    const int qch = ppos >> 3, qbo = (ppos & 7) * 2;
#define MLS_LOAD_SET(Rq, Rk, Rv, cc, hs) do { const int t0_ = 32 * (hs) + 8 * tg; int tl_ = tid; asm volatile("" : "+v"(tl_)); const int d0 = 2 * (tl_ & 127);     \
        const size_t ub_ = ((size_t)b * SEQ + 64 * (cc) + t0_) * 1024 + h * 256; \
        const bf16* qb_ = MQ + ub_; const bf16* kb_ = MK + ub_; const bf16* vb_ = MV + ub_; \
        _Pragma("unroll") for (int i = 0; i < 8; ++i) { Rq[i] = *(const unsigned*)(qb_ + (i * 1024 + d0)); Rk[i] = *(const unsigned*)(kb_ + (i * 1024 + d0)); Rv[i] = *(const unsigned*)(vb_ + (i * 1024 + d0)); } } while (0)
#define MLS_FILL_SET(Rq, Rk, Rv, hs) do { const int t0_ = 32 * (hs) + 8 * tg; MLS_LANE_IDS \
        float kw0_[8], kw1_[8]; \
        _Pragma("unroll") for (int t = 0; t < 8; ++t) { const int row = t0_ + t; \
            const int ro_ = row * 512 + ((qch ^ (row & 15)) * 16) + qbo; \
            *(LAS unsigned*)(lds + L_Q + ro_) = Rq[t]; *(LAS unsigned*)(lds + L_K + ro_) = Rk[t]; \
            const float wsr = S_ws[row]; kw0_[t] = bflo(Rk[t]) * wsr; kw1_[t] = bfhi(Rk[t]) * wsr; } \
        const int cs_ = t0_ >> 3; \
        { const int d = d0; const int ro_ = d * 128 + ((cs_ ^ ((d >> 1) & 7)) * 16); \
          u32x4 w; w.x = pk2(kw0_[0], kw0_[1]); w.y = pk2(kw0_[2], kw0_[3]); w.z = pk2(kw0_[4], kw0_[5]); w.w = pk2(kw0_[6], kw0_[7]); *(LAS u32x4*)(lds + L_KW + ro_) = w; \
          u32x4 wv; wv.x = (Rv[0] & 0xffffu) | (Rv[1] << 16); wv.y = (Rv[2] & 0xffffu) | (Rv[3] << 16); wv.z = (Rv[4] & 0xffffu) | (Rv[5] << 16); wv.w = (Rv[6] & 0xffffu) | (Rv[7] << 16); *(LAS u32x4*)(lds + L_V + ro_) = wv; } \
        { const int d = d0 + 1; const int ro_ = d * 128 + ((cs_ ^ ((d >> 1) & 7)) * 16); \
          u32x4 w; w.x = pk2(kw1_[0], kw1_[1]); w.y = pk2(kw1_[2], kw1_[3]); w.z = pk2(kw1_[4], kw1_[5]); w.w = pk2(kw1_[6], kw1_[7]); *(LAS u32x4*)(lds + L_KW + ro_) = w; \
          u32x4 wv; wv.x = (Rv[0] >> 16) | (Rv[1] & 0xffff0000u); wv.y = (Rv[2] >> 16) | (Rv[3] & 0xffff0000u); wv.z = (Rv[4] >> 16) | (Rv[5] & 0xffff0000u); wv.w = (Rv[6] >> 16) | (Rv[7] & 0xffff0000u); *(LAS u32x4*)(lds + L_V + ro_) = wv; } \
    } while (0)
    unsigned SAq[8], SAk[8], SAv[8];
    MLS_LOAD_SET(SAq, SAk, SAv, 0, 0);
    float pf_lf = 0.f, pf_li = 0.f;
    if (wave == 0) { const size_t ub_ = (size_t)b * SEQ * 4 + h; pf_lf = (LF + ub_)[lane * 4]; pf_li = (LI + ub_)[lane * 4]; }
#ifdef STAMP_SEG
    unsigned long long seg_acc = 0ull, seg_t = __builtin_amdgcn_s_memrealtime();
#define SEGT(k) do { const unsigned long long n_ = __builtin_amdgcn_s_memrealtime(); if ((k) == STAMP_SEG) seg_acc += n_ - seg_t; seg_t = n_; } while (0)
#else
#define SEGT(k) do { } while (0)
#endif
    for (int c = 0; c < SEQ / MCH; ++c) {
        const size_t row0 = (size_t)b * SEQ + 64 * c;
        LAS float* S_alpha = (LAS float*)(lds + L_SC) + (c & 1) * 384; LAS float* S_beta = S_alpha + 64; LAS float* S_iw = S_alpha + 128; LAS float* S_clamp = S_alpha + 192; LAS float* S_ws = S_alpha + 256; LAS float* S_misc = S_alpha + 320;
        unsigned SBq[8], SBk[8], SBv[8];
        MLS_LOAD_SET(SBq, SBk, SBv, c, 1);
        if (wave == 0) {
            const float lf = pf_lf, li = pf_li;
            if (c + 1 < SEQ / MCH) { const size_t ub_ = (row0 + 64) * 4 + h; pf_lf = (LF + ub_)[lane * 4]; pf_li = (LI + ub_)[lane * 4]; }
#define MLS_DPP(old_, src_, ctrl_, rmask_) __uint_as_float((unsigned)__builtin_amdgcn_update_dpp((int)__float_as_uint(old_), (int)__float_as_uint(src_), ctrl_, rmask_, 0xf, false))
            float bt = lf;
            bt += MLS_DPP(0.f, bt, 0x111, 0xf); bt += MLS_DPP(0.f, bt, 0x112, 0xf); bt += MLS_DPP(0.f, bt, 0x114, 0xf); bt += MLS_DPP(0.f, bt, 0x118, 0xf);
            bt += MLS_DPP(0.f, bt, 0x142, 0xa); bt += MLS_DPP(0.f, bt, 0x143, 0xc);
            const float beta = li - bt; float cm = beta; const float ninf = -INFINITY;
            cm = fmaxf(cm, MLS_DPP(ninf, cm, 0x111, 0xf)); cm = fmaxf(cm, MLS_DPP(ninf, cm, 0x112, 0xf)); cm = fmaxf(cm, MLS_DPP(ninf, cm, 0x114, 0xf)); cm = fmaxf(cm, MLS_DPP(ninf, cm, 0x118, 0xf));
            cm = fmaxf(cm, MLS_DPP(ninf, cm, 0x142, 0xa)); cm = fmaxf(cm, MLS_DPP(ninf, cm, 0x143, 0xc));
#undef MLS_DPP
            const float mx = fmaxf(cm, m_prev);
            S_alpha[lane] = -mx; S_beta[lane] = beta; S_iw[lane] = __expf(m_prev - mx); S_clamp[lane] = __expf(-(bt + mx));
            const float cmL = __uint_as_float(__builtin_amdgcn_readlane(__float_as_uint(cm), 63)), bL = __uint_as_float(__builtin_amdgcn_readlane(__float_as_uint(bt), 63)); const float mxL = fmaxf(m_prev, cmL);
            S_ws[lane] = __expf(beta - mxL);
            if (lane == 0) S_misc[0] = __expf(m_prev - mxL);
            m_prev = bL + mxL;
        }
        __syncthreads();
        SEGT(0);
        MLS_FILL_SET(SAq, SAk, SAv, 0);
        __builtin_amdgcn_sched_barrier(0);
        MLS_FILL_SET(SBq, SBk, SBv, 1);
        __builtin_amdgcn_sched_barrier(0);
        __syncthreads();
        SEGT(1);
        f32x16 num[2];
        {
            int lo_ = lane; asm volatile("" : "+v"(lo_));
            const int l15 = lo_ & 15, kq = lo_ >> 4, r32a = lo_ & 31, hia = lo_ >> 5;
            const int si = wave >> 1, ti0 = 2 * (wave & 1);
            f32x4 sa[2] = {(f32x4){0.f, 0.f, 0.f, 0.f}, (f32x4){0.f, 0.f, 0.f, 0.f}};
            { const int y = kq ^ l15; const int rowoff = l15 * 512;
              int b4[4];
#pragma unroll
              for (int j = 0; j < 4; ++j) b4[j] = rowoff + (((4 * j) ^ y) * 16);
              const LAS unsigned char* kbase = lds + L_K + si * 8192; const LAS unsigned char* qbase = lds + L_Q + ti0 * 8192;
#pragma unroll
              for (int kk = 0; kk < 8; ++kk) { const int o_ = b4[kk & 3] + (kk >> 2) * 256;
                  const bf16x8 ka = ldfrag(kbase + o_);
                  const bf16x8 q0_ = ldfrag(qbase + o_), q1_ = ldfrag(qbase + 8192 + o_);
                  sa[0] = __builtin_amdgcn_mfma_f32_16x16x32_bf16(ka, q0_, sa[0], 0, 0, 0);
                  sa[1] = __builtin_amdgcn_mfma_f32_16x16x32_bf16(ka, q1_, sa[1], 0, 0, 0); } }
#pragma unroll
            for (int u = 0; u < 2; ++u) { const int ti = ti0 + u, t = 16 * ti + l15, s_ = 16 * si + 4 * kq;
                const float al = S_alpha[t]; const f32x4 bt4 = *(const LAS f32x4*)(S_beta + s_); float pv_[4]; float psum = 0.f;
#pragma unroll
                for (int r = 0; r < 4; ++r) { pv_[r] = (s_ + r <= t) ? sa[u][r] * __expf(al + bt4[r]) : 0.f; psum += pv_[r]; }
                psum = xadd<16>(psum); psum = xadd<32>(psum);
                if (kq == 0) S_psum[si * 64 + t] = psum;
                u32x2 w; w.x = pk2(pv_[0], pv_[1]); w.y = pk2(pv_[2], pv_[3]);
                const int cp = 2 * si + (kq >> 1);
                *(LAS u32x2*)(lds + L_P + t * 128 + ((cp ^ ((t >> 1) & 7)) * 16) + 8 * (kq & 1)) = w; }
#pragma unroll
            for (int r = 0; r < 16; ++r) { num[0][r] = 0.f; num[1][r] = 0.f; }
            { const int yq = hia ^ (r32a & 15); const int rowoff = r32a * 512;
              int b8[8];
#pragma unroll
              for (int g = 0; g < 8; ++g) b8[g] = rowoff + (((2 * g) ^ yq) * 16);
              const LAS unsigned char* qbase = lds + L_Q;
#pragma unroll
              for (int dt = 0; dt < 8; ++dt) { MLS_SB;
#pragma unroll
                  for (int sp = 0; sp < 2; ++sp) { const bf16x8 xb = pack8(X[dt], 8 * sp); const int G_ = 2 * dt + sp; const int o_ = b8[G_ & 7] + (G_ >> 3) * 256;
                      const bf16x8 qa0 = ldfrag(qbase + o_), qa1 = ldfrag(qbase + 16384 + o_);
                      num[0] = __builtin_amdgcn_mfma_f32_32x32x16_bf16(qa0, xb, num[0], 0, 0, 0);
                      num[1] = __builtin_amdgcn_mfma_f32_32x32x16_bf16(qa1, xb, num[1], 0, 0, 0); } } }
            __builtin_amdgcn_sched_barrier(0);
            { int to_ = tid; asm volatile("" : "+v"(to_));
              const int t = to_ >> 3, part = to_ & 7; float accn = 0.f;
#pragma unroll
              for (int i = 0; i < 4; ++i) { const int ch = 4 * part + i; const u32x4 qq = *(const LAS u32x4*)(lds + L_Q + t * 512 + ((ch ^ (t & 15)) * 16));
                  const f32x4 n0 = *(const LAS f32x4*)(nperm + 8 * ch), n1 = *(const LAS f32x4*)(nperm + 8 * ch + 4);
                  accn += bflo(qq.x) * n0[0] + bfhi(qq.x) * n0[1] + bflo(qq.y) * n0[2] + bfhi(qq.y) * n0[3] + bflo(qq.z) * n1[0] + bfhi(qq.z) * n1[1] + bflo(qq.w) * n1[2] + bfhi(qq.w) * n1[3]; }
              accn = xadd<1>(accn); accn = xadd<2>(accn); accn = xadd<4>(accn);
              if (part == 0) S_qn[t] = accn; }
        }
        __syncthreads();
        SEGT(2);
        u32x4 gz[4];
        {
            int lo_ = lane; asm volatile("" : "+v"(lo_));
            const int r32a = lo_ & 31, hia = lo_ >> 5;
            const int e = 32 * wave + r32a;
            const int yk = hia ^ ((r32a >> 1) & 7); const int rowoff = r32a * 128;
            int b4[4];
#pragma unroll
            for (int ks = 0; ks < 4; ++ks) b4[ks] = rowoff + (((2 * ks) ^ yk) * 16);
            bf16x8 vf[4];
#pragma unroll
            for (int ks = 0; ks < 4; ++ks) vf[ks] = ldfrag(lds + L_V + wave * 4096 + b4[ks]);
#pragma unroll
            for (int tt = 0; tt < 2; ++tt) {
#pragma unroll
                for (int g = 0; g < 4; ++g) { const f32x4 iw4 = *(const LAS f32x4*)(S_iw + 32 * tt + 8 * g + 4 * hia);
#pragma unroll
                    for (int q = 0; q < 4; ++q) num[tt][4 * g + q] *= iw4[q]; }
#pragma unroll
                for (int ks = 0; ks < 4; ++ks) { const bf16x8 pa = ldfrag(lds + L_P + tt * 4096 + b4[ks]);
                    num[tt] = __builtin_amdgcn_mfma_f32_32x32x16_bf16(pa, vf[ks], num[tt], 0, 0, 0); }
#pragma unroll
                for (int r = 0; r < 16; ++r) stage[(32 * tt + crow(r, hia)) * SROW + e] = num[tt][r];
            }
            if (c + 1 < SEQ / MCH) MLS_LOAD_SET(SAq, SAk, SAv, c + 1, 0);
#ifndef MLS_GATE_LATE
            { int to2_ = tid; asm volatile("" : "+v"(to2_)); const int t = to2_ >> 3, part = to2_ & 7;
              const u32x4* gp = (const u32x4*)(GM + row0 * 1024 + h * 256 + (t * 1024 + 32 * part));
#pragma unroll
              for (int i = 0; i < 4; ++i) gz[i] = gp[i]; }
#endif
            const float decay = S_misc[0];
#pragma unroll
            for (int dt = 0; dt < 8; ++dt) { MLS_SB;
#pragma unroll
                for (int r = 0; r < 16; ++r) X[dt][r] *= decay;
#pragma unroll
                for (int ks = 0; ks < 4; ++ks) { const bf16x8 ka = ldfrag(lds + L_KW + dt * 4096 + b4[ks]);
                    X[dt] = __builtin_amdgcn_mfma_f32_32x32x16_bf16(ka, vf[ks], X[dt], 0, 0, 0); } }
            __builtin_amdgcn_sched_barrier(0);
            int to_ = tid; asm volatile("" : "+v"(to_));
            if (to_ < 256) { const int d = to_; float s = 0.f;
#pragma unroll
                for (int i = 0; i < 8; ++i) { const u32x4 kk = *(const LAS u32x4*)(lds + L_KW + d * 128 + i * 16);
                    s += (bflo(kk.x) + bfhi(kk.x)) + (bflo(kk.y) + bfhi(kk.y)) + (bflo(kk.z) + bfhi(kk.z)) + (bflo(kk.w) + bfhi(kk.w)); }
                const int p = (d & ~12) | ((d & 4) << 1) | ((d & 8) >> 1);
                nperm[p] = decay * nperm[p] + s; }
        }
        __syncthreads();
        SEGT(3);
        { int te_ = tid; asm volatile("" : "+v"(te_)); const int t = te_ >> 3, part = te_ & 7;
          const float den = S_iw[t] * S_qn[t] + ((S_psum[t] + S_psum[64 + t]) + (S_psum[128 + t] + S_psum[192 + t]));
          const float hd = 1.0f / fmaxf(fabsf(den), S_clamp[t]);
          const LAS f32x4* sp = (const LAS f32x4*)(stage + t * SROW + 32 * part);
          f32x4 v[8]; float s1 = 0.f;
#pragma unroll
          for (int i = 0; i < 8; ++i) { v[i] = sp[i] * hd; s1 += (v[i][0] + v[i][1]) + (v[i][2] + v[i][3]); }
          s1 = xadd<1>(s1); s1 = xadd<2>(s1); s1 = xadd<4>(s1);
          const float mu = s1 * (1.f / 256.f); float s2 = 0.f;
#pragma unroll
          for (int i = 0; i < 8; ++i) { v[i] = v[i] - mu; s2 += (v[i][0] * v[i][0] + v[i][1] * v[i][1]) + (v[i][2] * v[i][2] + v[i][3] * v[i][3]); }
          s2 = xadd<1>(s2); s2 = xadd<2>(s2); s2 = xadd<4>(s2);
          const float rs = 1.0f / sqrtf(s2 * (1.f / 256.f) + EPS);
          const size_t ub = row0 * 1024 + h * 256; const int lo2 = t * 1024 + 32 * part;
#ifdef MLS_GATE_LATE
          { const u32x4* gp = (const u32x4*)(GM + ub + lo2);
#pragma unroll
            for (int i = 0; i < 4; ++i) gz[i] = gp[i]; }
#endif
          u32x4* op = (u32x4*)(HM + ub + lo2); const LAS f32x4* wp = (const LAS f32x4*)(lds + L_MW) + 8 * part;
#pragma unroll
          for (int i = 0; i < 4; ++i) { const u32x4 z = gz[i]; const f32x4 w0 = wp[2 * i], w1 = wp[2 * i + 1]; const f32x4 x0 = v[2 * i] * rs * w0, x1 = v[2 * i + 1] * rs * w1;
              u32x4 w; w.x = pk2(x0[0] * bflo(z.x), x0[1] * bfhi(z.x)); w.y = pk2(x0[2] * bflo(z.y), x0[3] * bfhi(z.y));
              w.z = pk2(x1[0] * bflo(z.z), x1[1] * bfhi(z.z)); w.w = pk2(x1[2] * bflo(z.w), x1[3] * bfhi(z.w)); op[i] = w; } }
        SEGT(4);
    }
    __syncthreads();
#ifdef STAMP_SEG
    *(volatile LAS unsigned long long*)(lds + LDS_BYTES - 32) = seg_acc;
#endif
#undef SEGT
#undef MK
#undef MV
#undef GM
#undef HM
#undef LI
#undef LF
#undef MLS_LOAD_SET
#undef MLS_FILL_SET
#undef MLS_LANE_IDS
}
}

__device__ __forceinline__ void phase3(KArgs a, LAS unsigned char* lds, int WV) {
    const int tid = TID_OF(WV), lane = tid & 63;
    float s1 = a->in[11][lane] * a->in[12][lane], s2 = a->in[13][lane] * a->in[14][lane];
    s1 = wave_sum(s1); s2 = wave_sum(s2);
    if (tid == 0) *(volatile LAS float*)(lds + LDS_BYTES - 48) = expf(s1) - expf(s2) + 0.2f;
    LAS unsigned* slot = (LAS unsigned*)(lds + LDS_BYTES - 64);
#if defined(STAMP_UNIT) || defined(STAMP_ITEM)
    unsigned long long unit_span = 0ull;
#endif
    constexpr unsigned N_M1 = BATCH * MH, N_A1 = BATCH * AH * (SEQ / 128);
    constexpr unsigned N_M = N_M1 * REP_ML, N_AD = N_A1 * (REP_AT - 1), N_A = N_AD + N_A1;
    constexpr unsigned N_P = prep::N_ITEMS;
    const bool t0q = (WV == 0 && lane_id() == 0);
    unsigned nx = 0u;
    if (t0q) nx = __hip_atomic_fetch_add((unsigned*)(a->ws + WS_CTL) + CW_QUEUE, 1u, __ATOMIC_RELAXED, __HIP_MEMORY_SCOPE_AGENT);
    for (;;) {
        if (t0q) *slot = nx;
        __syncthreads();
        unsigned it = *slot;
        __syncthreads();
        if (it >= N_P + N_M + N_A) break;
        if (t0q) nx = __hip_atomic_fetch_add((unsigned*)(a->ws + WS_CTL) + CW_QUEUE, 1u, __ATOMIC_RELAXED, __HIP_MEMORY_SCOPE_AGENT);
#ifdef STAMP_ITEM
        const unsigned it_abs = it; const unsigned long long ti0 = __builtin_amdgcn_s_memrealtime();
#define STAMP_ITEM_END() do { if (it_abs == STAMP_ITEM) unit_span = __builtin_amdgcn_s_memrealtime() - ti0; } while (0)
#else
#define STAMP_ITEM_END() do { } while (0)
#endif
        if (it < N_P) { prep::conv_item(a, WV, (int)it); STAMP_ITEM_END(); continue; }
        it -= N_P;
        if (it < N_M) { const unsigned u = it % N_M1;
#ifdef STAMP_UNIT
            const unsigned long long tu0 = __builtin_amdgcn_s_memrealtime();
#endif
            mls::mlstm_unit(a, lds, WV, (int)(u >> 2), (int)(u & 3));
#ifdef STAMP_UNIT
#ifdef STAMP_SEG
            if (it == STAMP_UNIT) unit_span = *(volatile LAS unsigned long long*)(lds + LDS_BYTES - 32);
#else
            if (it == STAMP_UNIT) unit_span = __builtin_amdgcn_s_memrealtime() - tu0;
#endif
#endif
        }
        else { const unsigned i0 = it - N_M; const bool dummy = i0 < N_AD; const unsigned i = i0 % N_A1; const int qb = 15 - (int)(i >> 7), bh = (int)(i & 127); att::attn_unit(a, lds, WV, bh >> 3, bh & 7, qb, dummy); }
        STAMP_ITEM_END();
    }
#if defined(STAMP_UNIT) || defined(STAMP_ITEM)
    if (unit_span) { const unsigned long long t_end = __builtin_amdgcn_s_memrealtime(); while (__builtin_amdgcn_s_memrealtime() - t_end < unit_span) __builtin_amdgcn_s_sleep(8); }
#endif
}
template <bool COOP>
__global__ void __launch_bounds__(NTHREADS, 2) fwd(Args args) {
    extern __shared__ __attribute__((aligned(16))) unsigned char lds_raw[];
    LAS unsigned char* lds = (LAS unsigned char*)lds_raw;
    const int G = gridDim.x, bx = blockIdx.x;
    const int WV = __builtin_amdgcn_readfirstlane((int)threadIdx.x >> 6);
    const int vcu = (G % 8 == 0) ? (bx % 8) * (G / 8) + bx / 8 : bx;
    const int lo = args.ph_lo, hi = args.ph_hi;
    volatile LAS unsigned* MISC = (volatile LAS unsigned*)(lds + LDS_BYTES - 128);
    if (WV == 0) { const int l_ = lane_id(); if (l_ < 32) MISC[l_] = 0u; }
    __syncthreads();
    XcdBarrier bar; bar.bar = nullptr; bar.x = 0; bar.st = nullptr;
    if constexpr (COOP) bar = xcd_barrier_post((unsigned*)(kargs()->ws + WS_CTL) + CW_BAR, MISC + 8, WV == 0 && lane_id() == 0);
#define IN(k) (lo <= (k) && (k) < hi)
#ifdef STAMP_PHASE
    unsigned long long st_t0 = 0ull, st_t1 = 0ull;
#define STAMP_BEGIN(k) do { if ((k) == STAMP_PHASE) st_t0 = __builtin_amdgcn_s_memrealtime(); } while (0)
#define STAMP_END(k) do { if ((k) == STAMP_PHASE) st_t1 = __builtin_amdgcn_s_memrealtime(); } while (0)
#else
#define STAMP_BEGIN(k) do { } while (0)
#define STAMP_END(k) do { } while (0)
#endif
#ifdef MK_CG_SEAM0
#define SEAM(k) do { if constexpr (COOP) { if (IN(k) && IN((k) + 1)) { if ((k) == 0) cg::this_grid().sync(); else xcd_barrier(bar, WV == 0 && lane_id() == 0); } } } while (0)
#else
#define SEAM(k) do { if constexpr (COOP) { if (IN(k) && IN((k) + 1)) xcd_barrier(bar, WV == 0 && lane_id() == 0); } } while (0)
#endif
    STAMP_BEGIN(0);
    if (IN(0)) for (int rep = 0; rep < REP_P0; ++rep) { phase0(kargs(), lds, vcu, G, WV); __syncthreads(); }
    SEAM(0);
    STAMP_END(0);
    STAMP_BEGIN(1);
    if (IN(1)) for (int rep = 0; rep < REP_P1; ++rep) { phase1(kargs(), lds, vcu, G, WV); __syncthreads(); }
    SEAM(1);
    STAMP_END(1);
    STAMP_BEGIN(2);
    if (IN(2)) {
#pragma unroll 1
        for (int rep = 0; rep < REP_P2; ++rep) {
        const KArgs ka = kargs(); unsigned char* ws_ = ka->ws; float* out_ = ka->out;
        pg8::Gemm g{(const bf16*)(ws_ + WS_HB), (const bf16*)(ws_ + WS_HB), (const bf16*)(ws_ + WS_WIN), MTOK, NPROJ, 1024, 1024, 16};
        pg8::StaticOrder S; S.init(MTOK, NPROJ, G, bx);
        EpiProj E{(bf16*)out_, (bf16*)out_ + (size_t)MTOK * 1024, (bf16*)(ws_ + WS_MV), (bf16*)(ws_ + WS_GM), (bf16*)(ws_ + WS_AQ), (bf16*)(ws_ + WS_AK), (bf16*)(ws_ + WS_AV), (bf16*)(ws_ + WS_AZ), (bf16*)(ws_ + WS_HALO)};
        pg8::gemm_phase<EpiProj, pg8::StaticOrder, true, true>(lds, g, S, E, WV);
        }
    }
    SEAM(2);
    STAMP_END(2);
    STAMP_BEGIN(3);
    if (IN(3)) phase3(kargs(), lds, WV);
    SEAM(3);
    STAMP_END(3);
    STAMP_BEGIN(4);
    if (IN(4)) {
#pragma unroll 1
        for (int rep = 0; rep < REP_P4; ++rep) {
        const KArgs ka = kargs(); unsigned char* ws_ = ka->ws; float* out_ = ka->out; const float* x_ = ka->in[0];
        pg8::Gemm g{(const bf16*)(ws_ + WS_HB), (const bf16*)(ws_ + WS_AQ), (const bf16*)(ws_ + WS_WOUT), MTOK, D, DMIX, 1024, 16};
        pg8::StaticOrder S; S.init(MTOK, D, G, bx);
        EpiOut E{x_, (const float*)(ws_ + WS_MOD), out_, (float*)(ws_ + WS_RSS)};
        pg8::gemm_phase<EpiOut, pg8::StaticOrder, true, true>(lds, g, S, E, WV);
        }
    }
    SEAM(4);
    STAMP_END(4);
    STAMP_BEGIN(5);
    if (IN(5)) phase5(kargs(), vcu, G, WV);
#if REP_P5 > 1
    if (IN(5)) { __syncthreads(); phase5_touch(kargs(), vcu, G, WV); }
#endif
    STAMP_END(5);
#ifdef STAMP_PHASE
    if (blockIdx.x == 0 && WV == 0 && lane_id() == 0) { const unsigned long long t_end = __builtin_amdgcn_s_memrealtime(); while (__builtin_amdgcn_s_memrealtime() - t_end < (st_t1 - st_t0)) __builtin_amdgcn_s_sleep(8); }
#endif
#undef IN
#undef SEAM
}

#ifndef MK_MULTI
#define MK_MULTI 0
#endif
extern "C" void kernel_launch(void* const* d_in, const int* in_sizes, int n_in, void* d_out, int out_size, void* d_ws, size_t ws_size, hipStream_t stream) {
    static int grid = 0;
    if (grid == 0) {
        if (n_in != 19 || out_size != MTOK * D || ws_size < WS_END) { fprintf(stderr, "kernel_launch: unexpected shapes (n_in %d, out %d, ws %zu)\n", n_in, out_size, ws_size); grid = -1; return; }
        int dev = 0, cus = 0, per_cu = 0;
        (void)hipGetDevice(&dev); (void)hipDeviceGetAttribute(&cus, hipDeviceAttributeMultiprocessorCount, dev);
        (void)hipFuncSetAttribute((const void*)fwd<!MK_MULTI>, hipFuncAttributeMaxDynamicSharedMemorySize, LDS_BYTES);
        (void)hipOccupancyMaxActiveBlocksPerMultiprocessor(&per_cu, (const void*)fwd<!MK_MULTI>, NTHREADS, LDS_BYTES);
        if (per_cu < 1) { fprintf(stderr, "kernel_launch: occupancy query says %d blocks per CU\n", per_cu); per_cu = 1; }
        (void)hipGetLastError();
        grid = cus * (per_cu > 1 ? 1 : per_cu);
    }
    if (grid < 0) return;
    (void)hipMemsetAsync((char*)d_ws + WS_CTL, 0, 1 * MiB, stream);
    Args a{};
    for (int i = 0; i < 19; ++i) a.in[i] = (const float*)d_in[i];
    a.out = (float*)d_out; a.ws = (unsigned char*)d_ws;
#if MK_MULTI
    for (int ph = 0; ph < 6; ++ph) { a.ph_lo = ph; a.ph_hi = ph + 1; hipLaunchKernelGGL(fwd<false>, dim3(grid), dim3(NTHREADS), LDS_BYTES, stream, a); }
#else
    a.ph_lo = 0; a.ph_hi = 6;
    void* kargs[] = {&a};
    hipError_t e = hipLaunchCooperativeKernel((const void*)fwd<true>, dim3(grid), dim3(NTHREADS), kargs, LDS_BYTES, stream);
    if (e != hipSuccess) fprintf(stderr, "cooperative launch failed: %s (grid %d)\n", hipGetErrorString(e), grid);
#endif
}
```

```cpp
#include <hip/hip_runtime.h>
#include <hip/hip_cooperative_groups.h>
#include <cstdio>
#include <cstdint>
#include <cmath>
namespace cg = cooperative_groups;
namespace pg8 {
#define PG8_LAS __attribute__((address_space(3)))
typedef unsigned short bf16_t;
typedef short bf16x8 __attribute__((ext_vector_type(8)));
typedef float f32x4 __attribute__((ext_vector_type(4)));
typedef unsigned u32x4 __attribute__((ext_vector_type(4)));
constexpr int BM = 256, BK = 64, HALF = 128, HTB = HALF * BK * 2  , STAGE_BYTES = 8 * HTB, NXCD = 8, WGM = 8;

__host__ __device__ __forceinline__ int lds_byte(int r, int c) { const int st = (r >> 4) * 2 + (c >> 5), rr = r & 15, cc = c & 31, ob = rr * 64 + cc * 2; return st * 1024 + (ob ^ (((ob >> 9) & 1) << 5)); }
__host__ __device__ __forceinline__ void stage_rc(int b, int& R, int& C) { const int st = b / 1024, sb = b % 1024, swz = sb ^ (((sb >> 9) & 1) << 5); R = (st >> 1) * 16 + swz / 64; C = (st & 1) * 32 + (swz % 64) / 2; }
__host__ __device__ __forceinline__ int perm32(int rho) { const int n = rho >> 4, i = rho & 15; return 8 * (i >> 2) + 4 * n + (i & 3); }

struct Unit { int pm, pn; };
struct Gemm { const bf16_t* A; const bf16_t* A2; const bf16_t* Bt; int M, N, K, lda, nt1; };

struct StaticOrder {
    int nM, nN, nwg, G, c;
    __host__ __device__ void init(int M, int N, int G_, int c_) { nM = M / BM; nN = N / BM; nwg = nM * nN; G = G_; c = c_; }
    __host__ __device__ bool next(int i, Unit& u) const {
        const long L = (long)i * G + c; if (L >= nwg) return false;
        int wgid = (int)L; { const int q = nwg / NXCD, r = nwg % NXCD, xcd = wgid % NXCD, off = wgid / NXCD; wgid = (xcd < r ? xcd * (q + 1) : r * (q + 1) + (xcd - r) * q) + off; }
        const int nig = WGM * nN, gid = wgid / nig, fm = gid * WGM, gsz = (nM - fm) < WGM ? (nM - fm) : WGM;
        u.pm = fm + ((wgid % nig) % gsz); u.pn = (wgid % nig) / gsz; return true;
    }
    __device__ __forceinline__ void a_ready(const Unit&) const {}
    __device__ __forceinline__ void done(const Unit&) const {}
};

__device__ __forceinline__ unsigned cvt_pk_bf16(float lo, float hi) { unsigned r; asm volatile("v_cvt_pk_bf16_f32 %0, %1, %2" : "=v"(r) : "v"(lo), "v"(hi)); return r; }
template <class Epi, class Sched, bool ALIGN_EPI = false, bool SP2 = false>
__device__ __forceinline__ void gemm_phase(PG8_LAS unsigned char* lds, const Gemm g, const Sched& S, const Epi& E, const int wid) {
    const int lane = (int)__builtin_amdgcn_mbcnt_hi(~0u, __builtin_amdgcn_mbcnt_lo(~0u, 0u)), tid = wid * 64 + lane, wr = wid >> 2, wc = wid & 3, fr = lane & 15, fq = lane >> 4;
    const int K = g.K, nt = K / BK;
    unsigned voffA[2], voffB[2];
#pragma unroll
    for (int i = 0; i < 2; ++i) { int R, C; stage_rc(tid * 16 + i * 8192, R, C); const int Rb = Epi::PERM ? ((R & ~31) + perm32(R & 31)) : R;
        voffA[i] = (unsigned)(R * g.lda + C) * 2u; voffB[i] = (unsigned)(Rb * K + C) * 2u; }
    const size_t kstep = (size_t)(BK * 2);
    const size_t hstep = (size_t)HALF * K * 2;
    const size_t tstep = 2 * hstep;
    const size_t hstepA = (size_t)HALF * g.lda * 2, tstepA = 2 * hstepA; const int nt1 = g.nt1;
#define PG8_AP(b1, b2, t) ((t) < nt1 ? (b1) + (size_t)(t) * kstep : (b2) + (size_t)((t) - nt1) * kstep)
    const unsigned ldsw = (unsigned)wid * 1024u;
    const int aoff = lds_byte(wr * 64 + fr, fq * 8), boff = lds_byte(wc * 32 + fr, fq * 8);
#define PG8_SA(b, h) (((b) * 2 + (h)) * HTB)
#define PG8_SB(b, h) ((4 + (b) * 2 + (h)) * HTB)
#define PG8_STAGE(bufoff, gbase, voff) do { _Pragma("unroll") for (int _i = 0; _i < 2; ++_i) \
        __builtin_amdgcn_global_load_lds((const unsigned*)((const char*)(gbase) + (voff)[_i]), (PG8_LAS unsigned*)(lds + (bufoff) + ldsw + _i * 8192), 16, 0, 0); } while (0)
#define PG8_LDA(dst, b, h) do { _Pragma("unroll") for (int m = 0; m < 4; ++m) _Pragma("unroll") for (int k = 0; k < 2; ++k) dst[m][k] = *(const PG8_LAS bf16x8*)(lds + PG8_SA(b, h) + aoff + m * 2048 + k * 1024); } while (0)
#define PG8_LDB(dst, b, h) do { _Pragma("unroll") for (int n = 0; n < 2; ++n) _Pragma("unroll") for (int k = 0; k < 2; ++k) dst[n][k] = *(const PG8_LAS bf16x8*)(lds + PG8_SB(b, h) + boff + n * 2048 + k * 1024); } while (0)
#define PG8_MMA(ai, bj, At, Bt) do { __builtin_amdgcn_s_setprio(1); _Pragma("unroll") for (int m = 0; m < 4; ++m) _Pragma("unroll") for (int n = 0; n < 2; ++n) _Pragma("unroll") for (int k = 0; k < 2; ++k) \
        acc[ai][bj][m][n] = __builtin_amdgcn_mfma_f32_16x16x32_bf16(Bt[n][k], At[m][k], acc[ai][bj][m][n], 0, 0, 0); __builtin_amdgcn_s_setprio(0); } while (0)
#define PG8_WAIT_V(n) asm volatile("s_waitcnt vmcnt(" #n ")" ::: "memory")
#define PG8_WAIT_L(n) asm volatile("s_waitcnt lgkmcnt(" #n ")" ::: "memory")
#define PG8_BAR __builtin_amdgcn_s_barrier()
#define PG8_SCHED __builtin_amdgcn_sched_barrier(0)
    Unit cur, nxt; int ui = 0;
    if (!S.next(0, cur)) return;
    f32x4 acc[2][2][4][2];
#pragma unroll
    for (int a = 0; a < 2; ++a)
#pragma unroll
        for (int b = 0; b < 2; ++b)
#pragma unroll
            for (int m = 0; m < 4; ++m)
#pragma unroll
                for (int n = 0; n < 2; ++n) acc[a][b][m][n] = (f32x4){0.f, 0.f, 0.f, 0.f};
    bf16x8 At[4][2], B0[2][2], B1[2][2];
    const char* cA = (const char*)g.A + (size_t)cur.pm * tstepA; const char* cA2 = (const char*)g.A2 + (size_t)cur.pm * tstepA; const char* cB = (const char*)g.Bt + (size_t)cur.pn * tstep;
    S.a_ready(cur);
    if constexpr (SP2) {
        PG8_STAGE(PG8_SB(0, 0), cB, voffB); PG8_STAGE(PG8_SB(0, 1), cB + hstep, voffB); PG8_STAGE(PG8_SA(0, 0), cA, voffA); PG8_STAGE(PG8_SA(0, 1), cA + hstepA, voffA);
        if (wr == 1) PG8_BAR;
        PG8_WAIT_V(2); PG8_BAR;
        PG8_STAGE(PG8_SB(1, 0), cB + kstep, voffB); PG8_STAGE(PG8_SA(1, 0), cA + kstep, voffA); PG8_STAGE(PG8_SB(1, 1), cB + hstep + kstep, voffB);
        PG8_WAIT_V(6); PG8_BAR;
    } else {
        PG8_STAGE(PG8_SB(0, 0), cB, voffB); PG8_STAGE(PG8_SA(0, 0), cA, voffA); PG8_STAGE(PG8_SB(0, 1), cB + hstep, voffB); PG8_STAGE(PG8_SA(0, 1), cA + hstepA, voffA);
        if (wr == 1) PG8_BAR;
        PG8_WAIT_V(4); PG8_BAR;
        PG8_STAGE(PG8_SB(1, 0), cB + kstep, voffB); PG8_STAGE(PG8_SA(1, 0), cA + kstep, voffA); PG8_STAGE(PG8_SB(1, 1), cB + hstep + kstep, voffB);
        PG8_WAIT_V(6); PG8_BAR;
    }
    for (;;) {
        const bool has_next = S.next(ui + 1, nxt);
        const char* nA = has_next ? (const char*)g.A + (size_t)nxt.pm * tstepA : cA; const char* nA2 = has_next ? (const char*)g.A2 + (size_t)nxt.pm * tstepA : cA2; const char* nB = has_next ? (const char*)g.Bt + (size_t)nxt.pn * tstep : cB;
        for (int t = 0; t < nt; t += 2) {
            const bool last = (t == nt - 2);
            const char* a1 = PG8_AP(cA, cA2, t + 1);
            const char* a2 = last ? nA : PG8_AP(cA, cA2, t + 2); const char* b2 = last ? nB : cB + (size_t)(t + 2) * kstep;
            const char* a3 = last ? nA + kstep : PG8_AP(cA, cA2, t + 3); const char* b3 = b2 + kstep;
            if (last && has_next) S.a_ready(nxt);
            if constexpr (SP2) {
            PG8_LDB(B0, 0, 0); PG8_LDB(B1, 0, 1); PG8_SCHED; PG8_LDA(At, 0, 0); PG8_STAGE(PG8_SA(1, 1), a1 + hstepA, voffA);
            PG8_WAIT_V(8); PG8_WAIT_L(0); PG8_BAR; PG8_MMA(0, 0, At, B0); PG8_MMA(0, 1, At, B1); PG8_BAR; PG8_SCHED;
            PG8_LDA(At, 0, 1); PG8_STAGE(PG8_SB(0, 0), b2, voffB); PG8_STAGE(PG8_SB(0, 1), b2 + hstep, voffB); PG8_STAGE(PG8_SA(0, 0), a2, voffA);
            PG8_WAIT_V(8); PG8_WAIT_L(0); PG8_BAR; PG8_MMA(1, 0, At, B0); PG8_MMA(1, 1, At, B1); PG8_BAR; PG8_SCHED;
            PG8_LDB(B0, 1, 0); PG8_LDB(B1, 1, 1); PG8_SCHED; PG8_LDA(At, 1, 0); PG8_STAGE(PG8_SA(0, 1), a2 + hstepA, voffA);
            PG8_WAIT_V(8); PG8_WAIT_L(0); PG8_BAR; PG8_MMA(0, 0, At, B0); PG8_MMA(0, 1, At, B1); PG8_BAR; PG8_SCHED;
            PG8_LDA(At, 1, 1); PG8_STAGE(PG8_SB(1, 0), b3, voffB); PG8_STAGE(PG8_SB(1, 1), b3 + hstep, voffB); PG8_STAGE(PG8_SA(1, 0), a3, voffA);
            PG8_WAIT_V(8); PG8_WAIT_L(0); PG8_BAR; PG8_MMA(1, 0, At, B0); PG8_MMA(1, 1, At, B1); PG8_BAR; PG8_SCHED;
            } else {
            PG8_LDB(B0, 0, 0); PG8_SCHED; PG8_LDA(At, 0, 0); PG8_STAGE(PG8_SA(1, 1), a1 + hstepA, voffA);
            PG8_WAIT_L(8); PG8_BAR; PG8_WAIT_L(0); PG8_MMA(0, 0, At, B0); PG8_BAR; PG8_SCHED;
            PG8_LDB(B1, 0, 1); PG8_STAGE(PG8_SB(0, 0), b2, voffB);
            PG8_BAR; PG8_WAIT_L(0); PG8_MMA(0, 1, At, B1); PG8_BAR;
            PG8_LDA(At, 0, 1); PG8_STAGE(PG8_SA(0, 0), a2, voffA);
            PG8_BAR; PG8_WAIT_L(0); PG8_MMA(1, 0, At, B0); PG8_BAR; PG8_SCHED;
            PG8_STAGE(PG8_SB(0, 1), b2 + hstep, voffB);
            PG8_WAIT_V(6); PG8_BAR; PG8_MMA(1, 1, At, B1); PG8_BAR;
            PG8_LDB(B0, 1, 0); PG8_SCHED; PG8_LDA(At, 1, 0); PG8_STAGE(PG8_SA(0, 1), a2 + hstepA, voffA);
            PG8_WAIT_L(8); PG8_BAR; PG8_WAIT_L(0); PG8_MMA(0, 0, At, B0); PG8_BAR; PG8_SCHED;
            PG8_LDB(B1, 1, 1); PG8_STAGE(PG8_SB(1, 0), b3, voffB);
            PG8_BAR; PG8_WAIT_L(0); PG8_MMA(0, 1, At, B1); PG8_BAR;
            PG8_LDA(At, 1, 1); PG8_STAGE(PG8_SA(1, 0), a3, voffA);
            PG8_BAR; PG8_WAIT_L(0); PG8_MMA(1, 0, At, B0); PG8_BAR; PG8_SCHED;
            PG8_STAGE(PG8_SB(1, 1), b3 + hstep, voffB);
            PG8_WAIT_V(6); PG8_BAR; PG8_MMA(1, 1, At, B1); PG8_BAR;
            }
        }
        if constexpr (ALIGN_EPI) { if (wr == 0) PG8_BAR; }
        if constexpr (!Epi::AFTER_DRAIN) { E(acc, cur, wr, wc, fr, fq); S.done(cur); }
        if (!has_next) break;
#pragma unroll
        for (int a = 0; a < 2; ++a)
#pragma unroll
            for (int b = 0; b < 2; ++b)
#pragma unroll
                for (int m = 0; m < 4; ++m)
#pragma unroll
                    for (int n = 0; n < 2; ++n) acc[a][b][m][n] = (f32x4){0.f, 0.f, 0.f, 0.f};
        cur = nxt; cA = nA; cA2 = nA2; cB = nB; ++ui;
        if constexpr (ALIGN_EPI) { if (wr == 1) PG8_BAR; }
    }
    PG8_WAIT_V(0);
    if constexpr (!ALIGN_EPI) { if (wr == 0) PG8_BAR; }
    PG8_BAR;
    if constexpr (Epi::AFTER_DRAIN) { E.fused(acc, cur, wr, wc, fr, fq, lds, wid, lane); S.done(cur); }
#undef PG8_AP
#undef PG8_SA
#undef PG8_SB
#undef PG8_STAGE
#undef PG8_LDA
#undef PG8_LDB
#undef PG8_MMA
#undef PG8_WAIT_V
#undef PG8_WAIT_L
#undef PG8_BAR
#undef PG8_SCHED
}
}
#ifndef REP_P0
#define REP_P0 1
#endif
#ifndef REP_P5
#define REP_P5 1
#endif
#ifndef REP_P1
#define REP_P1 1
#endif
#ifndef REP_P2
#define REP_P2 1
#endif
#ifndef REP_ML
#define REP_ML 1
#endif
#ifndef REP_AT
#define REP_AT 1
#endif
#ifndef REP_P4
#define REP_P4 1
#endif
constexpr int NWAVES = 8, NTHREADS = 512;
constexpr int D = 1024, BATCH = 16, SEQ = 2048, MTOK = BATCH * SEQ, DIN = 9224, NPROJ = 9216, DMIX = 2048;
constexpr int MH = 4, MHD = 256, AH = 8, AVD = 128, AQK = 64, MCH = 64;
constexpr int C_MQ = 0, C_MK = 1024, C_MV = 2048, C_MO = 3072, C_MZ = 4096, C_MI = 5120, C_MF = 5124, C_AQ = 5128, C_AK = 6152, C_AV = 7176, C_AZ = 8200;
constexpr float EPS = 1e-6f, LOG2E = 1.4426950408889634f;
constexpr float QSCALE = 0.125f * LOG2E;
constexpr size_t MiB = 1u << 20;
constexpr size_t WS_CTL = 0;
constexpr size_t WS_MOD = 1 * MiB;
constexpr size_t WS_LI = 2 * MiB;
constexpr size_t WS_LF = 2 * MiB + 512 * 1024;
constexpr size_t WS_RSS = 4 * MiB;
constexpr size_t WS_WIN = 8 * MiB;
constexpr size_t WS_WOUT = 26 * MiB;
constexpr size_t WS_HB = 32 * MiB;
constexpr size_t WS_MV = 96 * MiB;
constexpr size_t WS_GM = 160 * MiB;
constexpr size_t WS_AQ = 224 * MiB;
constexpr size_t WS_AK = 288 * MiB;
constexpr size_t WS_AV = 352 * MiB;
constexpr size_t WS_AZ = 416 * MiB;
constexpr size_t WS_END = 480 * MiB;
constexpr size_t WS_HALO = 480 * MiB;
constexpr size_t WS_DUMMY = 496 * MiB;
constexpr int CW_QUEUE = 64;
constexpr int CW_PREP = 128;
constexpr int LDS_BYTES = 155648;

#define LAS __attribute__((address_space(3)))
typedef unsigned short bf16;
typedef float f32x4 __attribute__((ext_vector_type(4)));
typedef float f32x16 __attribute__((ext_vector_type(16)));
typedef float f32x2 __attribute__((ext_vector_type(2)));
typedef short bf16x8 __attribute__((ext_vector_type(8)));
typedef short s16x4 __attribute__((ext_vector_type(4)));
typedef unsigned u32x4 __attribute__((ext_vector_type(4)));
typedef unsigned u32x2 __attribute__((ext_vector_type(2)));
typedef __bf16 bf16x2_t __attribute__((ext_vector_type(2)));

__device__ __forceinline__ unsigned pk2(float lo, float hi) { f32x2 v = {lo, hi}; bf16x2_t b = __builtin_convertvector(v, bf16x2_t); return __builtin_bit_cast(unsigned, b); }
__device__ __forceinline__ float bflo(unsigned u) { return __uint_as_float(u << 16); }
__device__ __forceinline__ float bfhi(unsigned u) { return __uint_as_float(u & 0xffff0000u); }
__device__ __forceinline__ float siluf(float x) { return x * __builtin_amdgcn_rcpf(1.f + __expf(-x)); }
__device__ __forceinline__ float sigmf(float x) { return __builtin_amdgcn_rcpf(1.f + __expf(-x)); }
__device__ __forceinline__ int lane_id() { int l; asm volatile("v_mbcnt_lo_u32_b32 %0, -1, 0\n\tv_mbcnt_hi_u32_b32 %0, -1, %0" : "=v"(l)); return l; }
#define TID_OF(wv) ((wv) * 64 + lane_id())
template <int M> __device__ __forceinline__ float xadd(float v) {
    if constexpr (M == 32) { auto rr = __builtin_amdgcn_permlane32_swap(__float_as_uint(v), __float_as_uint(v), false, false); return __uint_as_float(rr[0]) + __uint_as_float(rr[1]); }
    else return v + __uint_as_float((unsigned)__builtin_amdgcn_ds_swizzle((int)__float_as_uint(v), (M << 10) | 0x1f));
}
template <int M> __device__ __forceinline__ float xswz(float v) {
    return __uint_as_float((unsigned)__builtin_amdgcn_ds_swizzle((int)__float_as_uint(v), (M << 10) | 0x1f));
}
__device__ __forceinline__ float wave_sum(float v) { v = xadd<1>(v); v = xadd<2>(v); v = xadd<4>(v); v = xadd<8>(v); v = xadd<16>(v); v = xadd<32>(v); return v; }

struct Args { const float* in[19]; float* out; unsigned char* ws; int ph_lo, ph_hi; };
typedef const __attribute__((address_space(4))) Args* KArgs;
__device__ __forceinline__ KArgs kargs() { KArgs p = (KArgs)__builtin_amdgcn_kernarg_segment_ptr(); asm volatile("" : "+s"(p)); return p; }

__device__ __forceinline__ int win_src_col(int n) {
    if (n < 3072) return n;
    if (n < 5120) { const int g = (n - 3072) >> 8, r = (n - 3072) & 255; return (r < 128) ? C_MO + 128 * g + r : C_MZ + 128 * g + (r - 128); }
    return n + 8;
}
__device__ __forceinline__ void p0_transpose_item(const float* W, int ldw, int K, bf16* WT, int k0, int n0, int sc0, LAS float* scr, int lane) {
#pragma unroll
    for (int i = 0; i < 32; ++i) { const int kk = 2 * i + (lane >> 5); scr[kk * 33 + (lane & 31)] = W[(size_t)(k0 + kk) * ldw + sc0 + (lane & 31)]; }
    asm volatile("s_waitcnt lgkmcnt(0)" ::: "memory");
    const int c = lane & 7;
#pragma unroll
    for (int j = 0; j < 4; ++j) { const int n = (lane >> 3) + 8 * j; const LAS float* s = scr + (8 * c) * 33 + n;
        u32x4 o; o.x = pk2(s[0 * 33], s[1 * 33]); o.y = pk2(s[2 * 33], s[3 * 33]); o.z = pk2(s[4 * 33], s[5 * 33]); o.w = pk2(s[6 * 33], s[7 * 33]);
        *(u32x4*)(WT + (size_t)(n0 + n) * K + k0 + 8 * c) = o; }
    asm volatile("s_waitcnt lgkmcnt(0)" ::: "memory");
}
__device__ __forceinline__ void phase0(KArgs a, LAS unsigned char* lds, int vcu, int G, int WV) {
    const int tid = TID_OF(WV), lane = tid & 63, wave = WV;
    const float* c = a->in[1]; const float* w_ada = a->in[3]; const float* b_ada = a->in[4];
    float* mod = (float*)(a->ws + WS_MOD);
    if (blockIdx.x == 0 && tid == 0) ((unsigned*)(a->ws + WS_CTL))[CW_QUEUE] = 0u;
    for (int cgp = vcu; cgp < 256; cgp += G) {
        const int b = tid >> 5, part = tid & 31, j0 = 12 * cgp;
        float acc[12];
#pragma unroll
        for (int j = 0; j < 12; ++j) acc[j] = 0.f;
#pragma unroll 8
        for (int ii = 0; ii < 32; ++ii) { const int i = part + 32 * ii;
            const float s = c[b * 1024 + i]; const float sv = s / (1.f + expf(-s));
            const f32x4* wr = (const f32x4*)(w_ada + (size_t)i * 3072 + j0);
            const f32x4 w0 = wr[0], w1 = wr[1], w2 = wr[2];
            acc[0] += sv * w0[0]; acc[1] += sv * w0[1]; acc[2] += sv * w0[2]; acc[3] += sv * w0[3];
            acc[4] += sv * w1[0]; acc[5] += sv * w1[1]; acc[6] += sv * w1[2]; acc[7] += sv * w1[3];
            acc[8] += sv * w2[0]; acc[9] += sv * w2[1]; acc[10] += sv * w2[2]; acc[11] += sv * w2[3]; }
#pragma unroll
        for (int j = 0; j < 12; ++j) { float v = acc[j];
            v = xadd<1>(v); v = xadd<2>(v); v = xadd<4>(v); v = xadd<8>(v); v = xadd<16>(v);
            if (part == 0) mod[b * 3072 + j0 + j] = v + b_ada[j0 + j]; }
    }
}

__device__ __forceinline__ void weight_copies(KArgs a, LAS float* scr, int vcu, int G, int wave, int lane) {
    const int gw = vcu * NWAVES + wave, NGW = G * NWAVES;
    constexpr int I_IN = (1024 / 64) * (NPROJ / 32), I_OUT = (2048 / 64) * (1024 / 32);
    bf16* WinT = (bf16*)(a->ws + WS_WIN); bf16* WoutT = (bf16*)(a->ws + WS_WOUT);
    for (int it = gw; it < I_IN + I_OUT; it += NGW) {
        if (it < I_IN) { const int nb = it % (NPROJ / 32), kb = it / (NPROJ / 32); p0_transpose_item(a->in[5], DIN, 1024, WinT, 64 * kb, 32 * nb, win_src_col(32 * nb), scr, lane); }
        else { const int r = it - I_IN, nb = r % 32, kb = r / 32; p0_transpose_item(a->in[17], 1024, 2048, WoutT, 64 * kb, 32 * nb, 32 * nb, scr, lane); }
    }
}

__device__ __forceinline__ void phase1(KArgs a, LAS unsigned char* lds, int vcu, int G, int WV) {
    const int tid = TID_OF(WV), lane = tid & 63, wave = WV;
    const float* x = a->in[0]; const float* norm_w = a->in[2]; const float* w_in = a->in[5]; const float* b_i = a->in[6]; const float* b_f = a->in[7];
    const float* mod = (const float*)(a->ws + WS_MOD);
    bf16* HB = (bf16*)(a->ws + WS_HB); float* LI = (float*)(a->ws + WS_LI); float* LF = (float*)(a->ws + WS_LF);
    LAS float* wg = (LAS float*)lds;
#pragma unroll
    for (int i = tid; i < 1024 * 8; i += NTHREADS) { const int k = i >> 3, q = i & 7;
        wg[(((((k >> 8) * 4 + (k & 3)) * 2 + (q >> 2)) * 64 + ((k & 255) >> 2)) * 4) + (q & 3)] = w_in[(size_t)k * DIN + C_MI + q]; }
    weight_copies(a, (LAS float*)(lds + 32768 + wave * 8448), vcu, G, wave, lane);
    __syncthreads();
    const int gw = vcu * NWAVES + wave, NGW = G * NWAVES;
    for (int grp = gw; grp < MTOK / 16; grp += NGW) {
        const int row0 = grp * 16, b = row0 / SEQ;
        f32x4 am[4], sh[4];
#pragma unroll
        for (int j = 0; j < 4; ++j) { const int col = 4 * lane + 256 * j;
            const f32x4 nw = *(const f32x4*)(norm_w + col), sc = *(const f32x4*)(mod + b * 3072 + 1024 + col);
            am[j] = nw * (sc + 1.0f); sh[j] = *(const f32x4*)(mod + b * 3072 + col); }
        f32x4 vn[4];
        { const f32x4* xr = (const f32x4*)(x + (size_t)row0 * D) + lane;
#pragma unroll
          for (int j = 0; j < 4; ++j) vn[j] = xr[64 * j]; }
        for (int r = 0; r < 16; ++r) { const int row = row0 + r;
            LAS float* wgr = wg; asm volatile("" : "+v"(wgr));
            f32x4 v[4]; float s = 0.f;
#pragma unroll
            for (int j = 0; j < 4; ++j) { v[j] = vn[j]; s += (v[j][0] * v[j][0] + v[j][1] * v[j][1]) + (v[j][2] * v[j][2] + v[j][3] * v[j][3]); }
            if (r < 15) { const f32x4* xr = (const f32x4*)(x + (size_t)(row + 1) * D) + lane;
#pragma unroll
                for (int j = 0; j < 4; ++j) vn[j] = xr[64 * j]; }
            const float rstd = 1.0f / sqrtf(wave_sum(s) * (1.f / D) + EPS);
            float g8[8];
#pragma unroll
            for (int q = 0; q < 8; ++q) g8[q] = 0.f;
            u32x2* o8 = (u32x2*)(HB + (size_t)row * D) + lane;
#pragma unroll
            for (int j = 0; j < 4; ++j) { const f32x4 hv = v[j] * rstd * am[j] + sh[j];
                u32x2 w; w.x = pk2(hv[0], hv[1]); w.y = pk2(hv[2], hv[3]); o8[64 * j] = w;
#pragma unroll
                for (int e = 0; e < 4; ++e) {
                    const f32x4 w0 = *(const LAS f32x4*)(wgr + ((((j * 4 + e) * 2 + 0) * 64 + lane) * 4)), w1 = *(const LAS f32x4*)(wgr + ((((j * 4 + e) * 2 + 1) * 64 + lane) * 4));
                    g8[0] += hv[e] * w0[0]; g8[1] += hv[e] * w0[1]; g8[2] += hv[e] * w0[2]; g8[3] += hv[e] * w0[3];
                    g8[4] += hv[e] * w1[0]; g8[5] += hv[e] * w1[1]; g8[6] += hv[e] * w1[2]; g8[7] += hv[e] * w1[3]; } }
            { const bool b0 = lane & 1, b1 = lane & 2, b2 = lane & 4;
              float h4[4], h2[2], m1;
#pragma unroll
              for (int q = 0; q < 4; ++q) { const float keep = b0 ? g8[4 + q] : g8[q], send = b0 ? g8[q] : g8[4 + q]; h4[q] = keep + xswz<1>(send); }
#pragma unroll
              for (int q = 0; q < 2; ++q) { const float keep = b1 ? h4[2 + q] : h4[q], send = b1 ? h4[q] : h4[2 + q]; h2[q] = keep + xswz<2>(send); }
              { const float keep = b2 ? h2[1] : h2[0], send = b2 ? h2[0] : h2[1]; m1 = keep + xswz<4>(send); }
              m1 = xadd<8>(m1); m1 = xadd<16>(m1); m1 = xadd<32>(m1);
              const int gq = ((lane & 1) << 2) | (lane & 2) | ((lane >> 2) & 1); const bool isf = gq >= 4; const int gi = gq & 3;
              const float xf = m1 + (isf ? b_f[gi] : b_i[gi]);
              const float outv = isf ? (fminf(xf, 0.f) - log1pf(expf(-fabsf(xf)))) : xf;
              if (lane < 8) (isf ? LF : LI)[(size_t)row * 4 + gi] = outv; }
        }
    }
}

struct EpiProj {
    static constexpr bool PERM = true, AFTER_DRAIN = false;
    bf16 *MQ, *MK, *MV, *GM, *AQ, *AK, *AV, *AZ, *HALO;
    __device__ __forceinline__ void operator()(const pg8::f32x4 (&acc)[2][2][4][2], const pg8::Unit& u, int wr, int wc, int fr, int fq) const {
        const int pn = u.pn; const int row0 = u.pm * 256 + wr * 64 + fr;
        if (pn >= 12 && pn < 20) {
            const int col = 128 * (pn - 12) + wc * 32 + 8 * fq;
#pragma unroll
            for (int ai = 0; ai < 2; ++ai)
#pragma unroll
                for (int m = 0; m < 4; ++m) { bf16* p = GM + (size_t)(row0 + ai * 128 + m * 16) * 1024 + col;
                    float g[8];
#pragma unroll
                    for (int n = 0; n < 2; ++n)
#pragma unroll
                        for (int e = 0; e < 4; ++e) { const float o = acc[ai][0][m][n][e], z = acc[ai][1][m][n][e]; g[4 * n + e] = z * __builtin_amdgcn_rcpf((1.f + __expf(-o)) * (1.f + __expf(-z))); }
                    u32x4 w; w.x = pk2(g[0], g[1]); w.y = pk2(g[2], g[3]); w.z = pk2(g[4], g[5]); w.w = pk2(g[6], g[7]);
                    *(u32x4*)p = w; }
            return;
        }
        bf16* base; float sc = 1.f; int act = 0; int ct;
        if (pn < 4) { base = MQ; ct = pn; } else if (pn < 8) { base = MK; ct = pn - 4; } else if (pn < 12) { base = MV; ct = pn - 8; }
        else if (pn < 24) { base = AQ; ct = pn - 20; sc = QSCALE; } else if (pn < 28) { base = AK; ct = pn - 24; } else if (pn < 32) { base = AV; ct = pn - 28; }
        else { base = AZ; ct = pn - 32; act = 1; }
        const int col0 = ct * 256 + wc * 32 + 8 * fq;
#pragma unroll
        for (int ai = 0; ai < 2; ++ai)
#pragma unroll
            for (int m = 0; m < 4; ++m) { bf16* rowp = base + (size_t)(row0 + ai * 128 + m * 16) * 1024 + col0;
#pragma unroll
                for (int bj = 0; bj < 2; ++bj) { pg8::f32x4 v0 = acc[ai][bj][m][0], v1 = acc[ai][bj][m][1];
                    if (act) { v0 = (pg8::f32x4){siluf(v0[0]), siluf(v0[1]), siluf(v0[2]), siluf(v0[3])}; v1 = (pg8::f32x4){siluf(v1[0]), siluf(v1[1]), siluf(v1[2]), siluf(v1[3])}; }
                    v0 = v0 * sc; v1 = v1 * sc;
                    u32x4 w; w.x = pk2(v0[0], v0[1]); w.y = pk2(v0[2], v0[3]); w.z = pk2(v1[0], v1[1]); w.w = pk2(v1[2], v1[3]);
                    *(u32x4*)(rowp + bj * 128) = w;
                    if (pn < 8) { const int row = row0 + ai * 128 + m * 16;
                        if ((row & 63) >= 61) *(u32x4*)(HALO + ((size_t)((pn >> 2) * 512 + (row >> 6)) * 3 + ((row & 63) - 61)) * 1024 + col0 + bj * 128) = w; } } }
    }
};
struct EpiOut {
    static constexpr bool PERM = false, AFTER_DRAIN = false;
    const float* x; const float* mod; float* out; float* rss;
    __device__ __forceinline__ void operator()(const pg8::f32x4 (&acc)[2][2][4][2], const pg8::Unit& u, int wr, int wc, int fr, int fq) const {
        const int col0 = u.pn * 256 + wc * 32 + 4 * fq; const int b = (u.pm * 256) / SEQ;
        pg8::f32x4 gv[2][2];
#pragma unroll
        for (int bj = 0; bj < 2; ++bj)
#pragma unroll
            for (int n = 0; n < 2; ++n) gv[bj][n] = *(const pg8::f32x4*)(mod + b * 3072 + 2048 + col0 + bj * 128 + n * 16);
#pragma unroll
        for (int ai = 0; ai < 2; ++ai)
#pragma unroll
            for (int m = 0; m < 4; ++m) { const int row = u.pm * 256 + ai * 128 + wr * 64 + m * 16 + fr; const size_t off = (size_t)row * D + col0; float ss = 0.f;
#pragma unroll
                for (int bj = 0; bj < 2; ++bj)
#pragma unroll
                    for (int n = 0; n < 2; ++n) { const pg8::f32x4 xv = *(const pg8::f32x4*)(x + off + bj * 128 + n * 16);
                        const pg8::f32x4 o = xv + gv[bj][n] * acc[ai][bj][m][n];
                        ss += (o[0] * o[0] + o[1] * o[1]) + (o[2] * o[2] + o[3] * o[3]);
                        *(pg8::f32x4*)(out + off + bj * 128 + n * 16) = o; }
                ss = xadd<16>(ss); ss = xadd<32>(ss);
                if (fq == 0) rss[(size_t)row * 16 + u.pn * 4 + wc] = ss; }
    }
};

__device__ __forceinline__ void phase5(KArgs a, int vcu, int G, int WV) {
    const int tid = TID_OF(WV), lane = tid & 63, wave = WV;
    const float* fnw = a->in[18]; const float* rss = (const float*)(a->ws + WS_RSS); float* out = a->out;
    f32x4 fw[4];
#pragma unroll
    for (int j = 0; j < 4; ++j) fw[j] = *(const f32x4*)(fnw + 4 * lane + 256 * j);
    const int gw = vcu * NWAVES + wave, NGW = G * NWAVES;
    for (int grp = gw; grp < MTOK / 16; grp += NGW)
        for (int r = 0; r < 16; ++r) { const int row = grp * 16 + r;
            const f32x4* pr = (const f32x4*)(rss + (size_t)row * 16);
            const f32x4 p0 = pr[0], p1 = pr[1], p2 = pr[2], p3 = pr[3];
            const float tot = (((p0[0] + p0[1]) + (p0[2] + p0[3])) + ((p1[0] + p1[1]) + (p1[2] + p1[3]))) + (((p2[0] + p2[1]) + (p2[2] + p2[3])) + ((p3[0] + p3[1]) + (p3[2] + p3[3])));
            const float rstd = 1.0f / sqrtf(tot * (1.f / D) + EPS);
            f32x4* o = (f32x4*)(out + (size_t)row * D) + lane;
#pragma unroll
            for (int j = 0; j < 4; ++j) o[64 * j] = o[64 * j] * rstd * fw[j]; }
}

__device__ __forceinline__ void phase5_touch(KArgs a, int vcu, int G, int WV) {
    const int tid = TID_OF(WV), lane = tid & 63, wave = WV;
    const float* rss = (const float*)(a->ws + WS_RSS); float* out = a->out;
    const int gw = vcu * NWAVES + wave, NGW = G * NWAVES;
    for (int grp = gw; grp < MTOK / 16; grp += NGW)
        for (int r = 0; r < 16; ++r) { const int row = grp * 16 + r;
            const f32x4* pr = (const f32x4*)(rss + (size_t)row * 16);
            const f32x4 p0 = pr[0], p1 = pr[1], p2 = pr[2], p3 = pr[3];
            const float tot = (p0[0] + p1[0]) + (p2[0] + p3[0]);
            const float one = (tot == -1.2345f) ? 2.f : 1.f;
            f32x4* o = (f32x4*)(out + (size_t)row * D) + lane;
#pragma unroll
            for (int j = 0; j < 4; ++j) o[64 * j] = o[64 * j] * one; }
}
constexpr int CW_BAR = 4096;
#define XB_TMO      128
#define XB_XCNT(j)  (256  + 64 * (j))
#define XB_XSUB(j)  (1280 + 64 * (j))
#define XB_XGEN(j)  (2304 + 64 * (j))
#define XB_TOP      3328
#define XB_TOPGEN   3392
#define XCD_BAR_WORDS 3456
#define XB_SPIN_CAP (1u << 18)

__device__ __forceinline__ unsigned xb_ld(unsigned* p)              { return __hip_atomic_load(p, __ATOMIC_RELAXED, __HIP_MEMORY_SCOPE_AGENT); }
__device__ __forceinline__ unsigned xb_add(unsigned* p, unsigned v) { return __hip_atomic_fetch_add(p, v, __ATOMIC_RELAXED, __HIP_MEMORY_SCOPE_AGENT); }
__device__ __forceinline__ unsigned xb_xcc_id() { return (unsigned)__builtin_amdgcn_s_getreg((3 << 11) | 20) & 0xFu; }
#define XB_SPIN(cond, bar) do { unsigned _sp = 0; while (cond) { __builtin_amdgcn_s_sleep(1); \
    if ((++_sp & 255u) == 0u) { if (xb_ld(&(bar)[XB_TMO])) break; if (_sp > XB_SPIN_CAP) { atomicAdd(&(bar)[XB_TMO], 1u); break; } } } } while (0)

struct XcdBarrier {
    unsigned* bar; unsigned x;
    volatile LAS unsigned* st;
};

__device__ __forceinline__ XcdBarrier xcd_barrier_post(unsigned* bar, volatile LAS unsigned* st, bool t0) {
    XcdBarrier b; b.bar = bar; b.x = xb_xcc_id(); b.st = st;
    if (t0) (void)xb_add(&bar[XB_XCNT(b.x)], 1u);
    return b;
}
__device__ __forceinline__ void xcd_barrier_complete(unsigned* bar, unsigned x, unsigned& nloc, unsigned& nx) {
    const unsigned G = gridDim.x * gridDim.y * gridDim.z;
    unsigned sum, cnt, mine, sp = 0u;
    for (;;) {
        sum = 0u; cnt = 0u; mine = 0u;
#pragma unroll
        for (unsigned j = 0; j < 16; ++j) { const unsigned c = xb_ld(&bar[XB_XCNT(j)]); sum += c; cnt += (c > 0u) ? 1u : 0u; mine = (j == x) ? c : mine; }
        if (sum == G) break;
        __builtin_amdgcn_s_sleep(1);
        if ((++sp & 255u) == 0u) { if (xb_ld(&bar[XB_TMO])) break; if (sp > XB_SPIN_CAP) { atomicAdd(&bar[XB_TMO], 1u); break; } }
    }
    nloc = mine > 0u ? mine : 1u; nx = cnt > 0u ? cnt : 1u;
}

__device__ __forceinline__ void xcd_barrier(const XcdBarrier& b, bool t0) {
    asm volatile("s_waitcnt vmcnt(0)" ::: "memory");
    __syncthreads();
    if (t0) {
        unsigned* bar = b.bar;
        __builtin_amdgcn_s_waitcnt(0);
        unsigned nloc = b.st[0], nx = b.st[1];
        if (nloc == 0u) { xcd_barrier_complete(bar, b.x, nloc, nx); b.st[0] = nloc; b.st[1] = nx; }
        const unsigned old = xb_add(&bar[XB_XSUB(b.x)], 1u);
        const unsigned gen = old / nloc;
        if (old + 1u == (gen + 1u) * nloc) {
            __builtin_amdgcn_fence(__ATOMIC_RELEASE, "agent");
            asm volatile("s_waitcnt vmcnt(0)" ::: "memory");
            const unsigned og = xb_add(&bar[XB_TOP], 1u);
            const unsigned tg = og / nx;
            if (og + 1u == (tg + 1u) * nx) xb_add(&bar[XB_TOPGEN], 1u);
            else XB_SPIN(xb_ld(&bar[XB_TOPGEN]) == tg, bar);
            __builtin_amdgcn_fence(__ATOMIC_ACQUIRE, "agent");
            xb_add(&bar[XB_XGEN(b.x)], 1u);
            asm volatile("s_waitcnt vmcnt(0)" ::: "memory");
        } else {
            XB_SPIN(xb_ld(&bar[XB_XGEN(b.x)]) == gen, bar);
            __builtin_amdgcn_fence(__ATOMIC_ACQUIRE, "agent");
            asm volatile("s_waitcnt vmcnt(0)" ::: "memory");
        }
    }
    __syncthreads();
}

__device__ __forceinline__ int crow(int r, int hi) { return (r & 3) + 8 * (r >> 2) + 4 * hi; }
typedef short v4i16_t __attribute__((ext_vector_type(4)));
__device__ __forceinline__ s16x4 ldtr(const LAS unsigned char* p) { return __builtin_bit_cast(s16x4, __builtin_amdgcn_ds_read_tr16_b64_v4i16((LAS v4i16_t*)p)); }
__device__ __forceinline__ bf16x8 ldfrag(const LAS unsigned char* p) { return *(const LAS bf16x8*)p; }
__device__ __forceinline__ float halfswap_max(float m) { auto rr = __builtin_amdgcn_permlane32_swap(__float_as_uint(m), __float_as_uint(m), false, false); return fmaxf(__uint_as_float(rr[0]), __uint_as_float(rr[1])); }
__device__ __forceinline__ float halfswap_sum(float m) { auto rr = __builtin_amdgcn_permlane32_swap(__float_as_uint(m), __float_as_uint(m), false, false); return __uint_as_float(rr[0]) + __uint_as_float(rr[1]); }
__device__ __forceinline__ bf16x8 pack8(const f32x16& p, int base) {
    u32x4 w; w.x = pk2(p[base + 0], p[base + 1]); w.y = pk2(p[base + 2], p[base + 3]); w.z = pk2(p[base + 4], p[base + 5]); w.w = pk2(p[base + 6], p[base + 7]);
    return __builtin_bit_cast(bf16x8, w);
}
__device__ __forceinline__ int t5_bucket(int n) {
    if (n < 16) return n;
    int bkt = 16;
    bkt += (n >= 19); bkt += (n >= 21); bkt += (n >= 24); bkt += (n >= 27); bkt += (n >= 31); bkt += (n >= 35); bkt += (n >= 40); bkt += (n >= 46);
    bkt += (n >= 52); bkt += (n >= 59); bkt += (n >= 67); bkt += (n >= 77); bkt += (n >= 87); bkt += (n >= 99); bkt += (n >= 113);
    return bkt;
}

namespace att {
constexpr int L_RING = 0;
constexpr int L_TB = 98304;
constexpr int L_WSF = L_TB + 512;
constexpr int L_STAGE = 0;
constexpr int SROW = 132;
constexpr float THR = 8.0f;

__device__ __forceinline__ void attn_unit(KArgs a, LAS unsigned char* lds, int WV, int b, int h, int qb, bool dummy = false) {
    int tid_ = TID_OF(WV); asm volatile("" : "+v"(tid_));
    const int tid = tid_, lane = tid & 63, r32 = lane & 31, hi = lane >> 5, wave = WV;
    const int rb = wave & 3, mp = wave >> 2;
    bf16* AQ = (bf16*)(a->ws + WS_AQ); const bf16* AK = (const bf16*)(a->ws + WS_AK); const bf16* AV = (const bf16*)(a->ws + WS_AV); const bf16* AZ = (const bf16*)(a->ws + WS_AZ);
    const float* relb = a->in[16]; const float* anw = a->in[15];
    const size_t rowbase = (size_t)b * SEQ; const int q0 = qb * 128;
    const int qmin = q0 + 32 * rb, qrow = qmin + r32;
    LAS float* tb = (LAS float*)(lds + L_TB); LAS float* wsf = (LAS float*)(lds + L_WSF) + wave * 64; LAS float* stage = (LAS float*)(lds + L_STAGE);
    bf16x8 qf[4];
#pragma unroll
    for (int ks = 0; ks < 4; ++ks) qf[ks] = *(const bf16x8*)(AQ + (rowbase + qrow) * 1024 + h * 128 + mp * 64 + ks * 16 + hi * 8);
    if (tid < 128) tb[tid] = (tid < 113) ? (relb[t5_bucket(tid) * AH + h] - relb[31 * AH + h]) * LOG2E : 0.f;
    const int lc = tid & 15, lkv = tid >> 4;
    const bf16* kg = AK + (rowbase + lkv) * 1024 + h * 128 + lc * 8;
    const bf16* vg = AV + (rowbase + lkv) * 1024 + h * 128 + lc * 8;
    const int kofs0 = lc * 1024 + ((lkv ^ lc) * 16), kofs1 = lc * 1024 + (((lkv + 32) ^ lc) * 16);
    const int vofs0 = 16384 + (lc >> 2) * 4096 + (lkv >> 4) * 1024 + (lkv & 15) * 64 + (lc & 3) * 16, vofs1 = vofs0 + 2048;
    const int NT = 2 * qb + 2;
    u32x4 kA0, kA1, vA0, vA1, kB0, kB1, vB0, vB1;
#define ATT_LOAD(K0, K1, V0, V1, t) do { const size_t go_ = (size_t)(t) * 64 * 1024; K0 = *(const u32x4*)(kg + go_); K1 = *(const u32x4*)(kg + go_ + 32 * 1024); V0 = *(const u32x4*)(vg + go_); V1 = *(const u32x4*)(vg + go_ + 32 * 1024); } while (0)
#define ATT_STORE(K0, K1, V0, V1, bo) do { LAS unsigned char* nb_ = lds + L_RING + (bo); *(LAS u32x4*)(nb_ + kofs0) = K0; *(LAS u32x4*)(nb_ + kofs1) = K1; *(LAS u32x4*)(nb_ + vofs0) = V0; *(LAS u32x4*)(nb_ + vofs1) = V1; } while (0)
    ATT_LOAD(kA0, kA1, vA0, vA1, 0); ATT_LOAD(kB0, kB1, vB0, vB1, 1);
    ATT_STORE(kA0, kA1, vA0, vA1, 0);
    __syncthreads();
    f32x16 o[4];
#pragma unroll
    for (int e = 0; e < 4; ++e)
#pragma unroll
        for (int r = 0; r < 16; ++r) o[e][r] = 0.f;
    float mref = 0.f, lsum = 0.f;
    f32x16 negm;
#pragma unroll
    for (int r = 0; r < 16; ++r) negm[r] = 0.f;
    const int vlane = ((lane >> 4) & 1) * 32 + (lane & 3) * 8 + (4 * hi + ((lane & 15) >> 2)) * 64;
    int bcur = 0, bnext = 32768;
    for (int jj = 0; jj < NT; jj += 2) {
#pragma unroll
      for (int par = 0; par < 2; ++par) { const int j = jj + par;
        if (j + 2 < NT) { if (par == 0) ATT_LOAD(kA0, kA1, vA0, vA1, j + 2); else ATT_LOAD(kB0, kB1, vB0, vB1, j + 2); }
        const int kv0 = 64 * j;
        if (kv0 <= qmin + 31) {
            const LAS unsigned char* kb = lds + L_RING + bcur; const LAS unsigned char* vb = kb + 16384 + vlane;
            f32x16 s0, s1;
#ifdef ATT_ABL
            const bool abl_ = dummy;
#else
            const bool abl_ = false;
#endif
            (void)abl_;
            { bf16x8 kf[8];
#pragma unroll
              for (int ks = 0; ks < 4; ++ks) { const int cgi = mp * 8 + 2 * ks + hi;
                  kf[2 * ks] = ldfrag(kb + cgi * 1024 + ((r32 ^ cgi) * 16)); kf[2 * ks + 1] = ldfrag(kb + cgi * 1024 + (((r32 + 32) ^ cgi) * 16)); }
              __builtin_amdgcn_sched_barrier(0);
#pragma unroll
              for (int ks = 0; ks < 4; ++ks) {
                  s0 = __builtin_amdgcn_mfma_f32_32x32x16_bf16(kf[2 * ks], qf[ks], ks == 0 ? negm : s0, 0, 0, 0);
                  s1 = __builtin_amdgcn_mfma_f32_32x32x16_bf16(kf[2 * ks + 1], qf[ks], ks == 0 ? negm : s1, 0, 0, 0); } }
            s16x4 vAl[4], vAh[4], vBl[4], vBh[4];
#pragma unroll
            for (int ks = 0; ks < 4; ++ks) { vAl[ks] = ldtr(vb + ks * 1024); vAh[ks] = ldtr(vb + ks * 1024 + 512); }
            if (qmin - (kv0 + 63) < 113) {
#pragma unroll
                for (int r = 0; r < 16; ++r) { const int d0 = qrow - (kv0 + crow(r, hi)); const int i0 = min(max(d0, 0), 127), i1 = min(max(d0 - 32, 0), 127);
                    s0[r] += tb[i0]; s1[r] += tb[i1]; }
            }
            if (kv0 + 63 > qmin) {
#pragma unroll
                for (int r = 0; r < 16; ++r) { const int kv = kv0 + crow(r, hi); if (kv > qrow) s0[r] = -INFINITY; if (kv + 32 > qrow) s1[r] = -INFINITY; }
            }
#if defined(ATT_ABL) && ATT_ABL == 2
            if (!abl_) {
#endif
            float rm;
            { float m0_ = fmaxf(fmaxf(s0[0], s0[1]), s0[2]), m1_ = fmaxf(fmaxf(s0[3], s0[4]), s0[5]), m2_ = fmaxf(fmaxf(s1[0], s1[1]), s1[2]), m3_ = fmaxf(fmaxf(s1[3], s1[4]), s1[5]);
              m0_ = fmaxf(fmaxf(m0_, s0[6]), s0[7]); m1_ = fmaxf(fmaxf(m1_, s0[8]), s0[9]); m2_ = fmaxf(fmaxf(m2_, s1[6]), s1[7]); m3_ = fmaxf(fmaxf(m3_, s1[8]), s1[9]);
              m0_ = fmaxf(fmaxf(m0_, s0[10]), s0[11]); m1_ = fmaxf(fmaxf(m1_, s0[12]), s0[13]); m2_ = fmaxf(fmaxf(m2_, s1[10]), s1[11]); m3_ = fmaxf(fmaxf(m3_, s1[12]), s1[13]);
              m0_ = fmaxf(fmaxf(m0_, s0[14]), s0[15]); m2_ = fmaxf(fmaxf(m2_, s1[14]), s1[15]);
              rm = fmaxf(fmaxf(m0_, m1_), fmaxf(m2_, m3_)); }
            rm = halfswap_max(rm);
            if (j == 0 || __any(rm > THR)) {
                const float dl = (j == 0) ? rm : fmaxf(rm, 0.f);
                mref += dl;
#pragma unroll
                for (int r = 0; r < 16; ++r) { s0[r] -= dl; s1[r] -= dl; negm[r] = -mref; }
                if (j != 0) { const float f = __builtin_amdgcn_exp2f(-dl); lsum *= f;
                    if (hi == 0) wsf[r32] = f;
#pragma unroll
                    for (int r = 0; r < 16; ++r) { const float fr_ = wsf[crow(r, hi)];
#pragma unroll
                        for (int e = 0; e < 4; ++e) o[e][r] *= fr_; } }
            }
#pragma unroll
            for (int r = 0; r < 16; ++r) { s0[r] = __builtin_amdgcn_exp2f(s0[r]); s1[r] = __builtin_amdgcn_exp2f(s1[r]); }
            lsum += (((s0[0] + s0[1]) + (s0[2] + s0[3])) + ((s0[4] + s0[5]) + (s0[6] + s0[7]))) + (((s0[8] + s0[9]) + (s0[10] + s0[11])) + ((s0[12] + s0[13]) + (s0[14] + s0[15])))
                  + (((s1[0] + s1[1]) + (s1[2] + s1[3])) + ((s1[4] + s1[5]) + (s1[6] + s1[7]))) + (((s1[8] + s1[9]) + (s1[10] + s1[11])) + ((s1[12] + s1[13]) + (s1[14] + s1[15])));
#if defined(ATT_ABL) && ATT_ABL == 2
            }
#endif
            const bf16x8 pa0 = pack8(s0, 0), pa1 = pack8(s0, 8), pa2 = pack8(s1, 0), pa3 = pack8(s1, 8);
#define ATT_VFX(L, H, k) (bf16x8){L[k][0], L[k][1], L[k][2], L[k][3], H[k][0], H[k][1], H[k][2], H[k][3]}
#define ATT_PV(e, L, H) do { o[e] = __builtin_amdgcn_mfma_f32_32x32x16_bf16(pa0, ATT_VFX(L, H, 0), o[e], 0, 0, 0); o[e] = __builtin_amdgcn_mfma_f32_32x32x16_bf16(pa1, ATT_VFX(L, H, 1), o[e], 0, 0, 0); \
                o[e] = __builtin_amdgcn_mfma_f32_32x32x16_bf16(pa2, ATT_VFX(L, H, 2), o[e], 0, 0, 0); o[e] = __builtin_amdgcn_mfma_f32_32x32x16_bf16(pa3, ATT_VFX(L, H, 3), o[e], 0, 0, 0); } while (0)
#define ATT_VRD(L, H, e) do { _Pragma("unroll") for (int ks = 0; ks < 4; ++ks) { L[ks] = ldtr(vb + (e) * 4096 + ks * 1024); H[ks] = ldtr(vb + (e) * 4096 + ks * 1024 + 512); } } while (0)
#if defined(ATT_ABL) && ATT_ABL == 1
            if (!abl_) {
#endif
            ATT_VRD(vBl, vBh, 1); __builtin_amdgcn_sched_barrier(0); ATT_PV(0, vAl, vAh);
            ATT_VRD(vAl, vAh, 2); __builtin_amdgcn_sched_barrier(0); ATT_PV(1, vBl, vBh);
            ATT_VRD(vBl, vBh, 3); __builtin_amdgcn_sched_barrier(0); ATT_PV(2, vAl, vAh);
            __builtin_amdgcn_sched_barrier(0); ATT_PV(3, vBl, vBh);
#if defined(ATT_ABL) && ATT_ABL == 1
            }
#endif
#undef ATT_VFX
#undef ATT_PV
#undef ATT_VRD
        }
        if (j + 1 < NT) { if (par == 0) ATT_STORE(kB0, kB1, vB0, vB1, bnext); else ATT_STORE(kA0, kA1, vA0, vA1, bnext); }
        bcur = bnext; bnext = (bnext == 65536) ? 0 : bnext + 32768;
        __syncthreads();
      }
    }
#undef ATT_LOAD
#undef ATT_STORE
    u32x4 zpre[4];
    { int te_ = tid; asm volatile("" : "+v"(te_)); const int row = te_ >> 2, part = te_ & 3;
      const u32x4* zp = (const u32x4*)(AZ + (rowbase + q0 + row) * 1024 + h * 128 + 32 * part);
#pragma unroll
      for (int i = 0; i < 4; ++i) zpre[i] = zp[i]; }
    const float ltot = halfswap_sum(lsum);
    const float lam_ = *(volatile LAS float*)(lds + LDS_BYTES - 48);
    const float sc = (mp == 0 ? 1.0f : -lam_) / ltot;
    if (hi == 0) wsf[r32] = sc;
    float scr[16];
#pragma unroll
    for (int r = 0; r < 16; ++r) scr[r] = wsf[crow(r, hi)];
    if (mp == 0) {
#pragma unroll
        for (int e = 0; e < 4; ++e)
#pragma unroll
            for (int r = 0; r < 16; ++r) stage[(32 * rb + crow(r, hi)) * SROW + 32 * e + r32] = o[e][r] * scr[r];
    }
    __syncthreads();
    if (mp == 1) {
#pragma unroll
        for (int e = 0; e < 4; ++e)
#pragma unroll
            for (int r = 0; r < 16; ++r) stage[(32 * rb + crow(r, hi)) * SROW + 32 * e + r32] += o[e][r] * scr[r];
    }
    __syncthreads();
    { const int row = tid >> 2, part = tid & 3;
      const LAS f32x4* sp = (const LAS f32x4*)(stage + row * SROW + 32 * part);
      f32x4 v[8]; float ss = 0.f;
#pragma unroll
      for (int i = 0; i < 8; ++i) { v[i] = sp[i]; ss += (v[i][0] * v[i][0] + v[i][1] * v[i][1]) + (v[i][2] * v[i][2] + v[i][3] * v[i][3]); }
      ss = xadd<1>(ss); ss = xadd<2>(ss);
      const float rs = 0.8f / sqrtf(ss * (1.f / 128.f) + EPS);
      const size_t go = (rowbase + q0 + row) * 1024 + h * 128 + 32 * part;
      u32x4* op = dummy ? (u32x4*)((bf16*)(a->ws + WS_DUMMY) + (size_t)row * 1024 + h * 128 + 32 * part) : (u32x4*)(AQ + go); const f32x4* wp = (const f32x4*)(anw + 32 * part);
#pragma unroll
      for (int i = 0; i < 4; ++i) { const u32x4 z = zpre[i]; const f32x4 w0 = wp[2 * i], w1 = wp[2 * i + 1]; const f32x4 x0 = v[2 * i] * rs * w0, x1 = v[2 * i + 1] * rs * w1;
          u32x4 w; w.x = pk2(x0[0] * bflo(z.x), x0[1] * bfhi(z.x)); w.y = pk2(x0[2] * bflo(z.y), x0[3] * bfhi(z.y));
          w.z = pk2(x1[0] * bflo(z.z), x1[1] * bfhi(z.z)); w.w = pk2(x1[2] * bflo(z.w), x1[3] * bfhi(z.w)); op[i] = w; } }
    __syncthreads();
}
}

namespace prep {
constexpr unsigned N_ITEMS = MTOK / 64;
__device__ __forceinline__ void conv_item(KArgs a, int WV, int g) {
    int tid_ = TID_OF(WV); asm volatile("" : "+v"(tid_)); const int tid = tid_;
    bf16* MQ = (bf16*)a->out; bf16* MK = MQ + (size_t)MTOK * 1024; const bf16* HALO = (const bf16*)(a->ws + WS_HALO);
    const int c0 = 2 * tid;
    f32x2 wq[4], wk[4];
#pragma unroll
    for (int j = 0; j < 4; ++j) { wq[j] = *(const f32x2*)(a->in[8] + j * 1024 + c0); wk[j] = *(const f32x2*)(a->in[9] + j * 1024 + c0); }
    unsigned q3 = 0u, q2 = 0u, q1 = 0u, k3 = 0u, k2 = 0u, k1 = 0u;
    if ((g & 31) != 0) { const bf16* hq = HALO + (size_t)(g - 1) * 3 * 1024 + c0; const bf16* hk = hq + (size_t)512 * 3 * 1024;
        q3 = *(const unsigned*)hq; q2 = *(const unsigned*)(hq + 1024); q1 = *(const unsigned*)(hq + 2048);
        k3 = *(const unsigned*)hk; k2 = *(const unsigned*)(hk + 1024); k1 = *(const unsigned*)(hk + 2048); }
    bf16* qp = MQ + (size_t)g * 64 * 1024 + c0; bf16* kp = MK + (size_t)g * 64 * 1024 + c0;
#define PREP_PASS(ptr, w, h3, h2, h1, SCALE) do { unsigned r_[64]; \
        _Pragma("unroll") for (int t = 0; t < 64; ++t) r_[t] = *(const unsigned*)((ptr) + t * 1024); \
        unsigned p3 = h3, p2 = h2, p1 = h1; \
        _Pragma("unroll") for (int t = 0; t < 64; ++t) { const unsigned u = r_[t]; \
            const float a0 = w[0][0] * bflo(p3) + w[1][0] * bflo(p2) + w[2][0] * bflo(p1) + w[3][0] * bflo(u); \
            const float a1 = w[0][1] * bfhi(p3) + w[1][1] * bfhi(p2) + w[2][1] * bfhi(p1) + w[3][1] * bfhi(u); \
            *(unsigned*)((ptr) + t * 1024) = pk2(siluf(a0) * (SCALE), siluf(a1) * (SCALE)); \
            p3 = p2; p2 = p1; p1 = u; } } while (0)
    PREP_PASS(qp, wq, q3, q2, q1, 0.0625f);
    PREP_PASS(kp, wk, k3, k2, k1, 1.0f);
#undef PREP_PASS
    asm volatile("s_waitcnt vmcnt(0)" ::: "memory");
    __syncthreads();
    if (tid == 0) { __builtin_amdgcn_fence(__ATOMIC_RELEASE, "agent"); asm volatile("s_waitcnt vmcnt(0)" ::: "memory");
        __hip_atomic_fetch_add((unsigned*)(a->ws + WS_CTL) + CW_PREP, 1u, __ATOMIC_RELAXED, __HIP_MEMORY_SCOPE_AGENT); }
}
__device__ __forceinline__ void wait_all(KArgs a, int WV) {
    if (WV == 0 && lane_id() == 0) { unsigned* cnt = (unsigned*)(a->ws + WS_CTL) + CW_PREP; unsigned spins = 0u;
        while (__hip_atomic_load(cnt, __ATOMIC_RELAXED, __HIP_MEMORY_SCOPE_AGENT) < N_ITEMS) { __builtin_amdgcn_s_sleep(16); if (++spins > (1u << 22)) break; }
        __builtin_amdgcn_fence(__ATOMIC_ACQUIRE, "agent"); asm volatile("s_waitcnt vmcnt(0)" ::: "memory"); }
    __syncthreads();
}
}

namespace mls {
#ifdef MLS_KEEP_SB
#define MLS_SB __builtin_amdgcn_sched_barrier(0)
#else
#define MLS_SB do { } while (0)
#endif
constexpr int L_Q = 0;
constexpr int L_K = 32768;
constexpr int L_STAGE = 0;
constexpr int L_KW = 66560;
constexpr int L_V = L_KW + 32768;
constexpr int L_P = L_V + 32768;
constexpr int L_SC = L_P + 8192;
constexpr int L_N = L_SC + 18 * 256;
constexpr int L_CW = L_N + 1024;
constexpr int L_MW = L_CW + 8192;
constexpr int L_END = L_MW + 1024;
static_assert(L_END <= LDS_BYTES, "mLSTM LDS map");
constexpr int SROW = 260;

__device__ __forceinline__ void mlstm_unit(KArgs a, LAS unsigned char* lds, int WV, int b, int h) {
    int tid_ = TID_OF(WV); asm volatile("" : "+v"(tid_));
    const int tid = tid_, lane = tid & 63, r32 = lane & 31, hi = lane >> 5, wave = WV;
    prep::wait_all(a, WV);
    const bf16* MQ = (const bf16*)a->out; unsigned char* wsb = a->ws;
#define MK (MQ + (size_t)MTOK * 1024)
#define MV ((const bf16*)(wsb + WS_MV))
#define GM ((const bf16*)(wsb + WS_GM))
#define HM ((bf16*)(wsb + WS_HB))
#define LI ((const float*)(wsb + WS_LI))
#define LF ((const float*)(wsb + WS_LF))
    LAS float* S_psum = (LAS float*)(lds + L_SC) + 768; LAS float* S_qn = S_psum + 256;
    LAS float* nperm = (LAS float*)(lds + L_N); LAS float* stage = (LAS float*)(lds + L_STAGE);
    f32x16 X[8];
#pragma unroll
    for (int i = 0; i < 8; ++i)
#pragma unroll
        for (int r = 0; r < 16; ++r) X[i][r] = 0.f;
    if (tid < 256) nperm[tid] = 0.f;
    if (tid < 256) ((LAS float*)(lds + L_MW))[tid] = a->in[10][h * 256 + tid];
    float m_prev = 0.f;
    const int tg = WV >> 1;
#define MLS_LANE_IDS int tf_ = tid; asm volatile("" : "+v"(tf_));   \
    const int dp = tf_ & 127, d0 = 2 * dp; \
    const int ppos = (d0 & ~12) | ((d0 & 4) << 1) | ((d0 & 8) >> 1);     \
    const int qch = ppos >> 3, qbo = (ppos & 7) * 2;
#define MLS_LOAD_SET(Rq, Rk, Rv, cc, hs) do { const int t0_ = 32 * (hs) + 8 * tg; int tl_ = tid; asm volatile("" : "+v"(tl_)); const int d0 = 2 * (tl_ & 127);     \
        const size_t ub_ = ((size_t)b * SEQ + 64 * (cc) + t0_) * 1024 + h * 256; \
        const bf16* qb_ = MQ + ub_; const bf16* kb_ = MK + ub_; const bf16* vb_ = MV + ub_; \
        _Pragma("unroll") for (int i = 0; i < 8; ++i) { Rq[i] = *(const unsigned*)(qb_ + (i * 1024 + d0)); Rk[i] = *(const unsigned*)(kb_ + (i * 1024 + d0)); Rv[i] = *(const unsigned*)(vb_ + (i * 1024 + d0)); } } while (0)
#define MLS_FILL_SET(Rq, Rk, Rv, hs) do { const int t0_ = 32 * (hs) + 8 * tg; MLS_LANE_IDS \
        float kw0_[8], kw1_[8]; \
        _Pragma("unroll") for (int t = 0; t < 8; ++t) { const int row = t0_ + t; \
            const int ro_ = row * 512 + ((qch ^ (row & 15)) * 16) + qbo; \
            *(LAS unsigned*)(lds + L_Q + ro_) = Rq[t]; *(LAS unsigned*)(lds + L_K + ro_) = Rk[t]; \
            const float wsr = S_ws[row]; kw0_[t] = bflo(Rk[t]) * wsr; kw1_[t] = bfhi(Rk[t]) * wsr; } \
        const int cs_ = t0_ >> 3; \
        { const int d = d0; const int ro_ = d * 128 + ((cs_ ^ ((d >> 1) & 7)) * 16); \
          u32x4 w; w.x = pk2(kw0_[0], kw0_[1]); w.y = pk2(kw0_[2], kw0_[3]); w.z = pk2(kw0_[4], kw0_[5]); w.w = pk2(kw0_[6], kw0_[7]); *(LAS u32x4*)(lds + L_KW + ro_) = w; \
          u32x4 wv; wv.x = (Rv[0] & 0xffffu) | (Rv[1] << 16); wv.y = (Rv[2] & 0xffffu) | (Rv[3] << 16); wv.z = (Rv[4] & 0xffffu) | (Rv[5] << 16); wv.w = (Rv[6] & 0xffffu) | (Rv[7] << 16); *(LAS u32x4*)(lds + L_V + ro_) = wv; } \
        { const int d = d0 + 1; const int ro_ = d * 128 + ((cs_ ^ ((d >> 1) & 7)) * 16); \
          u32x4 w; w.x = pk2(kw1_[0], kw1_[1]); w.y = pk2(kw1_[2], kw1_[3]); w.z = pk2(kw1_[4], kw1_[5]); w.w = pk2(kw1_[6], kw1_[7]); *(LAS u32x4*)(lds + L_KW + ro_) = w; \
          u32x4 wv; wv.x = (Rv[0] >> 16) | (Rv[1] & 0xffff0000u); wv.y = (Rv[2] >> 16) | (Rv[3] & 0xffff0000u); wv.z = (Rv[4] >> 16) | (Rv[5] & 0xffff0000u); wv.w = (Rv[6] >> 16) | (Rv[7] & 0xffff0000u); *(LAS u32x4*)(lds + L_V + ro_) = wv; } \
    } while (0)
    unsigned SAq[8], SAk[8], SAv[8];
    MLS_LOAD_SET(SAq, SAk, SAv, 0, 0);
    float pf_lf = 0.f, pf_li = 0.f;
    if (wave == 0) { const size_t ub_ = (size_t)b * SEQ * 4 + h; pf_lf = (LF + ub_)[lane * 4]; pf_li = (LI + ub_)[lane * 4]; }
#ifdef STAMP_SEG
    unsigned long long seg_acc = 0ull, seg_t = __builtin_amdgcn_s_memrealtime();
#define SEGT(k) do { const unsigned long long n_ = __builtin_amdgcn_s_memrealtime(); if ((k) == STAMP_SEG) seg_acc += n_ - seg_t; seg_t = n_; } while (0)
#else
#define SEGT(k) do { } while (0)
#endif
    for (int c = 0; c < SEQ / MCH; ++c) {
        const size_t row0 = (size_t)b * SEQ + 64 * c;
        LAS float* S_alpha = (LAS float*)(lds + L_SC) + (c & 1) * 384; LAS float* S_beta = S_alpha + 64; LAS float* S_iw = S_alpha + 128; LAS float* S_clamp = S_alpha + 192; LAS float* S_ws = S_alpha + 256; LAS float* S_misc = S_alpha + 320;
        unsigned SBq[8], SBk[8], SBv[8];
        MLS_LOAD_SET(SBq, SBk, SBv, c, 1);
        if (wave == 0) {
            const float lf = pf_lf, li = pf_li;
            if (c + 1 < SEQ / MCH) { const size_t ub_ = (row0 + 64) * 4 + h; pf_lf = (LF + ub_)[lane * 4]; pf_li = (LI + ub_)[lane * 4]; }
#define MLS_DPP(old_, src_, ctrl_, rmask_) __uint_as_float((unsigned)__builtin_amdgcn_update_dpp((int)__float_as_uint(old_), (int)__float_as_uint(src_), ctrl_, rmask_, 0xf, false))
            float bt = lf;
            bt += MLS_DPP(0.f, bt, 0x111, 0xf); bt += MLS_DPP(0.f, bt, 0x112, 0xf); bt += MLS_DPP(0.f, bt, 0x114, 0xf); bt += MLS_DPP(0.f, bt, 0x118, 0xf);
            bt += MLS_DPP(0.f, bt, 0x142, 0xa); bt += MLS_DPP(0.f, bt, 0x143, 0xc);
            const float beta = li - bt; float cm = beta; const float ninf = -INFINITY;
            cm = fmaxf(cm, MLS_DPP(ninf, cm, 0x111, 0xf)); cm = fmaxf(cm, MLS_DPP(ninf, cm, 0x112, 0xf)); cm = fmaxf(cm, MLS_DPP(ninf, cm, 0x114, 0xf)); cm = fmaxf(cm, MLS_DPP(ninf, cm, 0x118, 0xf));
            cm = fmaxf(cm, MLS_DPP(ninf, cm, 0x142, 0xa)); cm = fmaxf(cm, MLS_DPP(ninf, cm, 0x143, 0xc));
#undef MLS_DPP
            const float mx = fmaxf(cm, m_prev);
            S_alpha[lane] = -mx; S_beta[lane] = beta; S_iw[lane] = __expf(m_prev - mx); S_clamp[lane] = __expf(-(bt + mx));
            const float cmL = __uint_as_float(__builtin_amdgcn_readlane(__float_as_uint(cm), 63)), bL = __uint_as_float(__builtin_amdgcn_readlane(__float_as_uint(bt), 63)); const float mxL = fmaxf(m_prev, cmL);
            S_ws[lane] = __expf(beta - mxL);
            if (lane == 0) S_misc[0] = __expf(m_prev - mxL);
            m_prev = bL + mxL;
        }
        __syncthreads();
        SEGT(0);
        MLS_FILL_SET(SAq, SAk, SAv, 0);
        __builtin_amdgcn_sched_barrier(0);
        MLS_FILL_SET(SBq, SBk, SBv, 1);
        __builtin_amdgcn_sched_barrier(0);
        __syncthreads();
        SEGT(1);
        f32x16 num[2];
        {
            int lo_ = lane; asm volatile("" : "+v"(lo_));
            const int l15 = lo_ & 15, kq = lo_ >> 4, r32a = lo_ & 31, hia = lo_ >> 5;
            const int si = wave >> 1, ti0 = 2 * (wave & 1);
            f32x4 sa[2] = {(f32x4){0.f, 0.f, 0.f, 0.f}, (f32x4){0.f, 0.f, 0.f, 0.f}};
            { const int y = kq ^ l15; const int rowoff = l15 * 512;
              int b4[4];
#pragma unroll
              for (int j = 0; j < 4; ++j) b4[j] = rowoff + (((4 * j) ^ y) * 16);
              const LAS unsigned char* kbase = lds + L_K + si * 8192; const LAS unsigned char* qbase = lds + L_Q + ti0 * 8192;
#pragma unroll
              for (int kk = 0; kk < 8; ++kk) { const int o_ = b4[kk & 3] + (kk >> 2) * 256;
                  const bf16x8 ka = ldfrag(kbase + o_);
                  const bf16x8 q0_ = ldfrag(qbase + o_), q1_ = ldfrag(qbase + 8192 + o_);
                  sa[0] = __builtin_amdgcn_mfma_f32_16x16x32_bf16(ka, q0_, sa[0], 0, 0, 0);
                  sa[1] = __builtin_amdgcn_mfma_f32_16x16x32_bf16(ka, q1_, sa[1], 0, 0, 0); } }
#pragma unroll
            for (int u = 0; u < 2; ++u) { const int ti = ti0 + u, t = 16 * ti + l15, s_ = 16 * si + 4 * kq;
                const float al = S_alpha[t]; const f32x4 bt4 = *(const LAS f32x4*)(S_beta + s_); float pv_[4]; float psum = 0.f;
#pragma unroll
                for (int r = 0; r < 4; ++r) { pv_[r] = (s_ + r <= t) ? sa[u][r] * __expf(al + bt4[r]) : 0.f; psum += pv_[r]; }
                psum = xadd<16>(psum); psum = xadd<32>(psum);
                if (kq == 0) S_psum[si * 64 + t] = psum;
                u32x2 w; w.x = pk2(pv_[0], pv_[1]); w.y = pk2(pv_[2], pv_[3]);
                const int cp = 2 * si + (kq >> 1);
                *(LAS u32x2*)(lds + L_P + t * 128 + ((cp ^ ((t >> 1) & 7)) * 16) + 8 * (kq & 1)) = w; }
#pragma unroll
            for (int r = 0; r < 16; ++r) { num[0][r] = 0.f; num[1][r] = 0.f; }
            { const int yq = hia ^ (r32a & 15); const int rowoff = r32a * 512;
              int b8[8];
#pragma unroll
              for (int g = 0; g < 8; ++g) b8[g] = rowoff + (((2 * g) ^ yq) * 16);
              const LAS unsigned char* qbase = lds + L_Q;
#pragma unroll
              for (int dt = 0; dt < 8; ++dt) { MLS_SB;
#pragma unroll
                  for (int sp = 0; sp < 2; ++sp) { const bf16x8 xb = pack8(X[dt], 8 * sp); const int G_ = 2 * dt + sp; const int o_ = b8[G_ & 7] + (G_ >> 3) * 256;
                      const bf16x8 qa0 = ldfrag(qbase + o_), qa1 = ldfrag(qbase + 16384 + o_);
                      num[0] = __builtin_amdgcn_mfma_f32_32x32x16_bf16(qa0, xb, num[0], 0, 0, 0);
                      num[1] = __builtin_amdgcn_mfma_f32_32x32x16_bf16(qa1, xb, num[1], 0, 0, 0); } } }
            __builtin_amdgcn_sched_barrier(0);
            { int to_ = tid; asm volatile("" : "+v"(to_));
              const int t = to_ >> 3, part = to_ & 7; float accn = 0.f;
#pragma unroll
              for (int i = 0; i < 4; ++i) { const int ch = 4 * part + i; const u32x4 qq = *(const LAS u32x4*)(lds + L_Q + t * 512 + ((ch ^ (t & 15)) * 16));
                  const f32x4 n0 = *(const LAS f32x4*)(nperm + 8 * ch), n1 = *(const LAS f32x4*)(nperm + 8 * ch + 4);
                  accn += bflo(qq.x) * n0[0] + bfhi(qq.x) * n0[1] + bflo(qq.y) * n0[2] + bfhi(qq.y) * n0[3] + bflo(qq.z) * n1[0] + bfhi(qq.z) * n1[1] + bflo(qq.w) * n1[2] + bfhi(qq.w) * n1[3]; }
              accn = xadd<1>(accn); accn = xadd<2>(accn); accn = xadd<4>(accn);
              if (part == 0) S_qn[t] = accn; }
        }
        __syncthreads();
        SEGT(2);
        u32x4 gz[4];
        {
            int lo_ = lane; asm volatile("" : "+v"(lo_));
            const int r32a = lo_ & 31, hia = lo_ >> 5;
            const int e = 32 * wave + r32a;
            const int yk = hia ^ ((r32a >> 1) & 7); const int rowoff = r32a * 128;
            int b4[4];
#pragma unroll
            for (int ks = 0; ks < 4; ++ks) b4[ks] = rowoff + (((2 * ks) ^ yk) * 16);
            bf16x8 vf[4];
#pragma unroll
            for (int ks = 0; ks < 4; ++ks) vf[ks] = ldfrag(lds + L_V + wave * 4096 + b4[ks]);
#pragma unroll
            for (int tt = 0; tt < 2; ++tt) {
#pragma unroll
                for (int g = 0; g < 4; ++g) { const f32x4 iw4 = *(const LAS f32x4*)(S_iw + 32 * tt + 8 * g + 4 * hia);
#pragma unroll
                    for (int q = 0; q < 4; ++q) num[tt][4 * g + q] *= iw4[q]; }
#pragma unroll
                for (int ks = 0; ks < 4; ++ks) { const bf16x8 pa = ldfrag(lds + L_P + tt * 4096 + b4[ks]);
                    num[tt] = __builtin_amdgcn_mfma_f32_32x32x16_bf16(pa, vf[ks], num[tt], 0, 0, 0); }
#pragma unroll
                for (int r = 0; r < 16; ++r) stage[(32 * tt + crow(r, hia)) * SROW + e] = num[tt][r];
            }
            if (c + 1 < SEQ / MCH) MLS_LOAD_SET(SAq, SAk, SAv, c + 1, 0);
#ifndef MLS_GATE_LATE
            { int to2_ = tid; asm volatile("" : "+v"(to2_)); const int t = to2_ >> 3, part = to2_ & 7;
              const u32x4* gp = (const u32x4*)(GM + row0 * 1024 + h * 256 + (t * 1024 + 32 * part));
#pragma unroll
              for (int i = 0; i < 4; ++i) gz[i] = gp[i]; }
#endif
            const float decay = S_misc[0];
#pragma unroll
            for (int dt = 0; dt < 8; ++dt) { MLS_SB;
#pragma unroll
                for (int r = 0; r < 16; ++r) X[dt][r] *= decay;
#pragma unroll
                for (int ks = 0; ks < 4; ++ks) { const bf16x8 ka = ldfrag(lds + L_KW + dt * 4096 + b4[ks]);
                    X[dt] = __builtin_amdgcn_mfma_f32_32x32x16_bf16(ka, vf[ks], X[dt], 0, 0, 0); } }
            __builtin_amdgcn_sched_barrier(0);
            int to_ = tid; asm volatile("" : "+v"(to_));
            if (to_ < 256) { const int d = to_; float s = 0.f;
#pragma unroll
                for (int i = 0; i < 8; ++i) { const u32x4 kk = *(const LAS u32x4*)(lds + L_KW + d * 128 + i * 16);
                    s += (bflo(kk.x) + bfhi(kk.x)) + (bflo(kk.y) + bfhi(kk.y)) + (bflo(kk.z) + bfhi(kk.z)) + (bflo(kk.w) + bfhi(kk.w)); }
                const int p = (d & ~12) | ((d & 4) << 1) | ((d & 8) >> 1);
                nperm[p] = decay * nperm[p] + s; }
        }
        __syncthreads();
        SEGT(3);
        { int te_ = tid; asm volatile("" : "+v"(te_)); const int t = te_ >> 3, part = te_ & 7;
          const float den = S_iw[t] * S_qn[t] + ((S_psum[t] + S_psum[64 + t]) + (S_psum[128 + t] + S_psum[192 + t]));
          const float hd = 1.0f / fmaxf(fabsf(den), S_clamp[t]);
          const LAS f32x4* sp = (const LAS f32x4*)(stage + t * SROW + 32 * part);
          f32x4 v[8]; float s1 = 0.f;
#pragma unroll
          for (int i = 0; i < 8; ++i) { v[i] = sp[i] * hd; s1 += (v[i][0] + v[i][1]) + (v[i][2] + v[i][3]); }
          s1 = xadd<1>(s1); s1 = xadd<2>(s1); s1 = xadd<4>(s1);
          const float mu = s1 * (1.f / 256.f); float s2 = 0.f;
#pragma unroll
          for (int i = 0; i < 8; ++i) { v[i] = v[i] - mu; s2 += (v[i][0] * v[i][0] + v[i][1] * v[i][1]) + (v[i][2] * v[i][2] + v[i][3] * v[i][3]); }
          s2 = xadd<1>(s2); s2 = xadd<2>(s2); s2 = xadd<4>(s2);
          const float rs = 1.0f / sqrtf(s2 * (1.f / 256.f) + EPS);
          const size_t ub = row0 * 1024 + h * 256; const int lo2 = t * 1024 + 32 * part;
#ifdef MLS_GATE_LATE
          { const u32x4* gp = (const u32x4*)(GM + ub + lo2);
#pragma unroll
            for (int i = 0; i < 4; ++i) gz[i] = gp[i]; }
#endif
          u32x4* op = (u32x4*)(HM + ub + lo2); const LAS f32x4* wp = (const LAS f32x4*)(lds + L_MW) + 8 * part;
#pragma unroll
          for (int i = 0; i < 4; ++i) { const u32x4 z = gz[i]; const f32x4 w0 = wp[2 * i], w1 = wp[2 * i + 1]; const f32x4 x0 = v[2 * i] * rs * w0, x1 = v[2 * i + 1] * rs * w1;
              u32x4 w; w.x = pk2(x0[0] * bflo(z.x), x0[1] * bfhi(z.x)); w.y = pk2(x0[2] * bflo(z.y), x0[3] * bfhi(z.y));
              w.z = pk2(x1[0] * bflo(z.z), x1[1] * bfhi(z.z)); w.w = pk2(x1[2] * bflo(z.w), x1[3] * bfhi(z.w)); op[i] = w; } }
        SEGT(4);
    }
    __syncthreads();
#ifdef STAMP_SEG
    *(volatile LAS unsigned long long*)(lds + LDS_BYTES - 32) = seg_acc;
#endif
#undef SEGT
#undef MK
#undef MV
#undef GM
#undef HM
#undef LI
#undef LF
#undef MLS_LOAD_SET
#undef MLS_FILL_SET
#undef MLS_LANE_IDS
}
}

__device__ __forceinline__ void phase3(KArgs a, LAS unsigned char* lds, int WV) {
    const int tid = TID_OF(WV), lane = tid & 63;
    float s1 = a->in[11][lane] * a->in[12][lane], s2 = a->in[13][lane] * a->in[14][lane];
    s1 = wave_sum(s1); s2 = wave_sum(s2);
    if (tid == 0) *(volatile LAS float*)(lds + LDS_BYTES - 48) = expf(s1) - expf(s2) + 0.2f;
    LAS unsigned* slot = (LAS unsigned*)(lds + LDS_BYTES - 64);
#if defined(STAMP_UNIT) || defined(STAMP_ITEM)
    unsigned long long unit_span = 0ull;
#endif
    constexpr unsigned N_M1 = BATCH * MH, N_A1 = BATCH * AH * (SEQ / 128);
    constexpr unsigned N_M = N_M1 * REP_ML, N_AD = N_A1 * (REP_AT - 1), N_A = N_AD + N_A1;
    constexpr unsigned N_P = prep::N_ITEMS;
    const bool t0q = (WV == 0 && lane_id() == 0);
    unsigned nx = 0u;
    if (t0q) nx = __hip_atomic_fetch_add((unsigned*)(a->ws + WS_CTL) + CW_QUEUE, 1u, __ATOMIC_RELAXED, __HIP_MEMORY_SCOPE_AGENT);
    for (;;) {
        if (t0q) *slot = nx;
        __syncthreads();
        unsigned it = *slot;
        __syncthreads();
        if (it >= N_P + N_M + N_A) break;
        if (t0q) nx = __hip_atomic_fetch_add((unsigned*)(a->ws + WS_CTL) + CW_QUEUE, 1u, __ATOMIC_RELAXED, __HIP_MEMORY_SCOPE_AGENT);
#ifdef STAMP_ITEM
        const unsigned it_abs = it; const unsigned long long ti0 = __builtin_amdgcn_s_memrealtime();
#define STAMP_ITEM_END() do { if (it_abs == STAMP_ITEM) unit_span = __builtin_amdgcn_s_memrealtime() - ti0; } while (0)
#else
#define STAMP_ITEM_END() do { } while (0)
#endif
        if (it < N_P) { prep::conv_item(a, WV, (int)it); STAMP_ITEM_END(); continue; }
        it -= N_P;
        if (it < N_M) { const unsigned u = it % N_M1;
#ifdef STAMP_UNIT
            const unsigned long long tu0 = __builtin_amdgcn_s_memrealtime();
#endif
            mls::mlstm_unit(a, lds, WV, (int)(u >> 2), (int)(u & 3));
#ifdef STAMP_UNIT
#ifdef STAMP_SEG
            if (it == STAMP_UNIT) unit_span = *(volatile LAS unsigned long long*)(lds + LDS_BYTES - 32);
#else
            if (it == STAMP_UNIT) unit_span = __builtin_amdgcn_s_memrealtime() - tu0;
#endif
#endif
        }
        else { const unsigned i0 = it - N_M; const bool dummy = i0 < N_AD; const unsigned i = i0 % N_A1; const int qb = 15 - (int)(i >> 7), bh = (int)(i & 127); att::attn_unit(a, lds, WV, bh >> 3, bh & 7, qb, dummy); }
        STAMP_ITEM_END();
    }
#if defined(STAMP_UNIT) || defined(STAMP_ITEM)
    if (unit_span) { const unsigned long long t_end = __builtin_amdgcn_s_memrealtime(); while (__builtin_amdgcn_s_memrealtime() - t_end < unit_span) __builtin_amdgcn_s_sleep(8); }
#endif
}
template <bool COOP>
__global__ void __launch_bounds__(NTHREADS, 2) fwd(Args args) {
    extern __shared__ __attribute__((aligned(16))) unsigned char lds_raw[];
    LAS unsigned char* lds = (LAS unsigned char*)lds_raw;
    const int G = gridDim.x, bx = blockIdx.x;
    const int WV = __builtin_amdgcn_readfirstlane((int)threadIdx.x >> 6);
    const int vcu = (G % 8 == 0) ? (bx % 8) * (G / 8) + bx / 8 : bx;
    const int lo = args.ph_lo, hi = args.ph_hi;
    volatile LAS unsigned* MISC = (volatile LAS unsigned*)(lds + LDS_BYTES - 128);
    if (WV == 0) { const int l_ = lane_id(); if (l_ < 32) MISC[l_] = 0u; }
    __syncthreads();
    XcdBarrier bar; bar.bar = nullptr; bar.x = 0; bar.st = nullptr;
    if constexpr (COOP) bar = xcd_barrier_post((unsigned*)(kargs()->ws + WS_CTL) + CW_BAR, MISC + 8, WV == 0 && lane_id() == 0);
#define IN(k) (lo <= (k) && (k) < hi)
#ifdef STAMP_PHASE
    unsigned long long st_t0 = 0ull, st_t1 = 0ull;
#define STAMP_BEGIN(k) do { if ((k) == STAMP_PHASE) st_t0 = __builtin_amdgcn_s_memrealtime(); } while (0)
#define STAMP_END(k) do { if ((k) == STAMP_PHASE) st_t1 = __builtin_amdgcn_s_memrealtime(); } while (0)
#else
#define STAMP_BEGIN(k) do { } while (0)
#define STAMP_END(k) do { } while (0)
#endif
#ifdef MK_CG_SEAM0
#define SEAM(k) do { if constexpr (COOP) { if (IN(k) && IN((k) + 1)) { if ((k) == 0) cg::this_grid().sync(); else xcd_barrier(bar, WV == 0 && lane_id() == 0); } } } while (0)
#else
#define SEAM(k) do { if constexpr (COOP) { if (IN(k) && IN((k) + 1)) xcd_barrier(bar, WV == 0 && lane_id() == 0); } } while (0)
#endif
    STAMP_BEGIN(0);
    if (IN(0)) for (int rep = 0; rep < REP_P0; ++rep) { phase0(kargs(), lds, vcu, G, WV); __syncthreads(); }
    SEAM(0);
    STAMP_END(0);
    STAMP_BEGIN(1);
    if (IN(1)) for (int rep = 0; rep < REP_P1; ++rep) { phase1(kargs(), lds, vcu, G, WV); __syncthreads(); }
    SEAM(1);
    STAMP_END(1);
    STAMP_BEGIN(2);
    if (IN(2)) {
#pragma unroll 1
        for (int rep = 0; rep < REP_P2; ++rep) {
        const KArgs ka = kargs(); unsigned char* ws_ = ka->ws; float* out_ = ka->out;
        pg8::Gemm g{(const bf16*)(ws_ + WS_HB), (const bf16*)(ws_ + WS_HB), (const bf16*)(ws_ + WS_WIN), MTOK, NPROJ, 1024, 1024, 16};
        pg8::StaticOrder S; S.init(MTOK, NPROJ, G, bx);
        EpiProj E{(bf16*)out_, (bf16*)out_ + (size_t)MTOK * 1024, (bf16*)(ws_ + WS_MV), (bf16*)(ws_ + WS_GM), (bf16*)(ws_ + WS_AQ), (bf16*)(ws_ + WS_AK), (bf16*)(ws_ + WS_AV), (bf16*)(ws_ + WS_AZ), (bf16*)(ws_ + WS_HALO)};
        pg8::gemm_phase<EpiProj, pg8::StaticOrder, true, true>(lds, g, S, E, WV);
        }
    }
    SEAM(2);
    STAMP_END(2);
    STAMP_BEGIN(3);
    if (IN(3)) phase3(kargs(), lds, WV);
    SEAM(3);
    STAMP_END(3);
    STAMP_BEGIN(4);
    if (IN(4)) {
#pragma unroll 1
        for (int rep = 0; rep < REP_P4; ++rep) {
        const KArgs ka = kargs(); unsigned char* ws_ = ka->ws; float* out_ = ka->out; const float* x_ = ka->in[0];
        pg8::Gemm g{(const bf16*)(ws_ + WS_HB), (const bf16*)(ws_ + WS_AQ), (const bf16*)(ws_ + WS_WOUT), MTOK, D, DMIX, 1024, 16};
        pg8::StaticOrder S; S.init(MTOK, D, G, bx);
        EpiOut E{x_, (const float*)(ws_ + WS_MOD), out_, (float*)(ws_ + WS_RSS)};
        pg8::gemm_phase<EpiOut, pg8::StaticOrder, true, true>(lds, g, S, E, WV);
        }
    }
    SEAM(4);
    STAMP_END(4);
    STAMP_BEGIN(5);
    if (IN(5)) phase5(kargs(), vcu, G, WV);
#if REP_P5 > 1
    if (IN(5)) { __syncthreads(); phase5_touch(kargs(), vcu, G, WV); }
#endif
    STAMP_END(5);
#ifdef STAMP_PHASE
    if (blockIdx.x == 0 && WV == 0 && lane_id() == 0) { const unsigned long long t_end = __builtin_amdgcn_s_memrealtime(); while (__builtin_amdgcn_s_memrealtime() - t_end < (st_t1 - st_t0)) __builtin_amdgcn_s_sleep(8); }
#endif
#undef IN
#undef SEAM
}

#ifndef MK_MULTI
#define MK_MULTI 0
#endif
extern "C" void kernel_launch(void* const* d_in, const int* in_sizes, int n_in, void* d_out, int out_size, void* d_ws, size_t ws_size, hipStream_t stream) {
    static int grid = 0;
    if (grid == 0) {
        if (n_in != 19 || out_size != MTOK * D || ws_size < WS_HALO + 8 * MiB) { fprintf(stderr, "kernel_launch: unexpected shapes (n_in %d, out %d, ws %zu)\n", n_in, out_size, ws_size); grid = -1; return; }
        int dev = 0, cus = 0, per_cu = 0;
        (void)hipGetDevice(&dev); (void)hipDeviceGetAttribute(&cus, hipDeviceAttributeMultiprocessorCount, dev);
        (void)hipFuncSetAttribute((const void*)fwd<!MK_MULTI>, hipFuncAttributeMaxDynamicSharedMemorySize, LDS_BYTES);
        (void)hipOccupancyMaxActiveBlocksPerMultiprocessor(&per_cu, (const void*)fwd<!MK_MULTI>, NTHREADS, LDS_BYTES);
        if (per_cu < 1) { fprintf(stderr, "kernel_launch: occupancy query says %d blocks per CU\n", per_cu); per_cu = 1; }
        (void)hipGetLastError();
        grid = cus * (per_cu > 1 ? 1 : per_cu);
    }
    if (grid < 0) return;
    (void)hipMemsetAsync((char*)d_ws + WS_CTL, 0, 1 * MiB, stream);
    Args a{};
    for (int i = 0; i < 19; ++i) a.in[i] = (const float*)d_in[i];
    a.out = (float*)d_out; a.ws = (unsigned char*)d_ws;
#if MK_MULTI
    for (int ph = 0; ph < 6; ++ph) { a.ph_lo = ph; a.ph_hi = ph + 1; hipLaunchKernelGGL(fwd<false>, dim3(grid), dim3(NTHREADS), LDS_BYTES, stream, a); }
#else
    a.ph_lo = 0; a.ph_hi = 6;
    void* kargs[] = {&a};
    hipError_t e = hipLaunchCooperativeKernel((const void*)fwd<true>, dim3(grid), dim3(NTHREADS), kargs, LDS_BYTES, stream);
    if (e != hipSuccess) fprintf(stderr, "cooperative launch failed: %s (grid %d)\n", hipGetErrorString(e), grid);
#endif
}
```

```cpp
#include <hip/hip_runtime.h>
#include <hip/hip_cooperative_groups.h>
#include <cstdio>
#include <cstdint>
#include <cmath>
namespace cg = cooperative_groups;
namespace pg8 {
#define PG8_LAS __attribute__((address_space(3)))
typedef unsigned short bf16_t;
typedef short bf16x8 __attribute__((ext_vector_type(8)));
typedef float f32x4 __attribute__((ext_vector_type(4)));
typedef unsigned u32x4 __attribute__((ext_vector_type(4)));
constexpr int BM = 256, BK = 64, HALF = 128, HTB = HALF * BK * 2  , STAGE_BYTES = 8 * HTB, NXCD = 8, WGM = 8;

__host__ __device__ __forceinline__ int lds_byte(int r, int c) { const int st = (r >> 4) * 2 + (c >> 5), rr = r & 15, cc = c & 31, ob = rr * 64 + cc * 2; return st * 1024 + (ob ^ (((ob >> 9) & 1) << 5)); }
__host__ __device__ __forceinline__ void stage_rc(int b, int& R, int& C) { const int st = b / 1024, sb = b % 1024, swz = sb ^ (((sb >> 9) & 1) << 5); R = (st >> 1) * 16 + swz / 64; C = (st & 1) * 32 + (swz % 64) / 2; }
__host__ __device__ __forceinline__ int perm32(int rho) { const int n = rho >> 4, i = rho & 15; return 8 * (i >> 2) + 4 * n + (i & 3); }

struct Unit { int pm, pn; };
struct Gemm { const bf16_t* A; const bf16_t* A2; const bf16_t* Bt; int M, N, K, lda, nt1; };

struct StaticOrder {
    int nM, nN, nwg, G, c;
    __host__ __device__ void init(int M, int N, int G_, int c_) { nM = M / BM; nN = N / BM; nwg = nM * nN; G = G_; c = c_; }
    __host__ __device__ bool next(int i, Unit& u) const {
        const long L = (long)i * G + c; if (L >= nwg) return false;
        int wgid = (int)L; { const int q = nwg / NXCD, r = nwg % NXCD, xcd = wgid % NXCD, off = wgid / NXCD; wgid = (xcd < r ? xcd * (q + 1) : r * (q + 1) + (xcd - r) * q) + off; }
        const int nig = WGM * nN, gid = wgid / nig, fm = gid * WGM, gsz = (nM - fm) < WGM ? (nM - fm) : WGM;
        u.pm = fm + ((wgid % nig) % gsz); u.pn = (wgid % nig) / gsz; return true;
    }
    __device__ __forceinline__ void a_ready(const Unit&) const {}
    __device__ __forceinline__ void done(const Unit&) const {}
};

__device__ __forceinline__ unsigned cvt_pk_bf16(float lo, float hi) { unsigned r; asm volatile("v_cvt_pk_bf16_f32 %0, %1, %2" : "=v"(r) : "v"(lo), "v"(hi)); return r; }
template <class Epi, class Sched, bool ALIGN_EPI = false, bool SP2 = false>
__device__ __forceinline__ void gemm_phase(PG8_LAS unsigned char* lds, const Gemm g, const Sched& S, const Epi& E, const int wid) {
    const int lane = (int)__builtin_amdgcn_mbcnt_hi(~0u, __builtin_amdgcn_mbcnt_lo(~0u, 0u)), tid = wid * 64 + lane, wr = wid >> 2, wc = wid & 3, fr = lane & 15, fq = lane >> 4;
    const int K = g.K, nt = K / BK;
    unsigned voffA[2], voffB[2];
#pragma unroll
    for (int i = 0; i < 2; ++i) { int R, C; stage_rc(tid * 16 + i * 8192, R, C); const int Rb = Epi::PERM ? ((R & ~31) + perm32(R & 31)) : R;
        voffA[i] = (unsigned)(R * g.lda + C) * 2u; voffB[i] = (unsigned)(Rb * K + C) * 2u; }
    const size_t kstep = (size_t)(BK * 2);
    const size_t hstep = (size_t)HALF * K * 2;
    const size_t tstep = 2 * hstep;
    const size_t hstepA = (size_t)HALF * g.lda * 2, tstepA = 2 * hstepA; const int nt1 = g.nt1;
#define PG8_AP(b1, b2, t) ((t) < nt1 ? (b1) + (size_t)(t) * kstep : (b2) + (size_t)((t) - nt1) * kstep)
    const unsigned ldsw = (unsigned)wid * 1024u;
    const int aoff = lds_byte(wr * 64 + fr, fq * 8), boff = lds_byte(wc * 32 + fr, fq * 8);
#define PG8_SA(b, h) (((b) * 2 + (h)) * HTB)
#define PG8_SB(b, h) ((4 + (b) * 2 + (h)) * HTB)
#define PG8_STAGE(bufoff, gbase, voff) do { _Pragma("unroll") for (int _i = 0; _i < 2; ++_i) \
        __builtin_amdgcn_global_load_lds((const unsigned*)((const char*)(gbase) + (voff)[_i]), (PG8_LAS unsigned*)(lds + (bufoff) + ldsw + _i * 8192), 16, 0, 0); } while (0)
#define PG8_LDA(dst, b, h) do { _Pragma("unroll") for (int m = 0; m < 4; ++m) _Pragma("unroll") for (int k = 0; k < 2; ++k) dst[m][k] = *(const PG8_LAS bf16x8*)(lds + PG8_SA(b, h) + aoff + m * 2048 + k * 1024); } while (0)
#define PG8_LDB(dst, b, h) do { _Pragma("unroll") for (int n = 0; n < 2; ++n) _Pragma("unroll") for (int k = 0; k < 2; ++k) dst[n][k] = *(const PG8_LAS bf16x8*)(lds + PG8_SB(b, h) + boff + n * 2048 + k * 1024); } while (0)
#define PG8_MMA(ai, bj, At, Bt) do { __builtin_amdgcn_s_setprio(1); _Pragma("unroll") for (int m = 0; m < 4; ++m) _Pragma("unroll") for (int n = 0; n < 2; ++n) _Pragma("unroll") for (int k = 0; k < 2; ++k) \
        acc[ai][bj][m][n] = __builtin_amdgcn_mfma_f32_16x16x32_bf16(Bt[n][k], At[m][k], acc[ai][bj][m][n], 0, 0, 0); __builtin_amdgcn_s_setprio(0); } while (0)
#define PG8_WAIT_V(n) asm volatile("s_waitcnt vmcnt(" #n ")" ::: "memory")
#define PG8_WAIT_L(n) asm volatile("s_waitcnt lgkmcnt(" #n ")" ::: "memory")
#define PG8_BAR __builtin_amdgcn_s_barrier()
#define PG8_SCHED __builtin_amdgcn_sched_barrier(0)
    Unit cur, nxt; int ui = 0;
    if (!S.next(0, cur)) return;
    f32x4 acc[2][2][4][2];
#pragma unroll
    for (int a = 0; a < 2; ++a)
#pragma unroll
        for (int b = 0; b < 2; ++b)
#pragma unroll
            for (int m = 0; m < 4; ++m)
#pragma unroll
                for (int n = 0; n < 2; ++n) acc[a][b][m][n] = (f32x4){0.f, 0.f, 0.f, 0.f};
    bf16x8 At[4][2], B0[2][2], B1[2][2];
    const char* cA = (const char*)g.A + (size_t)cur.pm * tstepA; const char* cA2 = (const char*)g.A2 + (size_t)cur.pm * tstepA; const char* cB = (const char*)g.Bt + (size_t)cur.pn * tstep;
    S.a_ready(cur);
    if constexpr (SP2) {
        PG8_STAGE(PG8_SB(0, 0), cB, voffB); PG8_STAGE(PG8_SB(0, 1), cB + hstep, voffB); PG8_STAGE(PG8_SA(0, 0), cA, voffA); PG8_STAGE(PG8_SA(0, 1), cA + hstepA, voffA);
        if (wr == 1) PG8_BAR;
        PG8_WAIT_V(2); PG8_BAR;
        PG8_STAGE(PG8_SB(1, 0), cB + kstep, voffB); PG8_STAGE(PG8_SA(1, 0), cA + kstep, voffA); PG8_STAGE(PG8_SB(1, 1), cB + hstep + kstep, voffB);
        PG8_WAIT_V(6); PG8_BAR;
    } else {
        PG8_STAGE(PG8_SB(0, 0), cB, voffB); PG8_STAGE(PG8_SA(0, 0), cA, voffA); PG8_STAGE(PG8_SB(0, 1), cB + hstep, voffB); PG8_STAGE(PG8_SA(0, 1), cA + hstepA, voffA);
        if (wr == 1) PG8_BAR;
        PG8_WAIT_V(4); PG8_BAR;
        PG8_STAGE(PG8_SB(1, 0), cB + kstep, voffB); PG8_STAGE(PG8_SA(1, 0), cA + kstep, voffA); PG8_STAGE(PG8_SB(1, 1), cB + hstep + kstep, voffB);
        PG8_WAIT_V(6); PG8_BAR;
    }
    for (;;) {
        const bool has_next = S.next(ui + 1, nxt);
        const char* nA = has_next ? (const char*)g.A + (size_t)nxt.pm * tstepA : cA; const char* nA2 = has_next ? (const char*)g.A2 + (size_t)nxt.pm * tstepA : cA2; const char* nB = has_next ? (const char*)g.Bt + (size_t)nxt.pn * tstep : cB;
        for (int t = 0; t < nt; t += 2) {
            const bool last = (t == nt - 2);
            const char* a1 = PG8_AP(cA, cA2, t + 1);
            const char* a2 = last ? nA : PG8_AP(cA, cA2, t + 2); const char* b2 = last ? nB : cB + (size_t)(t + 2) * kstep;
            const char* a3 = last ? nA + kstep : PG8_AP(cA, cA2, t + 3); const char* b3 = b2 + kstep;
            if (last && has_next) S.a_ready(nxt);
            if constexpr (SP2) {
            PG8_LDB(B0, 0, 0); PG8_LDB(B1, 0, 1); PG8_SCHED; PG8_LDA(At, 0, 0); PG8_STAGE(PG8_SA(1, 1), a1 + hstepA, voffA);
            PG8_WAIT_V(8); PG8_WAIT_L(0); PG8_BAR; PG8_MMA(0, 0, At, B0); PG8_MMA(0, 1, At, B1); PG8_BAR; PG8_SCHED;
            PG8_LDA(At, 0, 1); PG8_STAGE(PG8_SB(0, 0), b2, voffB); PG8_STAGE(PG8_SB(0, 1), b2 + hstep, voffB); PG8_STAGE(PG8_SA(0, 0), a2, voffA);
            PG8_WAIT_V(8); PG8_WAIT_L(0); PG8_BAR; PG8_MMA(1, 0, At, B0); PG8_MMA(1, 1, At, B1); PG8_BAR; PG8_SCHED;
            PG8_LDB(B0, 1, 0); PG8_LDB(B1, 1, 1); PG8_SCHED; PG8_LDA(At, 1, 0); PG8_STAGE(PG8_SA(0, 1), a2 + hstepA, voffA);
            PG8_WAIT_V(8); PG8_WAIT_L(0); PG8_BAR; PG8_MMA(0, 0, At, B0); PG8_MMA(0, 1, At, B1); PG8_BAR; PG8_SCHED;
            PG8_LDA(At, 1, 1); PG8_STAGE(PG8_SB(1, 0), b3, voffB); PG8_STAGE(PG8_SB(1, 1), b3 + hstep, voffB); PG8_STAGE(PG8_SA(1, 0), a3, voffA);
            PG8_WAIT_V(8); PG8_WAIT_L(0); PG8_BAR; PG8_MMA(1, 0, At, B0); PG8_MMA(1, 1, At, B1); PG8_BAR; PG8_SCHED;
            } else {
            PG8_LDB(B0, 0, 0); PG8_SCHED; PG8_LDA(At, 0, 0); PG8_STAGE(PG8_SA(1, 1), a1 + hstepA, voffA);
            PG8_WAIT_L(8); PG8_BAR; PG8_WAIT_L(0); PG8_MMA(0, 0, At, B0); PG8_BAR; PG8_SCHED;
            PG8_LDB(B1, 0, 1); PG8_STAGE(PG8_SB(0, 0), b2, voffB);
            PG8_BAR; PG8_WAIT_L(0); PG8_MMA(0, 1, At, B1); PG8_BAR;
            PG8_LDA(At, 0, 1); PG8_STAGE(PG8_SA(0, 0), a2, voffA);
            PG8_BAR; PG8_WAIT_L(0); PG8_MMA(1, 0, At, B0); PG8_BAR; PG8_SCHED;
            PG8_STAGE(PG8_SB(0, 1), b2 + hstep, voffB);
            PG8_WAIT_V(6); PG8_BAR; PG8_MMA(1, 1, At, B1); PG8_BAR;
            PG8_LDB(B0, 1, 0); PG8_SCHED; PG8_LDA(At, 1, 0); PG8_STAGE(PG8_SA(0, 1), a2 + hstepA, voffA);
            PG8_WAIT_L(8); PG8_BAR; PG8_WAIT_L(0); PG8_MMA(0, 0, At, B0); PG8_BAR; PG8_SCHED;
            PG8_LDB(B1, 1, 1); PG8_STAGE(PG8_SB(1, 0), b3, voffB);
            PG8_BAR; PG8_WAIT_L(0); PG8_MMA(0, 1, At, B1); PG8_BAR;
            PG8_LDA(At, 1, 1); PG8_STAGE(PG8_SA(1, 0), a3, voffA);
            PG8_BAR; PG8_WAIT_L(0); PG8_MMA(1, 0, At, B0); PG8_BAR; PG8_SCHED;
            PG8_STAGE(PG8_SB(1, 1), b3 + hstep, voffB);
            PG8_WAIT_V(6); PG8_BAR; PG8_MMA(1, 1, At, B1); PG8_BAR;
            }
        }
        if constexpr (ALIGN_EPI) { if (wr == 0) PG8_BAR; }
        if constexpr (!Epi::AFTER_DRAIN) { E(acc, cur, wr, wc, fr, fq); S.done(cur); }
        if (!has_next) break;
#pragma unroll
        for (int a = 0; a < 2; ++a)
#pragma unroll
            for (int b = 0; b < 2; ++b)
#pragma unroll
                for (int m = 0; m < 4; ++m)
#pragma unroll
                    for (int n = 0; n < 2; ++n) acc[a][b][m][n] = (f32x4){0.f, 0.f, 0.f, 0.f};
        cur = nxt; cA = nA; cA2 = nA2; cB = nB; ++ui;
        if constexpr (ALIGN_EPI) { if (wr == 1) PG8_BAR; }
    }
    PG8_WAIT_V(0);
    if constexpr (!ALIGN_EPI) { if (wr == 0) PG8_BAR; }
    PG8_BAR;
    if constexpr (Epi::AFTER_DRAIN) { E.fused(acc, cur, wr, wc, fr, fq, lds, wid, lane); S.done(cur); }
#undef PG8_AP
#undef PG8_SA
#undef PG8_SB
#undef PG8_STAGE
#undef PG8_LDA
#undef PG8_LDB
#undef PG8_MMA
#undef PG8_WAIT_V
#undef PG8_WAIT_L
#undef PG8_BAR
#undef PG8_SCHED
}
}
#ifndef REP_P0
#define REP_P0 1
#endif
#ifndef REP_P5
#define REP_P5 1
#endif
#ifndef REP_P1
#define REP_P1 1
#endif
#ifndef REP_P2
#define REP_P2 1
#endif
#ifndef REP_ML
#define REP_ML 1
#endif
#ifndef REP_AT
#define REP_AT 1
#endif
#ifndef REP_P4
#define REP_P4 1
#endif
constexpr int NWAVES = 8, NTHREADS = 512;
constexpr int D = 1024, BATCH = 16, SEQ = 2048, MTOK = BATCH * SEQ, DIN = 9224, NPROJ = 9216, DMIX = 2048;
constexpr int MH = 4, MHD = 256, AH = 8, AVD = 128, AQK = 64, MCH = 64;
constexpr int C_MQ = 0, C_MK = 1024, C_MV = 2048, C_MO = 3072, C_MZ = 4096, C_MI = 5120, C_MF = 5124, C_AQ = 5128, C_AK = 6152, C_AV = 7176, C_AZ = 8200;
constexpr float EPS = 1e-6f, LOG2E = 1.4426950408889634f;
constexpr float QSCALE = 0.125f * LOG2E;
constexpr size_t MiB = 1u << 20;
constexpr size_t WS_CTL = 0;
constexpr size_t WS_MOD = 1 * MiB;
constexpr size_t WS_LI = 2 * MiB;
constexpr size_t WS_LF = 2 * MiB + 512 * 1024;
constexpr size_t WS_RSS = 4 * MiB;
constexpr size_t WS_WIN = 8 * MiB;
constexpr size_t WS_WOUT = 26 * MiB;
constexpr size_t WS_HB = 32 * MiB;
constexpr size_t WS_MV = 96 * MiB;
constexpr size_t WS_GM = 160 * MiB;
constexpr size_t WS_AQ = 224 * MiB;
constexpr size_t WS_AK = 288 * MiB;
constexpr size_t WS_AV = 352 * MiB;
constexpr size_t WS_AZ = 416 * MiB;
constexpr size_t WS_END = 480 * MiB;
constexpr size_t WS_HALO = 480 * MiB;
constexpr size_t WS_DUMMY = 496 * MiB;
constexpr int CW_QUEUE = 64;
constexpr int CW_QATT = 1024;
constexpr int CW_PREP = 128;
constexpr int LDS_BYTES = 155648;

#define LAS __attribute__((address_space(3)))
typedef unsigned short bf16;
typedef float f32x4 __attribute__((ext_vector_type(4)));
typedef float f32x16 __attribute__((ext_vector_type(16)));
typedef float f32x2 __attribute__((ext_vector_type(2)));
typedef short bf16x8 __attribute__((ext_vector_type(8)));
typedef short s16x4 __attribute__((ext_vector_type(4)));
typedef unsigned u32x4 __attribute__((ext_vector_type(4)));
typedef unsigned u32x2 __attribute__((ext_vector_type(2)));
typedef __bf16 bf16x2_t __attribute__((ext_vector_type(2)));

__device__ __forceinline__ unsigned pk2(float lo, float hi) { f32x2 v = {lo, hi}; bf16x2_t b = __builtin_convertvector(v, bf16x2_t); return __builtin_bit_cast(unsigned, b); }
__device__ __forceinline__ float bflo(unsigned u) { return __uint_as_float(u << 16); }
__device__ __forceinline__ float bfhi(unsigned u) { return __uint_as_float(u & 0xffff0000u); }
__device__ __forceinline__ float siluf(float x) { return x * __builtin_amdgcn_rcpf(1.f + __expf(-x)); }
__device__ __forceinline__ float sigmf(float x) { return __builtin_amdgcn_rcpf(1.f + __expf(-x)); }
__device__ __forceinline__ int lane_id() { int l; asm volatile("v_mbcnt_lo_u32_b32 %0, -1, 0\n\tv_mbcnt_hi_u32_b32 %0, -1, %0" : "=v"(l)); return l; }
#define TID_OF(wv) ((wv) * 64 + lane_id())
template <int M> __device__ __forceinline__ float xadd(float v) {
    if constexpr (M == 32) { auto rr = __builtin_amdgcn_permlane32_swap(__float_as_uint(v), __float_as_uint(v), false, false); return __uint_as_float(rr[0]) + __uint_as_float(rr[1]); }
    else return v + __uint_as_float((unsigned)__builtin_amdgcn_ds_swizzle((int)__float_as_uint(v), (M << 10) | 0x1f));
}
template <int M> __device__ __forceinline__ float xswz(float v) {
    return __uint_as_float((unsigned)__builtin_amdgcn_ds_swizzle((int)__float_as_uint(v), (M << 10) | 0x1f));
}
__device__ __forceinline__ float wave_sum(float v) { v = xadd<1>(v); v = xadd<2>(v); v = xadd<4>(v); v = xadd<8>(v); v = xadd<16>(v); v = xadd<32>(v); return v; }

struct Args { const float* in[19]; float* out; unsigned char* ws; int ph_lo, ph_hi; };
typedef const __attribute__((address_space(4))) Args* KArgs;
__device__ __forceinline__ KArgs kargs() { KArgs p = (KArgs)__builtin_amdgcn_kernarg_segment_ptr(); asm volatile("" : "+s"(p)); return p; }

__device__ __forceinline__ int win_src_col(int n) {
    if (n < 3072) return n;
    if (n < 5120) { const int g = (n - 3072) >> 8, r = (n - 3072) & 255; return (r < 128) ? C_MO + 128 * g + r : C_MZ + 128 * g + (r - 128); }
    return n + 8;
}
__device__ __forceinline__ void p0_transpose_item(const float* W, int ldw, int K, bf16* WT, int k0, int n0, int sc0, LAS float* scr, int lane) {
#pragma unroll
    for (int i = 0; i < 32; ++i) { const int kk = 2 * i + (lane >> 5); scr[kk * 33 + (lane & 31)] = W[(size_t)(k0 + kk) * ldw + sc0 + (lane & 31)]; }
    asm volatile("s_waitcnt lgkmcnt(0)" ::: "memory");
    const int c = lane & 7;
#pragma unroll
    for (int j = 0; j < 4; ++j) { const int n = (lane >> 3) + 8 * j; const LAS float* s = scr + (8 * c) * 33 + n;
        u32x4 o; o.x = pk2(s[0 * 33], s[1 * 33]); o.y = pk2(s[2 * 33], s[3 * 33]); o.z = pk2(s[4 * 33], s[5 * 33]); o.w = pk2(s[6 * 33], s[7 * 33]);
        *(u32x4*)(WT + (size_t)(n0 + n) * K + k0 + 8 * c) = o; }
    asm volatile("s_waitcnt lgkmcnt(0)" ::: "memory");
}
__device__ __forceinline__ void phase0(KArgs a, LAS unsigned char* lds, int vcu, int G, int WV) {
    const int tid = TID_OF(WV), lane = tid & 63, wave = WV;
    const float* c = a->in[1]; const float* w_ada = a->in[3]; const float* b_ada = a->in[4];
    float* mod = (float*)(a->ws + WS_MOD);
    if (blockIdx.x == 0 && tid == 0) ((unsigned*)(a->ws + WS_CTL))[CW_QUEUE] = 0u;
    for (int cgp = vcu; cgp < 256; cgp += G) {
        const int b = tid >> 5, part = tid & 31, j0 = 12 * cgp;
        float acc[12];
#pragma unroll
        for (int j = 0; j < 12; ++j) acc[j] = 0.f;
#pragma unroll 8
        for (int ii = 0; ii < 32; ++ii) { const int i = part + 32 * ii;
            const float s = c[b * 1024 + i]; const float sv = s / (1.f + expf(-s));
            const f32x4* wr = (const f32x4*)(w_ada + (size_t)i * 3072 + j0);
            const f32x4 w0 = wr[0], w1 = wr[1], w2 = wr[2];
            acc[0] += sv * w0[0]; acc[1] += sv * w0[1]; acc[2] += sv * w0[2]; acc[3] += sv * w0[3];
            acc[4] += sv * w1[0]; acc[5] += sv * w1[1]; acc[6] += sv * w1[2]; acc[7] += sv * w1[3];
            acc[8] += sv * w2[0]; acc[9] += sv * w2[1]; acc[10] += sv * w2[2]; acc[11] += sv * w2[3]; }
#pragma unroll
        for (int j = 0; j < 12; ++j) { float v = acc[j];
            v = xadd<1>(v); v = xadd<2>(v); v = xadd<4>(v); v = xadd<8>(v); v = xadd<16>(v);
            if (part == 0) mod[b * 3072 + j0 + j] = v + b_ada[j0 + j]; }
    }
}

__device__ __forceinline__ void weight_copies(KArgs a, LAS float* scr, int vcu, int G, int wave, int lane) {
    const int gw = vcu * NWAVES + wave, NGW = G * NWAVES;
    constexpr int I_IN = (1024 / 64) * (NPROJ / 32), I_OUT = (2048 / 64) * (1024 / 32);
    bf16* WinT = (bf16*)(a->ws + WS_WIN); bf16* WoutT = (bf16*)(a->ws + WS_WOUT);
    for (int it = gw; it < I_IN + I_OUT; it += NGW) {
        if (it < I_IN) { const int nb = it % (NPROJ / 32), kb = it / (NPROJ / 32); p0_transpose_item(a->in[5], DIN, 1024, WinT, 64 * kb, 32 * nb, win_src_col(32 * nb), scr, lane); }
        else { const int r = it - I_IN, nb = r % 32, kb = r / 32; p0_transpose_item(a->in[17], 1024, 2048, WoutT, 64 * kb, 32 * nb, 32 * nb, scr, lane); }
    }
}

__device__ __forceinline__ void phase1(KArgs a, LAS unsigned char* lds, int vcu, int G, int WV) {
    const int tid = TID_OF(WV), lane = tid & 63, wave = WV;
    const float* x = a->in[0]; const float* norm_w = a->in[2]; const float* w_in = a->in[5]; const float* b_i = a->in[6]; const float* b_f = a->in[7];
    const float* mod = (const float*)(a->ws + WS_MOD);
    bf16* HB = (bf16*)(a->ws + WS_HB); float* LI = (float*)(a->ws + WS_LI); float* LF = (float*)(a->ws + WS_LF);
    LAS float* wg = (LAS float*)lds;
#pragma unroll
    for (int i = tid; i < 1024 * 8; i += NTHREADS) { const int k = i >> 3, q = i & 7;
        wg[(((((k >> 8) * 4 + (k & 3)) * 2 + (q >> 2)) * 64 + ((k & 255) >> 2)) * 4) + (q & 3)] = w_in[(size_t)k * DIN + C_MI + q]; }
    weight_copies(a, (LAS float*)(lds + 32768 + wave * 8448), vcu, G, wave, lane);
    __syncthreads();
    const int gw = vcu * NWAVES + wave, NGW = G * NWAVES;
    for (int grp = gw; grp < MTOK / 16; grp += NGW) {
        const int row0 = grp * 16, b = row0 / SEQ;
        f32x4 am[4], sh[4];
#pragma unroll
        for (int j = 0; j < 4; ++j) { const int col = 4 * lane + 256 * j;
            const f32x4 nw = *(const f32x4*)(norm_w + col), sc = *(const f32x4*)(mod + b * 3072 + 1024 + col);
            am[j] = nw * (sc + 1.0f); sh[j] = *(const f32x4*)(mod + b * 3072 + col); }
        f32x4 vn[4];
        { const f32x4* xr = (const f32x4*)(x + (size_t)row0 * D) + lane;
#pragma unroll
          for (int j = 0; j < 4; ++j) vn[j] = xr[64 * j]; }
        for (int r = 0; r < 16; ++r) { const int row = row0 + r;
            LAS float* wgr = wg; asm volatile("" : "+v"(wgr));
            f32x4 v[4]; float s = 0.f;
#pragma unroll
            for (int j = 0; j < 4; ++j) { v[j] = vn[j]; s += (v[j][0] * v[j][0] + v[j][1] * v[j][1]) + (v[j][2] * v[j][2] + v[j][3] * v[j][3]); }
            if (r < 15) { const f32x4* xr = (const f32x4*)(x + (size_t)(row + 1) * D) + lane;
#pragma unroll
                for (int j = 0; j < 4; ++j) vn[j] = xr[64 * j]; }
            const float rstd = 1.0f / sqrtf(wave_sum(s) * (1.f / D) + EPS);
            float g8[8];
#pragma unroll
            for (int q = 0; q < 8; ++q) g8[q] = 0.f;
            u32x2* o8 = (u32x2*)(HB + (size_t)row * D) + lane;
#pragma unroll
            for (int j = 0; j < 4; ++j) { const f32x4 hv = v[j] * rstd * am[j] + sh[j];
                u32x2 w; w.x = pk2(hv[0], hv[1]); w.y = pk2(hv[2], hv[3]); o8[64 * j] = w;
#pragma unroll
                for (int e = 0; e < 4; ++e) {
                    const f32x4 w0 = *(const LAS f32x4*)(wgr + ((((j * 4 + e) * 2 + 0) * 64 + lane) * 4)), w1 = *(const LAS f32x4*)(wgr + ((((j * 4 + e) * 2 + 1) * 64 + lane) * 4));
                    g8[0] += hv[e] * w0[0]; g8[1] += hv[e] * w0[1]; g8[2] += hv[e] * w0[2]; g8[3] += hv[e] * w0[3];
                    g8[4] += hv[e] * w1[0]; g8[5] += hv[e] * w1[1]; g8[6] += hv[e] * w1[2]; g8[7] += hv[e] * w1[3]; } }
            { const bool b0 = lane & 1, b1 = lane & 2, b2 = lane & 4;
              float h4[4], h2[2], m1;
#pragma unroll
              for (int q = 0; q < 4; ++q) { const float keep = b0 ? g8[4 + q] : g8[q], send = b0 ? g8[q] : g8[4 + q]; h4[q] = keep + xswz<1>(send); }
#pragma unroll
              for (int q = 0; q < 2; ++q) { const float keep = b1 ? h4[2 + q] : h4[q], send = b1 ? h4[q] : h4[2 + q]; h2[q] = keep + xswz<2>(send); }
              { const float keep = b2 ? h2[1] : h2[0], send = b2 ? h2[0] : h2[1]; m1 = keep + xswz<4>(send); }
              m1 = xadd<8>(m1); m1 = xadd<16>(m1); m1 = xadd<32>(m1);
              const int gq = ((lane & 1) << 2) | (lane & 2) | ((lane >> 2) & 1); const bool isf = gq >= 4; const int gi = gq & 3;
              const float xf = m1 + (isf ? b_f[gi] : b_i[gi]);
              const float outv = isf ? (fminf(xf, 0.f) - log1pf(expf(-fabsf(xf)))) : xf;
              if (lane < 8) (isf ? LF : LI)[(size_t)row * 4 + gi] = outv; }
        }
    }
}

struct EpiProj {
    static constexpr bool PERM = true, AFTER_DRAIN = false;
    bf16 *MQ, *MK, *MV, *GM, *AQ, *AK, *AV, *AZ, *HALO;
    __device__ __forceinline__ void operator()(const pg8::f32x4 (&acc)[2][2][4][2], const pg8::Unit& u, int wr, int wc, int fr, int fq) const {
        const int pn = u.pn; const int row0 = u.pm * 256 + wr * 64 + fr;
        if (pn >= 12 && pn < 20) {
            const int col = 128 * (pn - 12) + wc * 32 + 8 * fq;
#pragma unroll
            for (int ai = 0; ai < 2; ++ai)
#pragma unroll
                for (int m = 0; m < 4; ++m) { bf16* p = GM + (size_t)(row0 + ai * 128 + m * 16) * 1024 + col;
                    float g[8];
#pragma unroll
                    for (int n = 0; n < 2; ++n)
#pragma unroll
                        for (int e = 0; e < 4; ++e) { const float o = acc[ai][0][m][n][e], z = acc[ai][1][m][n][e]; g[4 * n + e] = z * __builtin_amdgcn_rcpf((1.f + __expf(-o)) * (1.f + __expf(-z))); }
                    u32x4 w; w.x = pk2(g[0], g[1]); w.y = pk2(g[2], g[3]); w.z = pk2(g[4], g[5]); w.w = pk2(g[6], g[7]);
                    *(u32x4*)p = w; }
            return;
        }
        bf16* base; float sc = 1.f; int act = 0; int ct;
        if (pn < 4) { base = MQ; ct = pn; } else if (pn < 8) { base = MK; ct = pn - 4; } else if (pn < 12) { base = MV; ct = pn - 8; }
        else if (pn < 24) { base = AQ; ct = pn - 20; sc = QSCALE; } else if (pn < 28) { base = AK; ct = pn - 24; } else if (pn < 32) { base = AV; ct = pn - 28; }
        else { base = AZ; ct = pn - 32; act = 1; }
        const int col0 = ct * 256 + wc * 32 + 8 * fq;
#pragma unroll
        for (int ai = 0; ai < 2; ++ai)
#pragma unroll
            for (int m = 0; m < 4; ++m) { bf16* rowp = base + (size_t)(row0 + ai * 128 + m * 16) * 1024 + col0;
#pragma unroll
                for (int bj = 0; bj < 2; ++bj) { pg8::f32x4 v0 = acc[ai][bj][m][0], v1 = acc[ai][bj][m][1];
                    if (act) { v0 = (pg8::f32x4){siluf(v0[0]), siluf(v0[1]), siluf(v0[2]), siluf(v0[3])}; v1 = (pg8::f32x4){siluf(v1[0]), siluf(v1[1]), siluf(v1[2]), siluf(v1[3])}; }
                    v0 = v0 * sc; v1 = v1 * sc;
                    u32x4 w; w.x = pk2(v0[0], v0[1]); w.y = pk2(v0[2], v0[3]); w.z = pk2(v1[0], v1[1]); w.w = pk2(v1[2], v1[3]);
                    *(u32x4*)(rowp + bj * 128) = w;
                    if (pn < 8) { const int row = row0 + ai * 128 + m * 16;
                        if ((row & 63) >= 61) *(u32x4*)(HALO + ((size_t)((pn >> 2) * 512 + (row >> 6)) * 3 + ((row & 63) - 61)) * 1024 + col0 + bj * 128) = w; } } }
    }
};
struct EpiOut {
    static constexpr bool PERM = false, AFTER_DRAIN = false;
    const float* x; const float* mod; float* out; float* rss;
    __device__ __forceinline__ void operator()(const pg8::f32x4 (&acc)[2][2][4][2], const pg8::Unit& u, int wr, int wc, int fr, int fq) const {
        const int col0 = u.pn * 256 + wc * 32 + 4 * fq; const int b = (u.pm * 256) / SEQ;
        pg8::f32x4 gv[2][2];
#pragma unroll
        for (int bj = 0; bj < 2; ++bj)
#pragma unroll
            for (int n = 0; n < 2; ++n) gv[bj][n] = *(const pg8::f32x4*)(mod + b * 3072 + 2048 + col0 + bj * 128 + n * 16);
#pragma unroll
        for (int ai = 0; ai < 2; ++ai)
#pragma unroll
            for (int m = 0; m < 4; ++m) { const int row = u.pm * 256 + ai * 128 + wr * 64 + m * 16 + fr; const size_t off = (size_t)row * D + col0; float ss = 0.f;
#pragma unroll
                for (int bj = 0; bj < 2; ++bj)
#pragma unroll
                    for (int n = 0; n < 2; ++n) { const pg8::f32x4 xv = *(const pg8::f32x4*)(x + off + bj * 128 + n * 16);
                        const pg8::f32x4 o = xv + gv[bj][n] * acc[ai][bj][m][n];
                        ss += (o[0] * o[0] + o[1] * o[1]) + (o[2] * o[2] + o[3] * o[3]);
                        *(pg8::f32x4*)(out + off + bj * 128 + n * 16) = o; }
                ss = xadd<16>(ss); ss = xadd<32>(ss);
                if (fq == 0) rss[(size_t)row * 16 + u.pn * 4 + wc] = ss; }
    }
};

__device__ __forceinline__ void phase5(KArgs a, int vcu, int G, int WV) {
    const int tid = TID_OF(WV), lane = tid & 63, wave = WV;
    const float* fnw = a->in[18]; const float* rss = (const float*)(a->ws + WS_RSS); float* out = a->out;
    f32x4 fw[4];
#pragma unroll
    for (int j = 0; j < 4; ++j) fw[j] = *(const f32x4*)(fnw + 4 * lane + 256 * j);
    const int gw = vcu * NWAVES + wave, NGW = G * NWAVES;
    for (int grp = gw; grp < MTOK / 16; grp += NGW)
        for (int r = 0; r < 16; ++r) { const int row = grp * 16 + r;
            const f32x4* pr = (const f32x4*)(rss + (size_t)row * 16);
            const f32x4 p0 = pr[0], p1 = pr[1], p2 = pr[2], p3 = pr[3];
            const float tot = (((p0[0] + p0[1]) + (p0[2] + p0[3])) + ((p1[0] + p1[1]) + (p1[2] + p1[3]))) + (((p2[0] + p2[1]) + (p2[2] + p2[3])) + ((p3[0] + p3[1]) + (p3[2] + p3[3])));
            const float rstd = 1.0f / sqrtf(tot * (1.f / D) + EPS);
            f32x4* o = (f32x4*)(out + (size_t)row * D) + lane;
#pragma unroll
            for (int j = 0; j < 4; ++j) o[64 * j] = o[64 * j] * rstd * fw[j]; }
}

__device__ __forceinline__ void phase5_touch(KArgs a, int vcu, int G, int WV) {
    const int tid = TID_OF(WV), lane = tid & 63, wave = WV;
    const float* rss = (const float*)(a->ws + WS_RSS); float* out = a->out;
    const int gw = vcu * NWAVES + wave, NGW = G * NWAVES;
    for (int grp = gw; grp < MTOK / 16; grp += NGW)
        for (int r = 0; r < 16; ++r) { const int row = grp * 16 + r;
            const f32x4* pr = (const f32x4*)(rss + (size_t)row * 16);
            const f32x4 p0 = pr[0], p1 = pr[1], p2 = pr[2], p3 = pr[3];
            const float tot = (p0[0] + p1[0]) + (p2[0] + p3[0]);
            const float one = (tot == -1.2345f) ? 2.f : 1.f;
            f32x4* o = (f32x4*)(out + (size_t)row * D) + lane;
#pragma unroll
            for (int j = 0; j < 4; ++j) o[64 * j] = o[64 * j] * one; }
}
constexpr int CW_BAR = 4096;
#define XB_TMO      128
#define XB_XCNT(j)  (256  + 64 * (j))
#define XB_XSUB(j)  (1280 + 64 * (j))
#define XB_XGEN(j)  (2304 + 64 * (j))
#define XB_TOP      3328
#define XB_TOPGEN   3392
#define XCD_BAR_WORDS 3456
#define XB_SPIN_CAP (1u << 18)

__device__ __forceinline__ unsigned xb_ld(unsigned* p)              { return __hip_atomic_load(p, __ATOMIC_RELAXED, __HIP_MEMORY_SCOPE_AGENT); }
__device__ __forceinline__ unsigned xb_add(unsigned* p, unsigned v) { return __hip_atomic_fetch_add(p, v, __ATOMIC_RELAXED, __HIP_MEMORY_SCOPE_AGENT); }
__device__ __forceinline__ unsigned xb_xcc_id() { return (unsigned)__builtin_amdgcn_s_getreg((3 << 11) | 20) & 0xFu; }
#define XB_SPIN(cond, bar) do { unsigned _sp = 0; while (cond) { __builtin_amdgcn_s_sleep(1); \
    if ((++_sp & 255u) == 0u) { if (xb_ld(&(bar)[XB_TMO])) break; if (_sp > XB_SPIN_CAP) { atomicAdd(&(bar)[XB_TMO], 1u); break; } } } } while (0)

struct XcdBarrier {
    unsigned* bar; unsigned x;
    volatile LAS unsigned* st;
};

__device__ __forceinline__ XcdBarrier xcd_barrier_post(unsigned* bar, volatile LAS unsigned* st, bool t0) {
    XcdBarrier b; b.bar = bar; b.x = xb_xcc_id(); b.st = st;
    if (t0) (void)xb_add(&bar[XB_XCNT(b.x)], 1u);
    return b;
}
__device__ __forceinline__ void xcd_barrier_complete(unsigned* bar, unsigned x, unsigned& nloc, unsigned& nx) {
    const unsigned G = gridDim.x * gridDim.y * gridDim.z;
    unsigned sum, cnt, mine, sp = 0u;
    for (;;) {
        sum = 0u; cnt = 0u; mine = 0u;
#pragma unroll
        for (unsigned j = 0; j < 16; ++j) { const unsigned c = xb_ld(&bar[XB_XCNT(j)]); sum += c; cnt += (c > 0u) ? 1u : 0u; mine = (j == x) ? c : mine; }
        if (sum == G) break;
        __builtin_amdgcn_s_sleep(1);
        if ((++sp & 255u) == 0u) { if (xb_ld(&bar[XB_TMO])) break; if (sp > XB_SPIN_CAP) { atomicAdd(&bar[XB_TMO], 1u); break; } }
    }
    nloc = mine > 0u ? mine : 1u; nx = cnt > 0u ? cnt : 1u;
}

__device__ __forceinline__ void xcd_barrier(const XcdBarrier& b, bool t0) {
    asm volatile("s_waitcnt vmcnt(0)" ::: "memory");
    __syncthreads();
    if (t0) {
        unsigned* bar = b.bar;
        __builtin_amdgcn_s_waitcnt(0);
        unsigned nloc = b.st[0], nx = b.st[1];
        if (nloc == 0u) { xcd_barrier_complete(bar, b.x, nloc, nx); b.st[0] = nloc; b.st[1] = nx; }
        const unsigned old = xb_add(&bar[XB_XSUB(b.x)], 1u);
        const unsigned gen = old / nloc;
        if (old + 1u == (gen + 1u) * nloc) {
            __builtin_amdgcn_fence(__ATOMIC_RELEASE, "agent");
            asm volatile("s_waitcnt vmcnt(0)" ::: "memory");
            const unsigned og = xb_add(&bar[XB_TOP], 1u);
            const unsigned tg = og / nx;
            if (og + 1u == (tg + 1u) * nx) xb_add(&bar[XB_TOPGEN], 1u);
            else XB_SPIN(xb_ld(&bar[XB_TOPGEN]) == tg, bar);
            __builtin_amdgcn_fence(__ATOMIC_ACQUIRE, "agent");
            xb_add(&bar[XB_XGEN(b.x)], 1u);
            asm volatile("s_waitcnt vmcnt(0)" ::: "memory");
        } else {
            XB_SPIN(xb_ld(&bar[XB_XGEN(b.x)]) == gen, bar);
            __builtin_amdgcn_fence(__ATOMIC_ACQUIRE, "agent");
            asm volatile("s_waitcnt vmcnt(0)" ::: "memory");
        }
    }
    __syncthreads();
}

__device__ __forceinline__ int crow(int r, int hi) { return (r & 3) + 8 * (r >> 2) + 4 * hi; }
typedef short v4i16_t __attribute__((ext_vector_type(4)));
__device__ __forceinline__ s16x4 ldtr(const LAS unsigned char* p) { return __builtin_bit_cast(s16x4, __builtin_amdgcn_ds_read_tr16_b64_v4i16((LAS v4i16_t*)p)); }
__device__ __forceinline__ bf16x8 ldfrag(const LAS unsigned char* p) { return *(const LAS bf16x8*)p; }
__device__ __forceinline__ float halfswap_max(float m) { auto rr = __builtin_amdgcn_permlane32_swap(__float_as_uint(m), __float_as_uint(m), false, false); return fmaxf(__uint_as_float(rr[0]), __uint_as_float(rr[1])); }
__device__ __forceinline__ float halfswap_sum(float m) { auto rr = __builtin_amdgcn_permlane32_swap(__float_as_uint(m), __float_as_uint(m), false, false); return __uint_as_float(rr[0]) + __uint_as_float(rr[1]); }
__device__ __forceinline__ bf16x8 pack8(const f32x16& p, int base) {
    u32x4 w; w.x = pk2(p[base + 0], p[base + 1]); w.y = pk2(p[base + 2], p[base + 3]); w.z = pk2(p[base + 4], p[base + 5]); w.w = pk2(p[base + 6], p[base + 7]);
    return __builtin_bit_cast(bf16x8, w);
}
__device__ __forceinline__ int t5_bucket(int n) {
    if (n < 16) return n;
    int bkt = 16;
    bkt += (n >= 19); bkt += (n >= 21); bkt += (n >= 24); bkt += (n >= 27); bkt += (n >= 31); bkt += (n >= 35); bkt += (n >= 40); bkt += (n >= 46);
    bkt += (n >= 52); bkt += (n >= 59); bkt += (n >= 67); bkt += (n >= 77); bkt += (n >= 87); bkt += (n >= 99); bkt += (n >= 113);
    return bkt;
}

namespace att {
constexpr int L_RING = 0;
constexpr int L_TB = 98304;
constexpr int L_WSF = L_TB + 512;
constexpr int L_STAGE = 0;
constexpr int SROW = 132;
constexpr float THR = 8.0f;

__device__ __forceinline__ void attn_unit(KArgs a, LAS unsigned char* lds, int WV, int b, int h, int qb, bool dummy = false) {
    int tid_ = TID_OF(WV); asm volatile("" : "+v"(tid_));
    const int tid = tid_, lane = tid & 63, r32 = lane & 31, hi = lane >> 5, wave = WV;
    const int rb = wave & 3, mp = wave >> 2;
    bf16* AQ = (bf16*)(a->ws + WS_AQ); const bf16* AK = (const bf16*)(a->ws + WS_AK); const bf16* AV = (const bf16*)(a->ws + WS_AV); const bf16* AZ = (const bf16*)(a->ws + WS_AZ);
    const float* relb = a->in[16]; const float* anw = a->in[15];
    const size_t rowbase = (size_t)b * SEQ; const int q0 = qb * 128;
    const int qmin = q0 + 32 * rb, qrow = qmin + r32;
    LAS float* tb = (LAS float*)(lds + L_TB); LAS float* wsf = (LAS float*)(lds + L_WSF) + wave * 64; LAS float* stage = (LAS float*)(lds + L_STAGE);
    bf16x8 qf[4];
#pragma unroll
    for (int ks = 0; ks < 4; ++ks) qf[ks] = *(const bf16x8*)(AQ + (rowbase + qrow) * 1024 + h * 128 + mp * 64 + ks * 16 + hi * 8);
    if (tid < 128) tb[tid] = (tid < 113) ? (relb[t5_bucket(tid) * AH + h] - relb[31 * AH + h]) * LOG2E : 0.f;
    const int lc = tid & 15, lkv = tid >> 4;
    const bf16* kg = AK + (rowbase + lkv) * 1024 + h * 128 + lc * 8;
    const bf16* vg = AV + (rowbase + lkv) * 1024 + h * 128 + lc * 8;
    const int kofs0 = lc * 1024 + ((lkv ^ lc) * 16), kofs1 = lc * 1024 + (((lkv + 32) ^ lc) * 16);
    const int vofs0 = 16384 + (lc >> 2) * 4096 + (lkv >> 4) * 1024 + (lkv & 15) * 64 + (lc & 3) * 16, vofs1 = vofs0 + 2048;
#if defined(ATT_ABL) && ATT_ABL == 4
    const int NT = dummy ? 2 : 2 * qb + 2;
#else
    const int NT = 2 * qb + 2;
#endif
    u32x4 kA0, kA1, vA0, vA1, kB0, kB1, vB0, vB1;
#define ATT_LOAD(K0, K1, V0, V1, t) do { const size_t go_ = (size_t)(t) * 64 * 1024; K0 = *(const u32x4*)(kg + go_); K1 = *(const u32x4*)(kg + go_ + 32 * 1024); V0 = *(const u32x4*)(vg + go_); V1 = *(const u32x4*)(vg + go_ + 32 * 1024); } while (0)
#define ATT_STORE(K0, K1, V0, V1, bo) do { LAS unsigned char* nb_ = lds + L_RING + (bo); *(LAS u32x4*)(nb_ + kofs0) = K0; *(LAS u32x4*)(nb_ + kofs1) = K1; *(LAS u32x4*)(nb_ + vofs0) = V0; *(LAS u32x4*)(nb_ + vofs1) = V1; } while (0)
    ATT_LOAD(kA0, kA1, vA0, vA1, 0); ATT_LOAD(kB0, kB1, vB0, vB1, 1);
    ATT_STORE(kA0, kA1, vA0, vA1, 0);
    __syncthreads();
    f32x16 o[4];
#pragma unroll
    for (int e = 0; e < 4; ++e)
#pragma unroll
        for (int r = 0; r < 16; ++r) o[e][r] = 0.f;
    float mref = 0.f, lsum = 0.f;
    f32x16 negm;
#pragma unroll
    for (int r = 0; r < 16; ++r) negm[r] = 0.f;
    const int vlane = ((lane >> 4) & 1) * 32 + (lane & 3) * 8 + (4 * hi + ((lane & 15) >> 2)) * 64;
    int bcur = 0, bnext = 32768;
    for (int jj = 0; jj < NT; jj += 2) {
#pragma unroll
      for (int par = 0; par < 2; ++par) { const int j = jj + par;
        if (j + 2 < NT) { if (par == 0) ATT_LOAD(kA0, kA1, vA0, vA1, j + 2); else ATT_LOAD(kB0, kB1, vB0, vB1, j + 2); }
        const int kv0 = 64 * j;
#if defined(ATT_ABL) && ATT_ABL == 5
        if (kv0 <= qmin + 31 && !dummy) {
#else
        if (kv0 <= qmin + 31) {
#endif
            const LAS unsigned char* kb = lds + L_RING + bcur; const LAS unsigned char* vb = kb + 16384 + vlane;
            f32x16 s0, s1;
#ifdef ATT_ABL
            const bool abl_ = dummy;
#else
            const bool abl_ = false;
#endif
            (void)abl_;
            { bf16x8 kf[8];
#pragma unroll
              for (int ks = 0; ks < 4; ++ks) { const int cgi = mp * 8 + 2 * ks + hi;
                  kf[2 * ks] = ldfrag(kb + cgi * 1024 + ((r32 ^ cgi) * 16)); kf[2 * ks + 1] = ldfrag(kb + cgi * 1024 + (((r32 + 32) ^ cgi) * 16)); }
              __builtin_amdgcn_sched_barrier(0);
#pragma unroll
              for (int ks = 0; ks < 4; ++ks) {
                  s0 = __builtin_amdgcn_mfma_f32_32x32x16_bf16(kf[2 * ks], qf[ks], ks == 0 ? negm : s0, 0, 0, 0);
                  s1 = __builtin_amdgcn_mfma_f32_32x32x16_bf16(kf[2 * ks + 1], qf[ks], ks == 0 ? negm : s1, 0, 0, 0); } }
            s16x4 vAl[4], vAh[4], vBl[4], vBh[4];
#pragma unroll
            for (int ks = 0; ks < 4; ++ks) { vAl[ks] = ldtr(vb + ks * 1024); vAh[ks] = ldtr(vb + ks * 1024 + 512); }
            if (qmin - (kv0 + 63) < 113) {
#pragma unroll
                for (int r = 0; r < 16; ++r) { const int d0 = qrow - (kv0 + crow(r, hi)); const int i0 = min(max(d0, 0), 127), i1 = min(max(d0 - 32, 0), 127);
                    s0[r] += tb[i0]; s1[r] += tb[i1]; }
            }
            if (kv0 + 63 > qmin) {
#pragma unroll
                for (int r = 0; r < 16; ++r) { const int kv = kv0 + crow(r, hi); if (kv > qrow) s0[r] = -INFINITY; if (kv + 32 > qrow) s1[r] = -INFINITY; }
            }
#if defined(ATT_ABL) && ATT_ABL == 2
            if (!abl_) {
#endif
            float rm;
            { float m0_ = fmaxf(fmaxf(s0[0], s0[1]), s0[2]), m1_ = fmaxf(fmaxf(s0[3], s0[4]), s0[5]), m2_ = fmaxf(fmaxf(s1[0], s1[1]), s1[2]), m3_ = fmaxf(fmaxf(s1[3], s1[4]), s1[5]);
              m0_ = fmaxf(fmaxf(m0_, s0[6]), s0[7]); m1_ = fmaxf(fmaxf(m1_, s0[8]), s0[9]); m2_ = fmaxf(fmaxf(m2_, s1[6]), s1[7]); m3_ = fmaxf(fmaxf(m3_, s1[8]), s1[9]);
              m0_ = fmaxf(fmaxf(m0_, s0[10]), s0[11]); m1_ = fmaxf(fmaxf(m1_, s0[12]), s0[13]); m2_ = fmaxf(fmaxf(m2_, s1[10]), s1[11]); m3_ = fmaxf(fmaxf(m3_, s1[12]), s1[13]);
              m0_ = fmaxf(fmaxf(m0_, s0[14]), s0[15]); m2_ = fmaxf(fmaxf(m2_, s1[14]), s1[15]);
              rm = fmaxf(fmaxf(m0_, m1_), fmaxf(m2_, m3_)); }
            rm = halfswap_max(rm);
            if (j == 0 || __any(rm > THR)) {
                const float dl = (j == 0) ? rm : fmaxf(rm, 0.f);
                mref += dl;
#pragma unroll
                for (int r = 0; r < 16; ++r) { s0[r] -= dl; s1[r] -= dl; negm[r] = -mref; }
                if (j != 0) { const float f = __builtin_amdgcn_exp2f(-dl); lsum *= f;
                    if (hi == 0) wsf[r32] = f;
#pragma unroll
                    for (int r = 0; r < 16; ++r) { const float fr_ = wsf[crow(r, hi)];
#pragma unroll
                        for (int e = 0; e < 4; ++e) o[e][r] *= fr_; } }
            }
#pragma unroll
            for (int r = 0; r < 16; ++r) { s0[r] = __builtin_amdgcn_exp2f(s0[r]); s1[r] = __builtin_amdgcn_exp2f(s1[r]); }
            lsum += (((s0[0] + s0[1]) + (s0[2] + s0[3])) + ((s0[4] + s0[5]) + (s0[6] + s0[7]))) + (((s0[8] + s0[9]) + (s0[10] + s0[11])) + ((s0[12] + s0[13]) + (s0[14] + s0[15])))
                  + (((s1[0] + s1[1]) + (s1[2] + s1[3])) + ((s1[4] + s1[5]) + (s1[6] + s1[7]))) + (((s1[8] + s1[9]) + (s1[10] + s1[11])) + ((s1[12] + s1[13]) + (s1[14] + s1[15])));
#if defined(ATT_ABL) && ATT_ABL == 2
            }
#endif
            const bf16x8 pa0 = pack8(s0, 0), pa1 = pack8(s0, 8), pa2 = pack8(s1, 0), pa3 = pack8(s1, 8);
#define ATT_VFX(L, H, k) (bf16x8){L[k][0], L[k][1], L[k][2], L[k][3], H[k][0], H[k][1], H[k][2], H[k][3]}
#define ATT_PV(e, L, H) do { o[e] = __builtin_amdgcn_mfma_f32_32x32x16_bf16(pa0, ATT_VFX(L, H, 0), o[e], 0, 0, 0); o[e] = __builtin_amdgcn_mfma_f32_32x32x16_bf16(pa1, ATT_VFX(L, H, 1), o[e], 0, 0, 0); \
                o[e] = __builtin_amdgcn_mfma_f32_32x32x16_bf16(pa2, ATT_VFX(L, H, 2), o[e], 0, 0, 0); o[e] = __builtin_amdgcn_mfma_f32_32x32x16_bf16(pa3, ATT_VFX(L, H, 3), o[e], 0, 0, 0); } while (0)
#define ATT_VRD(L, H, e) do { _Pragma("unroll") for (int ks = 0; ks < 4; ++ks) { L[ks] = ldtr(vb + (e) * 4096 + ks * 1024); H[ks] = ldtr(vb + (e) * 4096 + ks * 1024 + 512); } } while (0)
#if defined(ATT_ABL) && ATT_ABL == 1
            if (!abl_) {
#endif
            ATT_VRD(vBl, vBh, 1); __builtin_amdgcn_sched_barrier(0); ATT_PV(0, vAl, vAh);
            ATT_VRD(vAl, vAh, 2); __builtin_amdgcn_sched_barrier(0); ATT_PV(1, vBl, vBh);
            ATT_VRD(vBl, vBh, 3); __builtin_amdgcn_sched_barrier(0); ATT_PV(2, vAl, vAh);
            __builtin_amdgcn_sched_barrier(0); ATT_PV(3, vBl, vBh);
#if defined(ATT_ABL) && ATT_ABL == 1
            }
#endif
#undef ATT_VFX
#undef ATT_PV
#undef ATT_VRD
        }
        if (j + 1 < NT) { if (par == 0) ATT_STORE(kB0, kB1, vB0, vB1, bnext); else ATT_STORE(kA0, kA1, vA0, vA1, bnext); }
        bcur = bnext; bnext = (bnext == 65536) ? 0 : bnext + 32768;
        __syncthreads();
      }
    }
#undef ATT_LOAD
#undef ATT_STORE
    u32x4 zpre[4];
    { int te_ = tid; asm volatile("" : "+v"(te_)); const int row = te_ >> 2, part = te_ & 3;
      const u32x4* zp = (const u32x4*)(AZ + (rowbase + q0 + row) * 1024 + h * 128 + 32 * part);
#pragma unroll
      for (int i = 0; i < 4; ++i) zpre[i] = zp[i]; }
    const float ltot = halfswap_sum(lsum);
    const float lam_ = *(volatile LAS float*)(lds + LDS_BYTES - 48);
    const float sc = (mp == 0 ? 1.0f : -lam_) / ltot;
    if (hi == 0) wsf[r32] = sc;
    float scr[16];
#pragma unroll
    for (int r = 0; r < 16; ++r) scr[r] = wsf[crow(r, hi)];
    if (mp == 0) {
#pragma unroll
        for (int e = 0; e < 4; ++e)
#pragma unroll
            for (int r = 0; r < 16; ++r) stage[(32 * rb + crow(r, hi)) * SROW + 32 * e + r32] = o[e][r] * scr[r];
    }
    __syncthreads();
    if (mp == 1) {
#pragma unroll
        for (int e = 0; e < 4; ++e)
#pragma unroll
            for (int r = 0; r < 16; ++r) stage[(32 * rb + crow(r, hi)) * SROW + 32 * e + r32] += o[e][r] * scr[r];
    }
    __syncthreads();
    { const int row = tid >> 2, part = tid & 3;
      const LAS f32x4* sp = (const LAS f32x4*)(stage + row * SROW + 32 * part);
      f32x4 v[8]; float ss = 0.f;
#pragma unroll
      for (int i = 0; i < 8; ++i) { v[i] = sp[i]; ss += (v[i][0] * v[i][0] + v[i][1] * v[i][1]) + (v[i][2] * v[i][2] + v[i][3] * v[i][3]); }
      ss = xadd<1>(ss); ss = xadd<2>(ss);
      const float rs = 0.8f / sqrtf(ss * (1.f / 128.f) + EPS);
      const size_t go = (rowbase + q0 + row) * 1024 + h * 128 + 32 * part;
      u32x4* op = dummy ? (u32x4*)((bf16*)(a->ws + WS_DUMMY) + (size_t)row * 1024 + h * 128 + 32 * part) : (u32x4*)(AQ + go); const f32x4* wp = (const f32x4*)(anw + 32 * part);
#pragma unroll
      for (int i = 0; i < 4; ++i) { const u32x4 z = zpre[i]; const f32x4 w0 = wp[2 * i], w1 = wp[2 * i + 1]; const f32x4 x0 = v[2 * i] * rs * w0, x1 = v[2 * i + 1] * rs * w1;
          u32x4 w; w.x = pk2(x0[0] * bflo(z.x), x0[1] * bfhi(z.x)); w.y = pk2(x0[2] * bflo(z.y), x0[3] * bfhi(z.y));
          w.z = pk2(x1[0] * bflo(z.z), x1[1] * bfhi(z.z)); w.w = pk2(x1[2] * bflo(z.w), x1[3] * bfhi(z.w)); op[i] = w; } }
    __syncthreads();
}
}

namespace prep {
constexpr unsigned N_ITEMS = MTOK / 64;
__device__ __forceinline__ void conv_item(KArgs a, int WV, int g) {
    int tid_ = TID_OF(WV); asm volatile("" : "+v"(tid_)); const int tid = tid_;
    bf16* MQ = (bf16*)a->out; bf16* MK = MQ + (size_t)MTOK * 1024; const bf16* HALO = (const bf16*)(a->ws + WS_HALO);
    const int c0 = 2 * tid;
    f32x2 wq[4], wk[4];
#pragma unroll
    for (int j = 0; j < 4; ++j) { wq[j] = *(const f32x2*)(a->in[8] + j * 1024 + c0); wk[j] = *(const f32x2*)(a->in[9] + j * 1024 + c0); }
    unsigned q3 = 0u, q2 = 0u, q1 = 0u, k3 = 0u, k2 = 0u, k1 = 0u;
    if ((g & 31) != 0) { const bf16* hq = HALO + (size_t)(g - 1) * 3 * 1024 + c0; const bf16* hk = hq + (size_t)512 * 3 * 1024;
        q3 = *(const unsigned*)hq; q2 = *(const unsigned*)(hq + 1024); q1 = *(const unsigned*)(hq + 2048);
        k3 = *(const unsigned*)hk; k2 = *(const unsigned*)(hk + 1024); k1 = *(const unsigned*)(hk + 2048); }
    bf16* qp = MQ + (size_t)g * 64 * 1024 + c0; bf16* kp = MK + (size_t)g * 64 * 1024 + c0;
#define PREP_PASS(ptr, w, h3, h2, h1, SCALE) do { unsigned r_[64]; \
        _Pragma("unroll") for (int t = 0; t < 64; ++t) r_[t] = *(const unsigned*)((ptr) + t * 1024); \
        unsigned p3 = h3, p2 = h2, p1 = h1; \
        _Pragma("unroll") for (int t = 0; t < 64; ++t) { const unsigned u = r_[t]; \
            const float a0 = w[0][0] * bflo(p3) + w[1][0] * bflo(p2) + w[2][0] * bflo(p1) + w[3][0] * bflo(u); \
            const float a1 = w[0][1] * bfhi(p3) + w[1][1] * bfhi(p2) + w[2][1] * bfhi(p1) + w[3][1] * bfhi(u); \
            *(unsigned*)((ptr) + t * 1024) = pk2(siluf(a0) * (SCALE), siluf(a1) * (SCALE)); \
            p3 = p2; p2 = p1; p1 = u; } } while (0)
    PREP_PASS(qp, wq, q3, q2, q1, 0.0625f);
    PREP_PASS(kp, wk, k3, k2, k1, 1.0f);
#undef PREP_PASS
    asm volatile("s_waitcnt vmcnt(0)" ::: "memory");
    __syncthreads();
    if (tid == 0) { __builtin_amdgcn_fence(__ATOMIC_RELEASE, "agent"); asm volatile("s_waitcnt vmcnt(0)" ::: "memory");
        __hip_atomic_fetch_add((unsigned*)(a->ws + WS_CTL) + CW_PREP, 1u, __ATOMIC_RELAXED, __HIP_MEMORY_SCOPE_AGENT); }
}
__device__ __forceinline__ void wait_all(KArgs a, int WV) {
    if (WV == 0 && lane_id() == 0) { unsigned* cnt = (unsigned*)(a->ws + WS_CTL) + CW_PREP; unsigned spins = 0u;
        while (__hip_atomic_load(cnt, __ATOMIC_RELAXED, __HIP_MEMORY_SCOPE_AGENT) < N_ITEMS) { __builtin_amdgcn_s_sleep(16); if (++spins > (1u << 22)) break; }
        __builtin_amdgcn_fence(__ATOMIC_ACQUIRE, "agent"); asm volatile("s_waitcnt vmcnt(0)" ::: "memory"); }
    __syncthreads();
}
}

namespace mls {
#ifdef MLS_KEEP_SB
#define MLS_SB __builtin_amdgcn_sched_barrier(0)
#else
#define MLS_SB do { } while (0)
#endif
constexpr int L_Q = 0;
constexpr int L_K = 32768;
constexpr int L_STAGE = 0;
constexpr int L_KW = 66560;
constexpr int L_V = L_KW + 32768;
constexpr int L_P = L_V + 32768;
constexpr int L_SC = L_P + 8192;
constexpr int L_N = L_SC + 18 * 256;
constexpr int L_CW = L_N + 1024;
constexpr int L_MW = L_CW + 8192;
constexpr int L_END = L_MW + 1024;
static_assert(L_END <= LDS_BYTES, "mLSTM LDS map");
constexpr int SROW = 260;

__device__ __forceinline__ void mlstm_unit(KArgs a, LAS unsigned char* lds, int WV, int b, int h) {
    int tid_ = TID_OF(WV); asm volatile("" : "+v"(tid_));
    const int tid = tid_, lane = tid & 63, r32 = lane & 31, hi = lane >> 5, wave = WV;
    prep::wait_all(a, WV);
    const bf16* MQ = (const bf16*)a->out; unsigned char* wsb = a->ws;
#define MK (MQ + (size_t)MTOK * 1024)
#define MV ((const bf16*)(wsb + WS_MV))
#define GM ((const bf16*)(wsb + WS_GM))
#define HM ((bf16*)(wsb + WS_HB))
#define LI ((const float*)(wsb + WS_LI))
#define LF ((const float*)(wsb + WS_LF))
    LAS float* S_psum = (LAS float*)(lds + L_SC) + 768; LAS float* S_qn = S_psum + 256;
    LAS float* nperm = (LAS float*)(lds + L_N); LAS float* stage = (LAS float*)(lds + L_STAGE);
    f32x16 X[8];
#pragma unroll
    for (int i = 0; i < 8; ++i)
#pragma unroll
        for (int r = 0; r < 16; ++r) X[i][r] = 0.f;
    if (tid < 256) nperm[tid] = 0.f;
    if (tid < 256) ((LAS float*)(lds + L_MW))[tid] = a->in[10][h * 256 + tid];
    float m_prev = 0.f;
    const int tg = WV >> 1;
#define MLS_LANE_IDS int tf_ = tid; asm volatile("" : "+v"(tf_));   \
    const int dp = tf_ & 127, d0 = 2 * dp; \
    const int ppos = (d0 & ~12) | ((d0 & 4) << 1) | ((d0 & 8) >> 1);     \
    const int qch = ppos >> 3, qbo = (ppos & 7) * 2;
#define MLS_LOAD_SET(Rq, Rk, Rv, cc, hs) do { const int t0_ = 32 * (hs) + 8 * tg; int tl_ = tid; asm volatile("" : "+v"(tl_)); const int d0 = 2 * (tl_ & 127);     \
        const size_t ub_ = ((size_t)b * SEQ + 64 * (cc) + t0_) * 1024 + h * 256; \
        const bf16* qb_ = MQ + ub_; const bf16* kb_ = MK + ub_; const bf16* vb_ = MV + ub_; \
        _Pragma("unroll") for (int i = 0; i < 8; ++i) { Rq[i] = *(const unsigned*)(qb_ + (i * 1024 + d0)); Rk[i] = *(const unsigned*)(kb_ + (i * 1024 + d0)); Rv[i] = *(const unsigned*)(vb_ + (i * 1024 + d0)); } } while (0)
#define MLS_FILL_SET(Rq, Rk, Rv, hs) do { const int t0_ = 32 * (hs) + 8 * tg; MLS_LANE_IDS \
        float kw0_[8], kw1_[8]; \
        _Pragma("unroll") for (int t = 0; t < 8; ++t) { const int row = t0_ + t; \
            const int ro_ = row * 512 + ((qch ^ (row & 15)) * 16) + qbo; \
            *(LAS unsigned*)(lds + L_Q + ro_) = Rq[t]; *(LAS unsigned*)(lds + L_K + ro_) = Rk[t]; \
            const float wsr = S_ws[row]; kw0_[t] = bflo(Rk[t]) * wsr; kw1_[t] = bfhi(Rk[t]) * wsr; } \
        const int cs_ = t0_ >> 3; \
        { const int d = d0; const int ro_ = d * 128 + ((cs_ ^ ((d >> 1) & 7)) * 16); \
          u32x4 w; w.x = pk2(kw0_[0], kw0_[1]); w.y = pk2(kw0_[2], kw0_[3]); w.z = pk2(kw0_[4], kw0_[5]); w.w = pk2(kw0_[6], kw0_[7]); *(LAS u32x4*)(lds + L_KW + ro_) = w; \
          u32x4 wv; wv.x = (Rv[0] & 0xffffu) | (Rv[1] << 16); wv.y = (Rv[2] & 0xffffu) | (Rv[3] << 16); wv.z = (Rv[4] & 0xffffu) | (Rv[5] << 16); wv.w = (Rv[6] & 0xffffu) | (Rv[7] << 16); *(LAS u32x4*)(lds + L_V + ro_) = wv; } \
        { const int d = d0 + 1; const int ro_ = d * 128 + ((cs_ ^ ((d >> 1) & 7)) * 16); \
          u32x4 w; w.x = pk2(kw1_[0], kw1_[1]); w.y = pk2(kw1_[2], kw1_[3]); w.z = pk2(kw1_[4], kw1_[5]); w.w = pk2(kw1_[6], kw1_[7]); *(LAS u32x4*)(lds + L_KW + ro_) = w; \
          u32x4 wv; wv.x = (Rv[0] >> 16) | (Rv[1] & 0xffff0000u); wv.y = (Rv[2] >> 16) | (Rv[3] & 0xffff0000u); wv.z = (Rv[4] >> 16) | (Rv[5] & 0xffff0000u); wv.w = (Rv[6] >> 16) | (Rv[7] & 0xffff0000u); *(LAS u32x4*)(lds + L_V + ro_) = wv; } \
    } while (0)
    unsigned SAq[8], SAk[8], SAv[8];
    MLS_LOAD_SET(SAq, SAk, SAv, 0, 0);
    float pf_lf = 0.f, pf_li = 0.f;
    if (wave == 0) { const size_t ub_ = (size_t)b * SEQ * 4 + h; pf_lf = (LF + ub_)[lane * 4]; pf_li = (LI + ub_)[lane * 4]; }
#ifdef STAMP_SEG
    unsigned long long seg_acc = 0ull, seg_t = __builtin_amdgcn_s_memrealtime();
#define SEGT(k) do { const unsigned long long n_ = __builtin_amdgcn_s_memrealtime(); if ((k) == STAMP_SEG) seg_acc += n_ - seg_t; seg_t = n_; } while (0)
#else
#define SEGT(k) do { } while (0)
#endif
    for (int c = 0; c < SEQ / MCH; ++c) {
        const size_t row0 = (size_t)b * SEQ + 64 * c;
        LAS float* S_alpha = (LAS float*)(lds + L_SC) + (c & 1) * 384; LAS float* S_beta = S_alpha + 64; LAS float* S_iw = S_alpha + 128; LAS float* S_clamp = S_alpha + 192; LAS float* S_ws = S_alpha + 256; LAS float* S_misc = S_alpha + 320;
        unsigned SBq[8], SBk[8], SBv[8];
        MLS_LOAD_SET(SBq, SBk, SBv, c, 1);
        if (wave == 0) {
            const float lf = pf_lf, li = pf_li;
            if (c + 1 < SEQ / MCH) { const size_t ub_ = (row0 + 64) * 4 + h; pf_lf = (LF + ub_)[lane * 4]; pf_li = (LI + ub_)[lane * 4]; }
#define MLS_DPP(old_, src_, ctrl_, rmask_) __uint_as_float((unsigned)__builtin_amdgcn_update_dpp((int)__float_as_uint(old_), (int)__float_as_uint(src_), ctrl_, rmask_, 0xf, false))
            float bt = lf;
            bt += MLS_DPP(0.f, bt, 0x111, 0xf); bt += MLS_DPP(0.f, bt, 0x112, 0xf); bt += MLS_DPP(0.f, bt, 0x114, 0xf); bt += MLS_DPP(0.f, bt, 0x118, 0xf);
            bt += MLS_DPP(0.f, bt, 0x142, 0xa); bt += MLS_DPP(0.f, bt, 0x143, 0xc);
            const float beta = li - bt; float cm = beta; const float ninf = -INFINITY;
            cm = fmaxf(cm, MLS_DPP(ninf, cm, 0x111, 0xf)); cm = fmaxf(cm, MLS_DPP(ninf, cm, 0x112, 0xf)); cm = fmaxf(cm, MLS_DPP(ninf, cm, 0x114, 0xf)); cm = fmaxf(cm, MLS_DPP(ninf, cm, 0x118, 0xf));
            cm = fmaxf(cm, MLS_DPP(ninf, cm, 0x142, 0xa)); cm = fmaxf(cm, MLS_DPP(ninf, cm, 0x143, 0xc));
#undef MLS_DPP
            const float mx = fmaxf(cm, m_prev);
            S_alpha[lane] = -mx; S_beta[lane] = beta; S_iw[lane] = __expf(m_prev - mx); S_clamp[lane] = __expf(-(bt + mx));
            const float cmL = __uint_as_float(__builtin_amdgcn_readlane(__float_as_uint(cm), 63)), bL = __uint_as_float(__builtin_amdgcn_readlane(__float_as_uint(bt), 63)); const float mxL = fmaxf(m_prev, cmL);
            S_ws[lane] = __expf(beta - mxL);
            if (lane == 0) S_misc[0] = __expf(m_prev - mxL);
            m_prev = bL + mxL;
        }
        __syncthreads();
        SEGT(0);
        MLS_FILL_SET(SAq, SAk, SAv, 0);
        __builtin_amdgcn_sched_barrier(0);
        MLS_FILL_SET(SBq, SBk, SBv, 1);
        __builtin_amdgcn_sched_barrier(0);
        __syncthreads();
        SEGT(1);
        f32x16 num[2];
        {
            int lo_ = lane; asm volatile("" : "+v"(lo_));
            const int l15 = lo_ & 15, kq = lo_ >> 4, r32a = lo_ & 31, hia = lo_ >> 5;
            const int si = wave >> 1, ti0 = 2 * (wave & 1);
            f32x4 sa[2] = {(f32x4){0.f, 0.f, 0.f, 0.f}, (f32x4){0.f, 0.f, 0.f, 0.f}};
            { const int y = kq ^ l15; const int rowoff = l15 * 512;
              int b4[4];
#pragma unroll
              for (int j = 0; j < 4; ++j) b4[j] = rowoff + (((4 * j) ^ y) * 16);
              const LAS unsigned char* kbase = lds + L_K + si * 8192; const LAS unsigned char* qbase = lds + L_Q + ti0 * 8192;
#pragma unroll
              for (int kk = 0; kk < 8; ++kk) { const int o_ = b4[kk & 3] + (kk >> 2) * 256;
                  const bf16x8 ka = ldfrag(kbase + o_);
                  const bf16x8 q0_ = ldfrag(qbase + o_), q1_ = ldfrag(qbase + 8192 + o_);
                  sa[0] = __builtin_amdgcn_mfma_f32_16x16x32_bf16(ka, q0_, sa[0], 0, 0, 0);
                  sa[1] = __builtin_amdgcn_mfma_f32_16x16x32_bf16(ka, q1_, sa[1], 0, 0, 0); } }
#pragma unroll
            for (int u = 0; u < 2; ++u) { const int ti = ti0 + u, t = 16 * ti + l15, s_ = 16 * si + 4 * kq;
                const float al = S_alpha[t]; const f32x4 bt4 = *(const LAS f32x4*)(S_beta + s_); float pv_[4]; float psum = 0.f;
#pragma unroll
                for (int r = 0; r < 4; ++r) { pv_[r] = (s_ + r <= t) ? sa[u][r] * __expf(al + bt4[r]) : 0.f; psum += pv_[r]; }
                psum = xadd<16>(psum); psum = xadd<32>(psum);
                if (kq == 0) S_psum[si * 64 + t] = psum;
                u32x2 w; w.x = pk2(pv_[0], pv_[1]); w.y = pk2(pv_[2], pv_[3]);
                const int cp = 2 * si + (kq >> 1);
                *(LAS u32x2*)(lds + L_P + t * 128 + ((cp ^ ((t >> 1) & 7)) * 16) + 8 * (kq & 1)) = w; }
#pragma unroll
            for (int r = 0; r < 16; ++r) { num[0][r] = 0.f; num[1][r] = 0.f; }
            { const int yq = hia ^ (r32a & 15); const int rowoff = r32a * 512;
              int b8[8];
#pragma unroll
              for (int g = 0; g < 8; ++g) b8[g] = rowoff + (((2 * g) ^ yq) * 16);
              const LAS unsigned char* qbase = lds + L_Q;
#pragma unroll
              for (int dt = 0; dt < 8; ++dt) { MLS_SB;
#pragma unroll
                  for (int sp = 0; sp < 2; ++sp) { const bf16x8 xb = pack8(X[dt], 8 * sp); const int G_ = 2 * dt + sp; const int o_ = b8[G_ & 7] + (G_ >> 3) * 256;
                      const bf16x8 qa0 = ldfrag(qbase + o_), qa1 = ldfrag(qbase + 16384 + o_);
                      num[0] = __builtin_amdgcn_mfma_f32_32x32x16_bf16(qa0, xb, num[0], 0, 0, 0);
                      num[1] = __builtin_amdgcn_mfma_f32_32x32x16_bf16(qa1, xb, num[1], 0, 0, 0); } } }
            __builtin_amdgcn_sched_barrier(0);
            { int to_ = tid; asm volatile("" : "+v"(to_));
              const int t = to_ >> 3, part = to_ & 7; float accn = 0.f;
#pragma unroll
              for (int i = 0; i < 4; ++i) { const int ch = 4 * part + i; const u32x4 qq = *(const LAS u32x4*)(lds + L_Q + t * 512 + ((ch ^ (t & 15)) * 16));
                  const f32x4 n0 = *(const LAS f32x4*)(nperm + 8 * ch), n1 = *(const LAS f32x4*)(nperm + 8 * ch + 4);
                  accn += bflo(qq.x) * n0[0] + bfhi(qq.x) * n0[1] + bflo(qq.y) * n0[2] + bfhi(qq.y) * n0[3] + bflo(qq.z) * n1[0] + bfhi(qq.z) * n1[1] + bflo(qq.w) * n1[2] + bfhi(qq.w) * n1[3]; }
              accn = xadd<1>(accn); accn = xadd<2>(accn); accn = xadd<4>(accn);
              if (part == 0) S_qn[t] = accn; }
        }
        __syncthreads();
        SEGT(2);
        u32x4 gz[4];
        {
            int lo_ = lane; asm volatile("" : "+v"(lo_));
            const int r32a = lo_ & 31, hia = lo_ >> 5;
            const int e = 32 * wave + r32a;
            const int yk = hia ^ ((r32a >> 1) & 7); const int rowoff = r32a * 128;
            int b4[4];
#pragma unroll
            for (int ks = 0; ks < 4; ++ks) b4[ks] = rowoff + (((2 * ks) ^ yk) * 16);
            bf16x8 vf[4];
#pragma unroll
            for (int ks = 0; ks < 4; ++ks) vf[ks] = ldfrag(lds + L_V + wave * 4096 + b4[ks]);
#pragma unroll
            for (int tt = 0; tt < 2; ++tt) {
#pragma unroll
                for (int g = 0; g < 4; ++g) { const f32x4 iw4 = *(const LAS f32x4*)(S_iw + 32 * tt + 8 * g + 4 * hia);
#pragma unroll
                    for (int q = 0; q < 4; ++q) num[tt][4 * g + q] *= iw4[q]; }
#pragma unroll
                for (int ks = 0; ks < 4; ++ks) { const bf16x8 pa = ldfrag(lds + L_P + tt * 4096 + b4[ks]);
                    num[tt] = __builtin_amdgcn_mfma_f32_32x32x16_bf16(pa, vf[ks], num[tt], 0, 0, 0); }
#pragma unroll
                for (int r = 0; r < 16; ++r) stage[(32 * tt + crow(r, hia)) * SROW + e] = num[tt][r];
            }
            if (c + 1 < SEQ / MCH) MLS_LOAD_SET(SAq, SAk, SAv, c + 1, 0);
#ifndef MLS_GATE_LATE
            { int to2_ = tid; asm volatile("" : "+v"(to2_)); const int t = to2_ >> 3, part = to2_ & 7;
              const u32x4* gp = (const u32x4*)(GM + row0 * 1024 + h * 256 + (t * 1024 + 32 * part));
#pragma unroll
              for (int i = 0; i < 4; ++i) gz[i] = gp[i]; }
#endif
            const float decay = S_misc[0];
#pragma unroll
            for (int dt = 0; dt < 8; ++dt) { MLS_SB;
#pragma unroll
                for (int r = 0; r < 16; ++r) X[dt][r] *= decay;
#pragma unroll
                for (int ks = 0; ks < 4; ++ks) { const bf16x8 ka = ldfrag(lds + L_KW + dt * 4096 + b4[ks]);
                    X[dt] = __builtin_amdgcn_mfma_f32_32x32x16_bf16(ka, vf[ks], X[dt], 0, 0, 0); } }
            __builtin_amdgcn_sched_barrier(0);
            int to_ = tid; asm volatile("" : "+v"(to_));
            if (to_ < 256) { const int d = to_; float s = 0.f;
#pragma unroll
                for (int i = 0; i < 8; ++i) { const u32x4 kk = *(const LAS u32x4*)(lds + L_KW + d * 128 + i * 16);
                    s += (bflo(kk.x) + bfhi(kk.x)) + (bflo(kk.y) + bfhi(kk.y)) + (bflo(kk.z) + bfhi(kk.z)) + (bflo(kk.w) + bfhi(kk.w)); }
                const int p = (d & ~12) | ((d & 4) << 1) | ((d & 8) >> 1);
                nperm[p] = decay * nperm[p] + s; }
        }
        __syncthreads();
        SEGT(3);
        { int te_ = tid; asm volatile("" : "+v"(te_)); const int t = te_ >> 3, part = te_ & 7;
          const float den = S_iw[t] * S_qn[t] + ((S_psum[t] + S_psum[64 + t]) + (S_psum[128 + t] + S_psum[192 + t]));
          const float hd = 1.0f / fmaxf(fabsf(den), S_clamp[t]);
          const LAS f32x4* sp = (const LAS f32x4*)(stage + t * SROW + 32 * part);
          f32x4 v[8]; float s1 = 0.f;
#pragma unroll
          for (int i = 0; i < 8; ++i) { v[i] = sp[i] * hd; s1 += (v[i][0] + v[i][1]) + (v[i][2] + v[i][3]); }
          s1 = xadd<1>(s1); s1 = xadd<2>(s1); s1 = xadd<4>(s1);
          const float mu = s1 * (1.f / 256.f); float s2 = 0.f;
#pragma unroll
          for (int i = 0; i < 8; ++i) { v[i] = v[i] - mu; s2 += (v[i][0] * v[i][0] + v[i][1] * v[i][1]) + (v[i][2] * v[i][2] + v[i][3] * v[i][3]); }
          s2 = xadd<1>(s2); s2 = xadd<2>(s2); s2 = xadd<4>(s2);
          const float rs = 1.0f / sqrtf(s2 * (1.f / 256.f) + EPS);
          const size_t ub = row0 * 1024 + h * 256; const int lo2 = t * 1024 + 32 * part;
#ifdef MLS_GATE_LATE
          { const u32x4* gp = (const u32x4*)(GM + ub + lo2);
#pragma unroll
            for (int i = 0; i < 4; ++i) gz[i] = gp[i]; }
#endif
          u32x4* op = (u32x4*)(HM + ub + lo2); const LAS f32x4* wp = (const LAS f32x4*)(lds + L_MW) + 8 * part;
#pragma unroll
          for (int i = 0; i < 4; ++i) { const u32x4 z = gz[i]; const f32x4 w0 = wp[2 * i], w1 = wp[2 * i + 1]; const f32x4 x0 = v[2 * i] * rs * w0, x1 = v[2 * i + 1] * rs * w1;
              u32x4 w; w.x = pk2(x0[0] * bflo(z.x), x0[1] * bfhi(z.x)); w.y = pk2(x0[2] * bflo(z.y), x0[3] * bfhi(z.y));
              w.z = pk2(x1[0] * bflo(z.z), x1[1] * bfhi(z.z)); w.w = pk2(x1[2] * bflo(z.w), x1[3] * bfhi(z.w)); op[i] = w; } }
        SEGT(4);
    }
    __syncthreads();
#ifdef STAMP_SEG
    *(volatile LAS unsigned long long*)(lds + LDS_BYTES - 32) = seg_acc;
#endif
#undef SEGT
#undef MK
#undef MV
#undef GM
#undef HM
#undef LI
#undef LF
#undef MLS_LOAD_SET
#undef MLS_FILL_SET
#undef MLS_LANE_IDS
}
}

__device__ __forceinline__ void phase3(KArgs a, LAS unsigned char* lds, int WV) {
    const int tid = TID_OF(WV), lane = tid & 63;
    float s1 = a->in[11][lane] * a->in[12][lane], s2 = a->in[13][lane] * a->in[14][lane];
    s1 = wave_sum(s1); s2 = wave_sum(s2);
    if (tid == 0) *(volatile LAS float*)(lds + LDS_BYTES - 48) = expf(s1) - expf(s2) + 0.2f;
    LAS unsigned* slot = (LAS unsigned*)(lds + LDS_BYTES - 64);
#if defined(STAMP_UNIT)
    unsigned long long unit_span = 0ull;
#endif
    constexpr unsigned N_M1 = BATCH * MH, N_M = N_M1 * REP_ML, N_P = prep::N_ITEMS;
    unsigned* ctl = (unsigned*)(a->ws + WS_CTL);
    const bool t0q = (WV == 0 && lane_id() == 0);
    unsigned nx = 0u;
    if (t0q) nx = __hip_atomic_fetch_add(ctl + CW_QUEUE, 1u, __ATOMIC_RELAXED, __HIP_MEMORY_SCOPE_AGENT);
    for (;;) {
        if (t0q) *slot = nx;
        __syncthreads();
        unsigned it = *slot;
        __syncthreads();
        if (it >= N_P + N_M) break;
        if (t0q) nx = __hip_atomic_fetch_add(ctl + CW_QUEUE, 1u, __ATOMIC_RELAXED, __HIP_MEMORY_SCOPE_AGENT);
        if (it < N_P) { prep::conv_item(a, WV, (int)it); continue; }
        it -= N_P;
        { const unsigned u = it % N_M1;
#ifdef STAMP_UNIT
            const unsigned long long tu0 = __builtin_amdgcn_s_memrealtime();
#endif
            mls::mlstm_unit(a, lds, WV, (int)(u >> 2), (int)(u & 3));
#ifdef STAMP_UNIT
#ifdef STAMP_SEG
            if (it == STAMP_UNIT) unit_span = *(volatile LAS unsigned long long*)(lds + LDS_BYTES - 32);
#else
            if (it == STAMP_UNIT) unit_span = __builtin_amdgcn_s_memrealtime() - tu0;
#endif
#endif
        }
    }
    {
        constexpr unsigned N_A1 = BATCH * AH * (SEQ / 128), N_A = N_A1 * REP_AT;
        unsigned* qh = ctl + CW_QATT;
        if (t0q) nx = __hip_atomic_fetch_add(qh, 1u, __ATOMIC_RELAXED, __HIP_MEMORY_SCOPE_AGENT);
        for (;;) {
            if (t0q) *slot = nx;
            __syncthreads();
            const unsigned it = *slot;
            __syncthreads();
            if (it >= N_A) break;
            if (t0q) nx = __hip_atomic_fetch_add(qh, 1u, __ATOMIC_RELAXED, __HIP_MEMORY_SCOPE_AGENT);
            const bool dummy = it < N_A1 * (REP_AT - 1); const unsigned i = it % N_A1;
            const int qb = 15 - (int)(i >> 7), bh = (int)(i & 127);
            att::attn_unit(a, lds, WV, bh >> 3, bh & 7, qb, dummy);
        }
    }
#if defined(STAMP_UNIT)
    if (unit_span) { const unsigned long long t_end = __builtin_amdgcn_s_memrealtime(); while (__builtin_amdgcn_s_memrealtime() - t_end < unit_span) __builtin_amdgcn_s_sleep(8); }
#endif
}
template <bool COOP>
__global__ void __launch_bounds__(NTHREADS, 2) fwd(Args args) {
    extern __shared__ __attribute__((aligned(16))) unsigned char lds_raw[];
    LAS unsigned char* lds = (LAS unsigned char*)lds_raw;
    const int G = gridDim.x, bx = blockIdx.x;
    const int WV = __builtin_amdgcn_readfirstlane((int)threadIdx.x >> 6);
    const int vcu = (G % 8 == 0) ? (bx % 8) * (G / 8) + bx / 8 : bx;
    const int lo = args.ph_lo, hi = args.ph_hi;
    volatile LAS unsigned* MISC = (volatile LAS unsigned*)(lds + LDS_BYTES - 128);
    if (WV == 0) { const int l_ = lane_id(); if (l_ < 32) MISC[l_] = 0u; }
    __syncthreads();
    XcdBarrier bar; bar.bar = nullptr; bar.x = 0; bar.st = nullptr;
    if constexpr (COOP) bar = xcd_barrier_post((unsigned*)(kargs()->ws + WS_CTL) + CW_BAR, MISC + 8, WV == 0 && lane_id() == 0);
#define IN(k) (lo <= (k) && (k) < hi)
#ifdef STAMP_ALL
    const unsigned long long all_t0 = __builtin_amdgcn_s_memrealtime();
#endif
#ifdef STAMP_PHASE
    unsigned long long st_t0 = 0ull, st_t1 = 0ull;
#define STAMP_BEGIN(k) do { if ((k) == STAMP_PHASE) st_t0 = __builtin_amdgcn_s_memrealtime(); } while (0)
#define STAMP_END(k) do { if ((k) == STAMP_PHASE) st_t1 = __builtin_amdgcn_s_memrealtime(); } while (0)
#else
#define STAMP_BEGIN(k) do { } while (0)
#define STAMP_END(k) do { } while (0)
#endif
#ifdef MK_CG_SEAM0
#define SEAM(k) do { if constexpr (COOP) { if (IN(k) && IN((k) + 1)) { if ((k) == 0) cg::this_grid().sync(); else xcd_barrier(bar, WV == 0 && lane_id() == 0); } } } while (0)
#else
#define SEAM(k) do { if constexpr (COOP) { if (IN(k) && IN((k) + 1)) xcd_barrier(bar, WV == 0 && lane_id() == 0); } } while (0)
#endif
    STAMP_BEGIN(0);
    if (IN(0)) for (int rep = 0; rep < REP_P0; ++rep) { phase0(kargs(), lds, vcu, G, WV); __syncthreads(); }
    SEAM(0);
    STAMP_END(0);
    STAMP_BEGIN(1);
    if (IN(1)) for (int rep = 0; rep < REP_P1; ++rep) { phase1(kargs(), lds, vcu, G, WV); __syncthreads(); }
    SEAM(1);
    STAMP_END(1);
    STAMP_BEGIN(2);
    if (IN(2)) {
#pragma unroll 1
        for (int rep = 0; rep < REP_P2; ++rep) {
        const KArgs ka = kargs(); unsigned char* ws_ = ka->ws; float* out_ = ka->out;
        pg8::Gemm g{(const bf16*)(ws_ + WS_HB), (const bf16*)(ws_ + WS_HB), (const bf16*)(ws_ + WS_WIN), MTOK, NPROJ, 1024, 1024, 16};
        pg8::StaticOrder S; S.init(MTOK, NPROJ, G, bx);
        EpiProj E{(bf16*)out_, (bf16*)out_ + (size_t)MTOK * 1024, (bf16*)(ws_ + WS_MV), (bf16*)(ws_ + WS_GM), (bf16*)(ws_ + WS_AQ), (bf16*)(ws_ + WS_AK), (bf16*)(ws_ + WS_AV), (bf16*)(ws_ + WS_AZ), (bf16*)(ws_ + WS_HALO)};
        pg8::gemm_phase<EpiProj, pg8::StaticOrder, true, true>(lds, g, S, E, WV);
        }
    }
    SEAM(2);
    STAMP_END(2);
    STAMP_BEGIN(3);
    if (IN(3)) phase3(kargs(), lds, WV);
    SEAM(3);
    STAMP_END(3);
    STAMP_BEGIN(4);
    if (IN(4)) {
#pragma unroll 1
        for (int rep = 0; rep < REP_P4; ++rep) {
        const KArgs ka = kargs(); unsigned char* ws_ = ka->ws; float* out_ = ka->out; const float* x_ = ka->in[0];
        pg8::Gemm g{(const bf16*)(ws_ + WS_HB), (const bf16*)(ws_ + WS_AQ), (const bf16*)(ws_ + WS_WOUT), MTOK, D, DMIX, 1024, 16};
        pg8::StaticOrder S; S.init(MTOK, D, G, bx);
        EpiOut E{x_, (const float*)(ws_ + WS_MOD), out_, (float*)(ws_ + WS_RSS)};
        pg8::gemm_phase<EpiOut, pg8::StaticOrder, true, true>(lds, g, S, E, WV);
        }
    }
    SEAM(4);
    STAMP_END(4);
    STAMP_BEGIN(5);
    if (IN(5)) phase5(kargs(), vcu, G, WV);
#if REP_P5 > 1
    if (IN(5)) { __syncthreads(); phase5_touch(kargs(), vcu, G, WV); }
#endif
    STAMP_END(5);
#ifdef STAMP_ALL
    if (blockIdx.x == 0 && WV == 0 && lane_id() == 0) { const unsigned long long t_end = __builtin_amdgcn_s_memrealtime(); while (__builtin_amdgcn_s_memrealtime() - t_end < (t_end - all_t0)) __builtin_amdgcn_s_sleep(8); }
#endif
#ifdef STAMP_PHASE
    if (blockIdx.x == 0 && WV == 0 && lane_id() == 0) { const unsigned long long t_end = __builtin_amdgcn_s_memrealtime(); while (__builtin_amdgcn_s_memrealtime() - t_end < (st_t1 - st_t0)) __builtin_amdgcn_s_sleep(8); }
#endif
#undef IN
#undef SEAM
}

#ifndef MK_MULTI
#define MK_MULTI 0
#endif
extern "C" void kernel_launch(void* const* d_in, const int* in_sizes, int n_in, void* d_out, int out_size, void* d_ws, size_t ws_size, hipStream_t stream) {
    static int grid = 0;
    if (grid == 0) {
        if (n_in != 19 || out_size != MTOK * D || ws_size < WS_HALO + 8 * MiB) { fprintf(stderr, "kernel_launch: unexpected shapes (n_in %d, out %d, ws %zu)\n", n_in, out_size, ws_size); grid = -1; return; }
        int dev = 0, cus = 0, per_cu = 0;
        (void)hipGetDevice(&dev); (void)hipDeviceGetAttribute(&cus, hipDeviceAttributeMultiprocessorCount, dev);
        (void)hipFuncSetAttribute((const void*)fwd<!MK_MULTI>, hipFuncAttributeMaxDynamicSharedMemorySize, LDS_BYTES);
        (void)hipOccupancyMaxActiveBlocksPerMultiprocessor(&per_cu, (const void*)fwd<!MK_MULTI>, NTHREADS, LDS_BYTES);
        if (per_cu < 1) { fprintf(stderr, "kernel_launch: occupancy query says %d blocks per CU\n", per_cu); per_cu = 1; }
        (void)hipGetLastError();
        grid = cus * (per_cu > 1 ? 1 : per_cu);
    }
    if (grid < 0) return;
    (void)hipMemsetAsync((char*)d_ws + WS_CTL, 0, 1 * MiB, stream);
    Args a{};
    for (int i = 0; i < 19; ++i) a.in[i] = (const float*)d_in[i];
    a.out = (float*)d_out; a.ws = (unsigned char*)d_ws;
#if MK_MULTI
    for (int ph = 0; ph < 6; ++ph) { a.ph_lo = ph; a.ph_hi = ph + 1; hipLaunchKernelGGL(fwd<false>, dim3(grid), dim3(NTHREADS), LDS_BYTES, stream, a); }
#else
    a.ph_lo = 0; a.ph_hi = 6;
    void* kargs[] = {&a};
    hipError_t e = hipLaunchCooperativeKernel((const void*)fwd<true>, dim3(grid), dim3(NTHREADS), kargs, LDS_BYTES, stream);
    if (e != hipSuccess) fprintf(stderr, "cooperative launch failed: %s (grid %d)\n", hipGetErrorString(e), grid);
#endif
}
```
